# Optimizing an MI355X kernel written in HIP

```python
import jax, jax.numpy as jnp
from jax import lax
import numpy as np

D_MODEL = 2048
BATCH = 4
SEQ = 4096
DEPTH = 1

CHUNK = 64
PLE_DIM = 256
EPS = 1e-6

GDN_HEADS = 8
GDN_DK = 128
GDN_DV = 128
GDN_CONV = 4
MLSTM_HEADS = 4
MLSTM_DQK = 128
MLSTM_DV = 256
GATE_SOFTCAP = 15.0
N_EXPERTS = 32
TOP_K = 4
D_EXPERT = 2048
SWIGLU_LIMIT = 7.0
SWIGLU_ALPHA = 1.702
MOE_BLOCK = 256

GDN_QK = GDN_HEADS * GDN_DK
GDN_V = GDN_HEADS * GDN_DV
ML_QK = MLSTM_HEADS * MLSTM_DQK
ML_V = MLSTM_HEADS * MLSTM_DV
MIX_WIDTH = GDN_V + ML_V
GDN_CONV_CH = 2 * GDN_QK + GDN_V
IN_SPLITS = (GDN_QK, GDN_QK, GDN_V, GDN_HEADS, GDN_HEADS, GDN_V,
             ML_QK, ML_QK, ML_V, MLSTM_HEADS, MLSTM_HEADS, ML_V)
D_IN = 2 * GDN_QK + 2 * GDN_V + 2 * GDN_HEADS + 2 * ML_QK + 2 * ML_V + 2 * MLSTM_HEADS

kernel_name = "hybrid_gdn_mlstm_moe_ple_block"


def rmsnorm(x, g):
    xf = x.astype(jnp.float32)
    y = xf * lax.rsqrt(jnp.mean(xf * xf, axis=-1, keepdims=True) + EPS)
    return (y * g.astype(jnp.float32)).astype(x.dtype)


def l2norm(x):
    return x * lax.rsqrt(jnp.sum(x * x, axis=-1, keepdims=True) + EPS)


def softcap(x, cap):
    return cap * jnp.tanh(x / cap)


def causal_dwconv(x, w):
    k = w.shape[0]
    return lax.conv_general_dilated(
        x, w[:, None, :].astype(x.dtype), window_strides=(1,), padding=[(k - 1, 0)],
        dimension_numbers=("NWC", "WIO", "NWC"), feature_group_count=x.shape[-1])


def to_chunks(t):
    b, s, h = t.shape[:3]
    t = t.reshape((b, s // CHUNK, CHUNK, h) + t.shape[3:])
    return t.transpose((1, 0, 3, 2) + tuple(range(4, t.ndim)))


def from_chunks(t):
    n, b, h, l, d = t.shape
    return t.transpose(1, 0, 3, 2, 4).reshape(b, n * l, h, d)


def gated_delta_chunked(q, k, v, g, beta):
    b_, s_, h_, dk = q.shape
    dv = v.shape[-1]
    qc, kc, vc = to_chunks(q), to_chunks(k), to_chunks(v)
    gc = jnp.cumsum(to_chunks(g), axis=-1)
    bc = to_chunks(beta)
    tril = jnp.tril(jnp.ones((CHUNK, CHUNK), bool))
    strict = jnp.tril(jnp.ones((CHUNK, CHUNK), bool), -1)
    decay = jnp.exp(jnp.where(tril, gc[..., :, None] - gc[..., None, :], -jnp.inf))
    kb = kc * bc[..., None]
    vb = vc * bc[..., None]
    m_low = jnp.where(strict, jnp.einsum("nbhld,nbhmd->nbhlm", kb, kc) * decay, 0.0)
    eye = jnp.eye(CHUNK, dtype=jnp.float32)
    a_mat = eye + m_low
    t_inv = lax.linalg.triangular_solve(a_mat, jnp.broadcast_to(eye, a_mat.shape),
                                        left_side=True, lower=True, unit_diagonal=True)
    u = jnp.einsum("nbhlm,nbhme->nbhle", t_inv, vb)
    w = jnp.einsum("nbhlm,nbhmd->nbhld", t_inv, kb * jnp.exp(gc)[..., None])
    attn = jnp.where(tril, jnp.einsum("nbhld,nbhmd->nbhlm", qc, kc) * decay, 0.0)
    q_dec = qc * jnp.exp(gc)[..., None]
    k_dec = kc * jnp.exp(gc[..., -1:] - gc)[..., None]
    g_last = jnp.exp(gc[..., -1])

    def step(state, xs):
        qd, kd, uc, wc, at, gl = xs
        v_new = uc - jnp.einsum("bhld,bhde->bhle", wc, state)
        o = jnp.einsum("bhld,bhde->bhle", qd, state) + jnp.einsum("bhlm,bhme->bhle", at, v_new)
        state = state * gl[..., None, None] + jnp.einsum("bhld,bhle->bhde", kd, v_new)
        return state, o

    s0 = jnp.zeros((b_, h_, dk, dv), jnp.float32)
    _, o = lax.scan(step, s0, (q_dec, k_dec, u, w, attn, g_last))
    return from_chunks(o)


def mlstm_chunked(q, k, v, i_pre, log_f):
    b_, s_, h_, dqk = q.shape
    dv = v.shape[-1]
    qc, kc, vc = to_chunks(q), to_chunks(k), to_chunks(v)
    fc = jnp.cumsum(to_chunks(log_f), axis=-1)
    ic = to_chunks(i_pre)
    tril = jnp.tril(jnp.ones((CHUNK, CHUNK), bool))
    d_mat = jnp.where(tril, fc[..., :, None] - fc[..., None, :] + ic[..., None, :], -jnp.inf)
    d_max = jnp.max(d_mat, axis=-1)
    qk = jnp.einsum("nbhld,nbhmd->nbhlm", qc, kc)
    a_end = fc[..., -1:] - fc + ic
    a_max = jnp.max(a_end, axis=-1)

    def step(carry, xs):
        c_st, n_st, m_st = carry
        q_c, k_c, v_c, f_c, dm, dmx, qk_c, ae, am = xs
        inter = f_c + m_st[..., None]
        m_i = jnp.maximum(dmx, inter)
        wts = jnp.exp(dm - m_i[..., None]) * qk_c
        s_inter = jnp.exp(inter - m_i)
        num = (s_inter[..., None] * jnp.einsum("bhld,bhde->bhle", q_c, c_st)
               + jnp.einsum("bhlm,bhme->bhle", wts, v_c))
        den = s_inter * jnp.einsum("bhld,bhd->bhl", q_c, n_st) + jnp.sum(wts, axis=-1)
        h = num / jnp.maximum(jnp.abs(den), jnp.exp(-m_i))[..., None]
        m_new = jnp.maximum(f_c[..., -1] + m_st, am)
        dec = jnp.exp(f_c[..., -1] + m_st - m_new)
        wk = jnp.exp(ae - m_new[..., None])
        c_st = dec[..., None, None] * c_st + jnp.einsum("bhl,bhld,bhle->bhde", wk, k_c, v_c)
        n_st = dec[..., None] * n_st + jnp.einsum("bhl,bhld->bhd", wk, k_c)
        return (c_st, n_st, m_new), h

    init = (jnp.zeros((b_, h_, dqk, dv), jnp.float32), jnp.zeros((b_, h_, dqk), jnp.float32),
            jnp.zeros((b_, h_), jnp.float32))
    _, h = lax.scan(step, init, (qc, kc, vc, fc, d_mat, d_max, qk, a_end, a_max))
    return from_chunks(h)


def hybrid_mixer(u, w_in, conv_w, a_log, dt_bias, gdn_norm, ml_b_i, ml_b_f, ml_norm, w_out):
    b_, s_, _ = u.shape
    f32 = jnp.float32
    z = u @ w_in
    parts = []
    off = 0
    for width in IN_SPLITS:
        parts.append(z[..., off:off + width])
        off += width
    g_q, g_k, g_v, g_a, g_b, g_z, m_q, m_k, m_v, m_i, m_f, m_o = parts

    qkv = jax.nn.silu(causal_dwconv(jnp.concatenate([g_q, g_k, g_v], axis=-1), conv_w)).astype(f32)
    q = l2norm(qkv[..., :GDN_QK].reshape(b_, s_, GDN_HEADS, GDN_DK)) * (GDN_DK ** -0.5)
    k = l2norm(qkv[..., GDN_QK:2 * GDN_QK].reshape(b_, s_, GDN_HEADS, GDN_DK))
    v = qkv[..., 2 * GDN_QK:].reshape(b_, s_, GDN_HEADS, GDN_DV)
    beta = jax.nn.sigmoid(g_b.astype(f32))
    g = -jnp.exp(a_log.astype(f32)) * jax.nn.softplus(g_a.astype(f32) + dt_bias.astype(f32))
    o_gdn = gated_delta_chunked(q, k, v, g, beta)
    o_gdn = rmsnorm(o_gdn, gdn_norm) * jax.nn.silu(g_z.astype(f32).reshape(b_, s_, GDN_HEADS, GDN_DV))

    mq = m_q.astype(f32).reshape(b_, s_, MLSTM_HEADS, MLSTM_DQK)
    mk = m_k.astype(f32).reshape(b_, s_, MLSTM_HEADS, MLSTM_DQK) * (MLSTM_DQK ** -0.5)
    mv = m_v.astype(f32).reshape(b_, s_, MLSTM_HEADS, MLSTM_DV)
    i_pre = softcap(m_i.astype(f32) + ml_b_i.astype(f32), GATE_SOFTCAP)
    log_f = jax.nn.log_sigmoid(softcap(m_f.astype(f32) + ml_b_f.astype(f32), GATE_SOFTCAP))
    h_ml = mlstm_chunked(mq, mk, mv, i_pre, log_f)
    h_ml = rmsnorm(h_ml, ml_norm) * jax.nn.sigmoid(m_o.astype(f32).reshape(b_, s_, MLSTM_HEADS, MLSTM_DV))

    y = jnp.concatenate([o_gdn.reshape(b_, s_, GDN_V), h_ml.reshape(b_, s_, ML_V)], axis=-1)
    return y.astype(u.dtype) @ w_out


def moe_ffn(u, w_router, b_router, w_gu, b_gu, w_down, b_down):
    b_, s_, d = u.shape
    n_tok = b_ * s_
    xt = u.reshape(n_tok, d)
    logits = (xt @ w_router).astype(jnp.float32) + b_router.astype(jnp.float32)
    top_v, top_i = lax.top_k(logits, TOP_K)
    gates = jax.nn.softmax(top_v, axis=-1)
    n_asg = n_tok * TOP_K
    flat_e = top_i.reshape(n_asg).astype(jnp.int32)
    flat_tok = jnp.arange(n_asg, dtype=jnp.int32) // TOP_K
    flat_g = gates.reshape(n_asg)
    order = jnp.argsort(flat_e)
    se, stok, sg = flat_e[order], flat_tok[order], flat_g[order]
    counts = jnp.zeros((N_EXPERTS,), jnp.int32).at[flat_e].add(1)
    padded = (counts + MOE_BLOCK - 1) // MOE_BLOCK * MOE_BLOCK
    start = jnp.cumsum(counts) - counts
    pend = jnp.cumsum(padded)
    pstart = pend - padded
    dest = pstart[se] + (jnp.arange(n_asg, dtype=jnp.int32) - start[se])
    n_blocks = -(-n_asg // MOE_BLOCK) + N_EXPERTS
    n_rows = n_blocks * MOE_BLOCK
    row_tok = jnp.full((n_rows,), n_tok, jnp.int32).at[dest].set(stok)
    row_g = jnp.zeros((n_rows,), jnp.float32).at[dest].set(sg)
    block_start = jnp.arange(n_blocks, dtype=jnp.int32) * MOE_BLOCK
    block_e = jnp.minimum(jnp.searchsorted(pend, block_start, side="right"), N_EXPERTS - 1)
    x_pad = jnp.concatenate([xt, jnp.zeros((1, d), xt.dtype)], axis=0)

    def expert_block(args):
        toks, e = args
        xb = x_pad[toks]
        hgu = xb @ w_gu[e] + b_gu[e]
        gate = jnp.minimum(hgu[:, ::2], SWIGLU_LIMIT)
        up = jnp.clip(hgu[:, 1::2], -SWIGLU_LIMIT, SWIGLU_LIMIT)
        act = gate * jax.nn.sigmoid(gate * SWIGLU_ALPHA) * (up + 1.0)
        return act @ w_down[e] + b_down[e]

    yb = lax.map(expert_block, (row_tok.reshape(n_blocks, MOE_BLOCK), block_e))
    y = jnp.zeros((n_tok + 1, d), jnp.float32).at[row_tok].add(
        yb.reshape(n_rows, d).astype(jnp.float32) * row_g[:, None])
    return y[:n_tok].reshape(b_, s_, d).astype(u.dtype)


def setup_inputs(seed: int = 0) -> dict:
    key = jax.random.key(seed)
    ks = jax.random.split(key, 32)
    f32 = jnp.float32

    def nrm(k, shape, scale):
        return jax.random.normal(k, shape, f32) * scale

    def gain(k, shape):
        return 1.0 + 0.05 * jax.random.normal(k, shape, f32)

    dt = jnp.exp(jax.random.uniform(ks[6], (DEPTH, GDN_HEADS), f32, np.log(1e-3), np.log(1e-1)))
    return {
        "x": nrm(ks[0], (BATCH, SEQ, D_MODEL), 1.0),
        "p": nrm(ks[1], (DEPTH, BATCH, SEQ, PLE_DIM), 1.0),
        "g_mix": gain(ks[2], (DEPTH, D_MODEL)),
        "w_in": nrm(ks[3], (DEPTH, D_MODEL, D_IN), D_MODEL ** -0.5),
        "conv_w": nrm(ks[4], (DEPTH, GDN_CONV, GDN_CONV_CH), GDN_CONV ** -0.5),
        "a_log": jnp.log(jax.random.uniform(ks[5], (DEPTH, GDN_HEADS), f32, 1.0, 16.0)),
        "dt_bias": dt + jnp.log(-jnp.expm1(-dt)),
        "gdn_norm": gain(ks[7], (DEPTH, GDN_DV)),
        "ml_b_i": nrm(ks[8], (DEPTH, MLSTM_HEADS), 0.1),
        "ml_b_f": jnp.linspace(3.0, 6.0, MLSTM_HEADS, dtype=f32)[None, :] + nrm(ks[9], (DEPTH, MLSTM_HEADS), 0.1),
        "ml_norm": gain(ks[10], (DEPTH, MLSTM_HEADS, MLSTM_DV)),
        "w_out": nrm(ks[11], (DEPTH, MIX_WIDTH, D_MODEL), MIX_WIDTH ** -0.5),
        "g_ffn": gain(ks[12], (DEPTH, D_MODEL)),
        "w_router": nrm(ks[13], (DEPTH, D_MODEL, N_EXPERTS), D_MODEL ** -0.5),
        "b_router": nrm(ks[14], (DEPTH, N_EXPERTS), 0.01),
        "w_gu": nrm(ks[15], (DEPTH, N_EXPERTS, D_MODEL, 2 * D_EXPERT), D_MODEL ** -0.5),
        "b_gu": nrm(ks[16], (DEPTH, N_EXPERTS, 2 * D_EXPERT), 0.01),
        "w_down": nrm(ks[17], (DEPTH, N_EXPERTS, D_EXPERT, D_MODEL), D_EXPERT ** -0.5),
        "b_down": nrm(ks[18], (DEPTH, N_EXPERTS, D_MODEL), 0.01),
        "g_ple": gain(ks[19], (DEPTH, D_MODEL)),
        "w_ple_gate": nrm(ks[20], (DEPTH, D_MODEL, D_MODEL), D_MODEL ** -0.5),
        "w_ple_proj": nrm(ks[21], (DEPTH, PLE_DIM, D_MODEL), PLE_DIM ** -0.5),
        "g_ple_post": gain(ks[22], (DEPTH, D_MODEL)),
        "g_final": gain(ks[23], (D_MODEL,)),
    }


def reference(x, p, g_mix, w_in, conv_w, a_log, dt_bias, gdn_norm, ml_b_i, ml_b_f, ml_norm, w_out,
              g_ffn, w_router, b_router, w_gu, b_gu, w_down, b_down, g_ple, w_ple_gate, w_ple_proj,
              g_ple_post, g_final):
    h = x
    for l in range(DEPTH):
        u = rmsnorm(h, g_mix[l])
        h = h + hybrid_mixer(u, w_in[l], conv_w[l], a_log[l], dt_bias[l], gdn_norm[l],
                             ml_b_i[l], ml_b_f[l], ml_norm[l], w_out[l])
        u = rmsnorm(h, g_ffn[l])
        h = h + moe_ffn(u, w_router[l], b_router[l], w_gu[l], b_gu[l], w_down[l], b_down[l])
        gate = jax.nn.sigmoid((rmsnorm(h, g_ple[l]) @ w_ple_gate[l]).astype(jnp.float32))
        pe = rmsnorm(p[l].astype(h.dtype) @ w_ple_proj[l], g_ple_post[l])
        h = h + (gate * pe.astype(jnp.float32)).astype(h.dtype)
    return rmsnorm(h, g_final)
```

```cpp
#include <hip/hip_runtime.h>
#include <cstdio>
#include <cstdint>


#ifndef MK_SPLIT
#define MK_SPLIT 1
#endif

#define LAS __attribute__((address_space(3)))
typedef unsigned short bf16;
typedef short bf16x8 __attribute__((ext_vector_type(8)));
typedef float f32x4 __attribute__((ext_vector_type(4)));
typedef float f32x2 __attribute__((ext_vector_type(2)));
typedef unsigned u32x4 __attribute__((ext_vector_type(4)));
typedef unsigned u32x2 __attribute__((ext_vector_type(2)));

constexpr int NTOK = 16384, DM = 2048, SEQL = 4096, NCHT = 256  ;
constexpr int DIN = 7192, NZ = 7168, PLE = 256, NEXP = 32;
constexpr int ZQ = 0, ZK = 1024, ZV = 2048, ZG = 3072, ZMQ = 4096, ZMK = 4608, ZMV = 5120, ZMO = 6144;
constexpr int MAXROWS = 73728;
constexpr float EPS = 1e-6f;

constexpr size_t MiB = 1ull << 20;
constexpr size_t WS_CTL = 0, CTL_ZERO_BYTES = 1 * MiB;
constexpr size_t WS_WIN = 1 * MiB, WS_WOUT = 29 * MiB, WS_WPG = 37 * MiB, WS_WPP = 45 * MiB, WS_WGU = 46 * MiB, WS_WDN = 558 * MiB;
constexpr size_t WS_XB = 814 * MiB, WS_PB = 878 * MiB, WS_Z = 886 * MiB, WS_PE = 1110 * MiB;
constexpr size_t WS_GW = 1174 * MiB, WS_GQD = 1206 * MiB, WS_GKDT = 1238 * MiB, WS_GAT = 1270 * MiB, WS_GU = 1286 * MiB;
constexpr size_t WS_MWT = 1350 * MiB, WS_MKWT = 1358 * MiB, WS_MVT = 1374 * MiB;
constexpr size_t WS_OSC = 1406 * MiB, WS_Y = 1534 * MiB, WS_H1 = 1598 * MiB, WS_H1B = 1726 * MiB;
constexpr size_t WS_ACT = 1790 * MiB, WS_YB = 2078 * MiB, WS_H2 = 2366 * MiB, WS_H2B = 2494 * MiB, WS_H3 = 2558 * MiB;
constexpr size_t WS_SMALL = 2686 * MiB, WS_END = 2718 * MiB;
constexpr size_t SM_RS1 = 0, SM_GC = 64 << 10, SM_BETA = SM_GC + (512 << 10), SM_FC = SM_BETA + (512 << 10), SM_IC = SM_FC + (256 << 10);
constexpr size_t SM_FLAST = SM_IC + (256 << 10), SM_AMAX = SM_FLAST + 4096, SM_GLAST = SM_AMAX + 4096;
constexpr size_t SM_MSI = SM_GLAST + 8192, SM_MEN = SM_MSI + (256 << 10), SM_MWS = SM_MEN + (256 << 10), SM_MDEC = SM_MWS + (256 << 10);
constexpr size_t SM_DEN = SM_MDEC + 4096, SM_PESSQ = SM_DEN + (256 << 10), SM_SSQ1 = SM_PESSQ + (2 << 20), SM_SSQ3 = SM_SSQ1 + (2 << 20);
constexpr size_t SM_RS2 = SM_SSQ3 + (2 << 20), SM_RS3 = SM_RS2 + (64 << 10), SM_RSPE = SM_RS3 + (64 << 10);
constexpr size_t SM_TOPI = SM_RSPE + (64 << 10), SM_TOPG = SM_TOPI + (256 << 10), SM_LRANK = SM_TOPG + (256 << 10), SM_DEST = SM_LRANK + (256 << 10);
constexpr size_t SM_UCNT = SM_DEST + (256 << 10), SM_ROWTOK = SM_UCNT + (32 << 10), SM_ROWGATE = SM_ROWTOK + (288 << 10), SM_ROWRS = SM_ROWGATE + (288 << 10);
constexpr size_t SM_END = SM_ROWRS + (288 << 10);
static_assert(SM_END <= 32 * MiB, "small arrays");
constexpr int CW_BAR = 4096, CW_CNTE = 8192;

constexpr int RING_BYTES = 131072, MISC_OFF = 139264, LDS_BYTES = 155648;
constexpr int NWAVES = 8;

typedef __bf16 bf16v2_t __attribute__((ext_vector_type(2)));
__device__ __forceinline__ unsigned pk2(float lo, float hi) { const f32x2 v = {lo, hi}; return __builtin_bit_cast(unsigned, __builtin_convertvector(v, bf16v2_t)); }
__device__ __forceinline__ bf16 f2bf(float f) { return __builtin_bit_cast(unsigned short, (__bf16)f); }
__device__ __forceinline__ float bf2f(bf16 b) { return __uint_as_float(((unsigned)b) << 16); }
__device__ __forceinline__ float bflo(unsigned w) { return __uint_as_float(w << 16); }
__device__ __forceinline__ float bfhi(unsigned w) { return __uint_as_float(w & 0xffff0000u); }
__device__ __forceinline__ float wave_sum(float v) {
#pragma unroll
    for (int o = 1; o < 64; o <<= 1) v += __shfl_xor(v, o);
    return v;
}
__device__ __forceinline__ float sigm(float x) { return 1.f / (1.f + __expf(-x)); }
__device__ __forceinline__ float softplusf(float x) { return fmaxf(x, 0.f) + log1pf(expf(-fabsf(x))); }
#define LDS_WAIT() asm volatile("s_waitcnt lgkmcnt(0)" ::: "memory")

#define XB_TMO      128
#define XB_XCNT(j)  (256  + 64 * (j))
#define XB_XSUB(j)  (1280 + 64 * (j))
#define XB_XGEN(j)  (2304 + 64 * (j))
#define XB_TOP      3328
#define XB_TOPGEN   3392
#define XCD_BAR_WORDS 3456
#define XB_SPIN_CAP (1u << 18)
__device__ __forceinline__ unsigned xb_ld(unsigned* p)              { return __hip_atomic_load(p, __ATOMIC_RELAXED, __HIP_MEMORY_SCOPE_AGENT); }
__device__ __forceinline__ unsigned xb_add(unsigned* p, unsigned v) { return __hip_atomic_fetch_add(p, v, __ATOMIC_RELAXED, __HIP_MEMORY_SCOPE_AGENT); }
__device__ __forceinline__ unsigned xb_xcc_id() { return (unsigned)__builtin_amdgcn_s_getreg((3 << 11) | 20) & 0xFu; }
#define XB_SPIN(cond, bar) do { unsigned _sp = 0; while (cond) { __builtin_amdgcn_s_sleep(1); \
    if ((++_sp & 255u) == 0u) { if (xb_ld(&(bar)[XB_TMO])) break; if (_sp > XB_SPIN_CAP) { atomicAdd(&(bar)[XB_TMO], 1u); break; } } } } while (0)
struct XcdBarrier { unsigned* bar; unsigned x; volatile LAS unsigned* st; };
__device__ __forceinline__ XcdBarrier xcd_barrier_post(unsigned* bar, volatile LAS unsigned* st) {
    XcdBarrier b; b.bar = bar; b.x = xb_xcc_id(); b.st = st;
    if (threadIdx.x == 0) (void)xb_add(&bar[XB_XCNT(b.x)], 1u);
    return b;
}
__device__ __forceinline__ void xcd_barrier_complete(unsigned* bar, unsigned x, unsigned& nloc, unsigned& nx) {
    const unsigned G = gridDim.x * gridDim.y * gridDim.z;
    unsigned sum, cnt, mine, sp = 0u;
    for (;;) {
        sum = 0u; cnt = 0u; mine = 0u;
#pragma unroll
        for (unsigned j = 0; j < 16; ++j) { const unsigned c = xb_ld(&bar[XB_XCNT(j)]); sum += c; cnt += (c > 0u) ? 1u : 0u; mine = (j == x) ? c : mine; }
        if (sum == G) break;
        __builtin_amdgcn_s_sleep(1);
        if ((++sp & 255u) == 0u) { if (xb_ld(&bar[XB_TMO])) break; if (sp > XB_SPIN_CAP) { atomicAdd(&bar[XB_TMO], 1u); break; } }
    }
    nloc = mine > 0u ? mine : 1u; nx = cnt > 0u ? cnt : 1u;
}
__device__ __forceinline__ void xcd_barrier(const XcdBarrier& b) {
    asm volatile("s_waitcnt vmcnt(0)" ::: "memory");
    __syncthreads();
    if (threadIdx.x == 0) {
        unsigned* bar = b.bar;
        __builtin_amdgcn_s_waitcnt(0);
        unsigned nloc = b.st[0], nx = b.st[1];
        if (nloc == 0u) { xcd_barrier_complete(bar, b.x, nloc, nx); b.st[0] = nloc; b.st[1] = nx; }
        const unsigned old = xb_add(&bar[XB_XSUB(b.x)], 1u);
        const unsigned gen = old / nloc;
        if (old + 1u == (gen + 1u) * nloc) {
            __builtin_amdgcn_fence(__ATOMIC_RELEASE, "agent");
            asm volatile("s_waitcnt vmcnt(0)" ::: "memory");
            const unsigned og = xb_add(&bar[XB_TOP], 1u);
            const unsigned tg = og / nx;
            if (og + 1u == (tg + 1u) * nx) xb_add(&bar[XB_TOPGEN], 1u);
            else XB_SPIN(xb_ld(&bar[XB_TOPGEN]) == tg, bar);
            __builtin_amdgcn_fence(__ATOMIC_ACQUIRE, "agent");
            xb_add(&bar[XB_XGEN(b.x)], 1u);
            asm volatile("s_waitcnt vmcnt(0)" ::: "memory");
        } else {
            XB_SPIN(xb_ld(&bar[XB_XGEN(b.x)]) == gen, bar);
            __builtin_amdgcn_fence(__ATOMIC_ACQUIRE, "agent");
            asm volatile("s_waitcnt vmcnt(0)" ::: "memory");
        }
    }
    __syncthreads();
}

namespace pg8 {
constexpr int BM = 256, BK = 64, HALF = 128, HTB = HALF * BK * 2, STAGE_BYTES = 8 * HTB, NXCD = 8, WGM = 8;
__host__ __device__ __forceinline__ int lds_byte(int r, int c) { const int st = (r >> 4) * 2 + (c >> 5), rr = r & 15, cc = c & 31, ob = rr * 64 + cc * 2; return st * 1024 + (ob ^ (((ob >> 9) & 1) << 5)); }
__host__ __device__ __forceinline__ void stage_rc(int b, int& R, int& C) { const int st = b / 1024, sb = b % 1024, swz = sb ^ (((sb >> 9) & 1) << 5); R = (st >> 1) * 16 + swz / 64; C = (st & 1) * 32 + (swz % 64) / 2; }
__host__ __device__ __forceinline__ int perm32(int rho) { const int n = rho >> 4, i = rho & 15; return 8 * (i >> 2) + 4 * n + (i & 3); }
struct Unit { int pm, pn, e; };
struct Gemm { const bf16* A; const bf16* Bt; int K; size_t bstride; const int* rowtab; };
struct Order {
    int nM, nN, nwg, G, c; const LAS int* tile_e;
    __device__ __forceinline__ void init(int nM_, int nN_, int G_, int c_, const LAS int* te) { nM = nM_; nN = nN_; nwg = nM * nN; G = G_; c = c_; tile_e = te; }
    __device__ __forceinline__ bool next(int i, Unit& u) const {
        const long L = (long)i * G + c; if (L >= nwg) return false;
        int wgid = (int)L; { const int q = nwg / NXCD, r = nwg % NXCD, xcd = wgid % NXCD, off = wgid / NXCD; wgid = (xcd < r ? xcd * (q + 1) : r * (q + 1) + (xcd - r) * q) + off; }
        const int nig = WGM * nN, gid = wgid / nig, fm = gid * WGM, gsz = (nM - fm) < WGM ? (nM - fm) : WGM;
        u.pm = fm + ((wgid % nig) % gsz); u.pn = (wgid % nig) / gsz; u.e = tile_e ? tile_e[u.pm] : 0; return true;
    }
};

template <class Epi, bool GATHER, bool ALIGN_EPI>
__device__ __forceinline__ void gemm_phase(LAS unsigned char* lds, const Gemm g, const Order& S, const Epi& E) {
    const int tid = threadIdx.x, wid = __builtin_amdgcn_readfirstlane(tid >> 6), lane = tid & 63, wr = wid >> 2, wc = wid & 3, fr = lane & 15, fq = lane >> 4;
    const int K = g.K, nt = K / BK;
    unsigned voffA[2], voffB[2]; int Rg[2], Cg[2];
#pragma unroll
    for (int i = 0; i < 2; ++i) { int R, C; stage_rc(tid * 16 + i * 8192, R, C); const int Rb = Epi::PERM ? ((R & ~31) + perm32(R & 31)) : R;
        voffA[i] = (unsigned)(R * K + C) * 2u; voffB[i] = (unsigned)(Rb * K + C) * 2u; Rg[i] = R; Cg[i] = C; }
    unsigned vAc[2][2], vAn[2][2];
    const size_t kstep = (size_t)(BK * 2);
    const size_t hstep = (size_t)HALF * K * 2;
    const size_t tstep = 2 * hstep;
    const unsigned ldsw = (unsigned)wid * 1024u;
    const int aoff = lds_byte(wr * 64 + fr, fq * 8), boff = lds_byte(wc * 32 + fr, fq * 8);
#define PG8_SA(b, h) (((b) * 2 + (h)) * HTB)
#define PG8_SB(b, h) ((4 + (b) * 2 + (h)) * HTB)
#define PG8_STAGE(bufoff, gbase, voff) do { _Pragma("unroll") for (int _i = 0; _i < 2; ++_i) \
        __builtin_amdgcn_global_load_lds((const unsigned*)((const char*)(gbase) + (voff)[_i]), (LAS unsigned*)(lds + (bufoff) + ldsw + _i * 8192), 16, 0, 0); } while (0)
#define PG8_STAGE_A(bufoff, kp, h, nx) do { if constexpr (GATHER) { _Pragma("unroll") for (int _i = 0; _i < 2; ++_i) { const unsigned _vo = (nx) ? vAn[h][_i] : vAc[h][_i]; \
        __builtin_amdgcn_global_load_lds((const unsigned*)((const char*)(kp) + _vo), (LAS unsigned*)(lds + (bufoff) + ldsw + _i * 8192), 16, 0, 0); } } \
        else { PG8_STAGE(bufoff, (kp) + (h) * hstep, voffA); } } while (0)
#define PG8_LDA(dst, b, h) do { _Pragma("unroll") for (int m = 0; m < 4; ++m) _Pragma("unroll") for (int k = 0; k < 2; ++k) dst[m][k] = *(const LAS bf16x8*)(lds + PG8_SA(b, h) + aoff + m * 2048 + k * 1024); } while (0)
#define PG8_LDB(dst, b, h) do { _Pragma("unroll") for (int n = 0; n < 2; ++n) _Pragma("unroll") for (int k = 0; k < 2; ++k) dst[n][k] = *(const LAS bf16x8*)(lds + PG8_SB(b, h) + boff + n * 2048 + k * 1024); } while (0)
#define PG8_MMA(ai, bj, At, Bt) do { __builtin_amdgcn_s_setprio(1); _Pragma("unroll") for (int m = 0; m < 4; ++m) _Pragma("unroll") for (int n = 0; n < 2; ++n) _Pragma("unroll") for (int k = 0; k < 2; ++k) \
        acc[ai][bj][m][n] = __builtin_amdgcn_mfma_f32_16x16x32_bf16(Bt[n][k], At[m][k], acc[ai][bj][m][n], 0, 0, 0); __builtin_amdgcn_s_setprio(0); } while (0)
#define PG8_WAIT_V(n) asm volatile("s_waitcnt vmcnt(" #n ")" ::: "memory")
#define PG8_WAIT_L(n) asm volatile("s_waitcnt lgkmcnt(" #n ")" ::: "memory")
#define PG8_BAR __builtin_amdgcn_s_barrier()
#define PG8_SCHED __builtin_amdgcn_sched_barrier(0)
#define PG8_GOFF(dst, u) do { if constexpr (GATHER) { _Pragma("unroll") for (int _h = 0; _h < 2; ++_h) _Pragma("unroll") for (int _i = 0; _i < 2; ++_i) \
        dst[_h][_i] = (unsigned)g.rowtab[(u).pm * BM + _h * HALF + Rg[_i]] * (unsigned)(K * 2) + (unsigned)(Cg[_i] * 2); } } while (0)
    Unit cur, nxt; int ui = 0;
    if (!S.next(0, cur)) return;
    f32x4 acc[2][2][4][2];
#pragma unroll
    for (int a = 0; a < 2; ++a)
#pragma unroll
        for (int b = 0; b < 2; ++b)
#pragma unroll
            for (int m = 0; m < 4; ++m)
#pragma unroll
                for (int n = 0; n < 2; ++n) acc[a][b][m][n] = (f32x4){0.f, 0.f, 0.f, 0.f};
    bf16x8 At[4][2], B0[2][2], B1[2][2];
    PG8_GOFF(vAc, cur);
#pragma unroll
    for (int _h = 0; _h < 2; ++_h)
#pragma unroll
        for (int _i = 0; _i < 2; ++_i) vAn[_h][_i] = vAc[_h][_i];
    const char* cA = GATHER ? (const char*)g.A : (const char*)g.A + (size_t)cur.pm * tstep;
    const char* cB = (const char*)g.Bt + (size_t)cur.e * g.bstride + (size_t)cur.pn * tstep;
    PG8_STAGE(PG8_SB(0, 0), cB, voffB); PG8_STAGE(PG8_SB(0, 1), cB + hstep, voffB); PG8_STAGE_A(PG8_SA(0, 0), cA, 0, false); PG8_STAGE_A(PG8_SA(0, 1), cA, 1, false);
    if (wr == 1) PG8_BAR;
    PG8_WAIT_V(2); PG8_BAR;
    PG8_STAGE(PG8_SB(1, 0), cB + kstep, voffB); PG8_STAGE_A(PG8_SA(1, 0), cA + kstep, 0, false); PG8_STAGE(PG8_SB(1, 1), cB + hstep + kstep, voffB);
    PG8_WAIT_V(6); PG8_BAR;
    for (;;) {
        const bool has_next = S.next(ui + 1, nxt);
        if (has_next) { PG8_GOFF(vAn, nxt); }
        const char* nA = GATHER ? (const char*)g.A : (has_next ? (const char*)g.A + (size_t)nxt.pm * tstep : cA);
        const char* nB = has_next ? (const char*)g.Bt + (size_t)nxt.e * g.bstride + (size_t)nxt.pn * tstep : cB;
        for (int t = 0; t < nt; t += 2) {
            const bool last = (t == nt - 2);
            const char* a1 = cA + (size_t)(t + 1) * kstep;
            const char* a2 = last ? nA : cA + (size_t)(t + 2) * kstep; const char* b2 = last ? nB : cB + (size_t)(t + 2) * kstep;
            const char* a3 = a2 + kstep; const char* b3 = b2 + kstep;
            PG8_LDB(B0, 0, 0); PG8_LDB(B1, 0, 1); PG8_SCHED; PG8_LDA(At, 0, 0); PG8_STAGE_A(PG8_SA(1, 1), a1, 1, false);
            PG8_WAIT_V(8); PG8_WAIT_L(0); PG8_BAR; PG8_MMA(0, 0, At, B0); PG8_MMA(0, 1, At, B1); PG8_BAR; PG8_SCHED;
            PG8_LDA(At, 0, 1); PG8_STAGE(PG8_SB(0, 0), b2, voffB); PG8_STAGE(PG8_SB(0, 1), b2 + hstep, voffB); PG8_STAGE_A(PG8_SA(0, 0), a2, 0, last);
            PG8_WAIT_V(8); PG8_WAIT_L(0); PG8_BAR; PG8_MMA(1, 0, At, B0); PG8_MMA(1, 1, At, B1); PG8_BAR; PG8_SCHED;
            PG8_LDB(B0, 1, 0); PG8_LDB(B1, 1, 1); PG8_SCHED; PG8_LDA(At, 1, 0); PG8_STAGE_A(PG8_SA(0, 1), a2, 1, last);
            PG8_WAIT_V(8); PG8_WAIT_L(0); PG8_BAR; PG8_MMA(0, 0, At, B0); PG8_MMA(0, 1, At, B1); PG8_BAR; PG8_SCHED;
            PG8_LDA(At, 1, 1); PG8_STAGE(PG8_SB(1, 0), b3, voffB); PG8_STAGE(PG8_SB(1, 1), b3 + hstep, voffB); PG8_STAGE_A(PG8_SA(1, 0), a3, 0, last);
            PG8_WAIT_V(8); PG8_WAIT_L(0); PG8_BAR; PG8_MMA(1, 0, At, B0); PG8_MMA(1, 1, At, B1); PG8_BAR; PG8_SCHED;
        }
        if constexpr (ALIGN_EPI) { if (wr == 0) PG8_BAR; }
        E(acc, cur, wr, wc, fr, fq);
        if (!has_next) break;
#pragma unroll
        for (int a = 0; a < 2; ++a)
#pragma unroll
            for (int b = 0; b < 2; ++b)
#pragma unroll
                for (int m = 0; m < 4; ++m)
#pragma unroll
                    for (int n = 0; n < 2; ++n) acc[a][b][m][n] = (f32x4){0.f, 0.f, 0.f, 0.f};
        cur = nxt; cA = nA; cB = nB; ++ui;
#pragma unroll
        for (int _h = 0; _h < 2; ++_h)
#pragma unroll
            for (int _i = 0; _i < 2; ++_i) vAc[_h][_i] = vAn[_h][_i];
        if constexpr (ALIGN_EPI) { if (wr == 1) PG8_BAR; }
    }
    PG8_WAIT_V(0);
    if constexpr (!ALIGN_EPI) { if (wr == 0) PG8_BAR; }
    PG8_BAR;
#undef PG8_SA
#undef PG8_SB
#undef PG8_STAGE
#undef PG8_STAGE_A
#undef PG8_LDA
#undef PG8_LDB
#undef PG8_MMA
#undef PG8_WAIT_V
#undef PG8_WAIT_L
#undef PG8_BAR
#undef PG8_SCHED
#undef PG8_GOFF
}

typedef const f32x4 (&AccRef)[2][2][4][2];

struct EpiZ {
    static constexpr bool PERM = true;
    bf16* Z; int ldc; const float* rs;
    __device__ __forceinline__ void operator()(AccRef acc, const Unit& u, int wr, int wc, int fr, int fq) const {
        const int row0 = u.pm * BM + wr * 64 + fr, col0 = u.pn * BM + wc * 32 + 8 * fq;
#pragma unroll
        for (int ai = 0; ai < 2; ++ai)
#pragma unroll
            for (int m = 0; m < 4; ++m) { const int r = row0 + ai * HALF + m * 16; const float s = rs[r]; bf16* rowp = Z + (size_t)r * ldc + col0;
#pragma unroll
                for (int bj = 0; bj < 2; ++bj) { const f32x4 v0 = acc[ai][bj][m][0] * s, v1 = acc[ai][bj][m][1] * s;
                    u32x4 w; w.x = pk2(v0[0], v0[1]); w.y = pk2(v0[2], v0[3]); w.z = pk2(v1[0], v1[1]); w.w = pk2(v1[2], v1[3]);
                    *(u32x4*)(rowp + bj * HALF) = w; } }
    }
};
struct EpiPe {
    static constexpr bool PERM = true;
    bf16* O; float* ssq;
    __device__ __forceinline__ void operator()(AccRef acc, const Unit& u, int wr, int wc, int fr, int fq) const {
        const int row0 = u.pm * BM + wr * 64 + fr, col0 = u.pn * BM + wc * 32 + 8 * fq;
#pragma unroll
        for (int ai = 0; ai < 2; ++ai)
#pragma unroll
            for (int m = 0; m < 4; ++m) { const int r = row0 + ai * HALF + m * 16; bf16* rowp = O + (size_t)r * DM + col0; float ss = 0.f;
#pragma unroll
                for (int bj = 0; bj < 2; ++bj) { const f32x4 v0 = acc[ai][bj][m][0], v1 = acc[ai][bj][m][1];
                    ss += (v0[0] * v0[0] + v0[1] * v0[1]) + (v0[2] * v0[2] + v0[3] * v0[3]) + (v1[0] * v1[0] + v1[1] * v1[1]) + (v1[2] * v1[2] + v1[3] * v1[3]);
                    u32x4 w; w.x = pk2(v0[0], v0[1]); w.y = pk2(v0[2], v0[3]); w.z = pk2(v1[0], v1[1]); w.w = pk2(v1[2], v1[3]);
                    *(u32x4*)(rowp + bj * HALF) = w; }
                ss += __shfl_xor(ss, 16); ss += __shfl_xor(ss, 32);
                if (fq == 0) ssq[(size_t)r * 32 + u.pn * 4 + wc] = ss; }
    }
};
struct EpiOut {
    static constexpr bool PERM = false;
    const float* X; float* H; bf16* HB; float* ssq;
    __device__ __forceinline__ void operator()(AccRef acc, const Unit& u, int wr, int wc, int fr, int fq) const {
        const int row0 = u.pm * BM + wr * 64 + fr, col0 = u.pn * BM + wc * 32 + 4 * fq;
#pragma unroll
        for (int ai = 0; ai < 2; ++ai)
#pragma unroll
            for (int m = 0; m < 4; ++m) { const int r = row0 + ai * HALF + m * 16; const size_t off = (size_t)r * DM + col0; float ss = 0.f;
#pragma unroll
                for (int bj = 0; bj < 2; ++bj)
#pragma unroll
                    for (int n = 0; n < 2; ++n) { const size_t o = off + bj * HALF + n * 16; const f32x4 h = *(const f32x4*)(X + o) + acc[ai][bj][m][n];
                        *(f32x4*)(H + o) = h; u32x2 w; w.x = pk2(h[0], h[1]); w.y = pk2(h[2], h[3]); *(u32x2*)(HB + o) = w;
                        ss += (h[0] * h[0] + h[1] * h[1]) + (h[2] * h[2] + h[3] * h[3]); }
                ss += __shfl_xor(ss, 16); ss += __shfl_xor(ss, 32);
                if (fq == 0) ssq[(size_t)r * 32 + u.pn * 4 + wc] = ss; }
    }
};
struct EpiMoe1 {
    static constexpr bool PERM = true;
    bf16* ACT; const float* bgu; const float* rowrs;
    __device__ __forceinline__ void operator()(AccRef acc, const Unit& u, int wr, int wc, int fr, int fq) const {
        const int row0 = u.pm * BM + wr * 64 + fr, j0 = u.pn * HALF + wc * 32 + 8 * fq;
        const float* bp = bgu + (size_t)u.e * 4096 + 2 * j0;
        const f32x4 b0 = *(const f32x4*)(bp), b1 = *(const f32x4*)(bp + 4), b2 = *(const f32x4*)(bp + 8), b3 = *(const f32x4*)(bp + 12);
        const float bg[8] = {b0[0], b0[2], b1[0], b1[2], b2[0], b2[2], b3[0], b3[2]}, bu[8] = {b0[1], b0[3], b1[1], b1[3], b2[1], b2[3], b3[1], b3[3]};
#pragma unroll
        for (int ai = 0; ai < 2; ++ai)
#pragma unroll
            for (int m = 0; m < 4; ++m) { const int r = row0 + ai * HALF + m * 16; const float s = rowrs[r]; float o[8];
#pragma unroll
                for (int n = 0; n < 2; ++n)
#pragma unroll
                    for (int q = 0; q < 4; ++q) { float gt = acc[ai][0][m][n][q] * s + bg[4 * n + q], up = acc[ai][1][m][n][q] * s + bu[4 * n + q];
                        gt = fminf(gt, 7.f); up = fminf(fmaxf(up, -7.f), 7.f); o[4 * n + q] = gt * sigm(1.702f * gt) * (up + 1.f); }
                u32x4 w; w.x = pk2(o[0], o[1]); w.y = pk2(o[2], o[3]); w.z = pk2(o[4], o[5]); w.w = pk2(o[6], o[7]);
                *(u32x4*)(ACT + (size_t)r * DM + j0) = w; }
    }
};
struct EpiMoe2 {
    static constexpr bool PERM = true;
    bf16* YB; const float* bdn; const float* rowgate;
    __device__ __forceinline__ void operator()(AccRef acc, const Unit& u, int wr, int wc, int fr, int fq) const {
        const int row0 = u.pm * BM + wr * 64 + fr, col0 = u.pn * BM + wc * 32 + 8 * fq;
        const float* bp = bdn + (size_t)u.e * DM + col0;
        f32x4 bv[2][2];
#pragma unroll
        for (int bj = 0; bj < 2; ++bj)
#pragma unroll
            for (int n = 0; n < 2; ++n) bv[bj][n] = *(const f32x4*)(bp + bj * HALF + 4 * n);
#pragma unroll
        for (int ai = 0; ai < 2; ++ai)
#pragma unroll
            for (int m = 0; m < 4; ++m) { const int r = row0 + ai * HALF + m * 16; const float gt = rowgate[r]; bf16* rowp = YB + (size_t)r * DM + col0;
#pragma unroll
                for (int bj = 0; bj < 2; ++bj) { const f32x4 v0 = (acc[ai][bj][m][0] + bv[bj][0]) * gt, v1 = (acc[ai][bj][m][1] + bv[bj][1]) * gt;
                    u32x4 w; w.x = pk2(v0[0], v0[1]); w.y = pk2(v0[2], v0[3]); w.z = pk2(v1[0], v1[1]); w.w = pk2(v1[2], v1[3]);
                    *(u32x4*)(rowp + bj * HALF) = w; } }
    }
};
struct EpiPg {
    static constexpr bool PERM = false;
    const float* H2; const bf16* PE; const float* rs3; const float* rspe; const float* gpost; float* H3; float* ssq;
    __device__ __forceinline__ void operator()(AccRef acc, const Unit& u, int wr, int wc, int fr, int fq) const {
        const int row0 = u.pm * BM + wr * 64 + fr, col0 = u.pn * BM + wc * 32 + 4 * fq;
#pragma unroll
        for (int ai = 0; ai < 2; ++ai)
#pragma unroll
            for (int m = 0; m < 4; ++m) { const int r = row0 + ai * HALF + m * 16; const size_t off = (size_t)r * DM + col0; const float s3 = rs3[r], sp = rspe[r]; float ss = 0.f;
#pragma unroll
                for (int bj = 0; bj < 2; ++bj)
#pragma unroll
                    for (int n = 0; n < 2; ++n) { const size_t o = off + bj * HALF + n * 16; const f32x4 a = acc[ai][bj][m][n] * s3; const f32x4 gp = *(const f32x4*)(gpost + col0 + bj * HALF + n * 16);
                        const u32x2 pw = *(const u32x2*)(PE + o); const f32x4 h2 = *(const f32x4*)(H2 + o);
                        f32x4 h; h[0] = h2[0] + sigm(a[0]) * (bflo(pw.x) * sp * gp[0]); h[1] = h2[1] + sigm(a[1]) * (bfhi(pw.x) * sp * gp[1]);
                        h[2] = h2[2] + sigm(a[2]) * (bflo(pw.y) * sp * gp[2]); h[3] = h2[3] + sigm(a[3]) * (bfhi(pw.y) * sp * gp[3]);
                        *(f32x4*)(H3 + o) = h; ss += (h[0] * h[0] + h[1] * h[1]) + (h[2] * h[2] + h[3] * h[3]); }
                ss += __shfl_xor(ss, 16); ss += __shfl_xor(ss, 32);
                if (fq == 0) ssq[(size_t)r * 32 + u.pn * 4 + wc] = ss; }
    }
};
}

__device__ __forceinline__ bf16x8 frag(const LAS bf16* base, int row0, int ld, int k0, int lane) {
    return *(const LAS bf16x8*)(base + (row0 + (lane & 15)) * ld + k0 + 8 * (lane >> 4));
}
#define MMA16(a, b, c) __builtin_amdgcn_mfma_f32_16x16x32_bf16(a, b, c, 0, 0, 0)

struct Args { const float* in[24]; float* out; unsigned char* ws; int ph_lo, ph_hi, aux, pad; };
__device__ __forceinline__ const float* argin(const Args& a, int k) { asm volatile("" : "+s"(k)); return a.in[k]; }

__device__ __forceinline__ void tr_tile(const float* W, int ldn, int c0, int k0, const float* g, bf16* WT, int K, int d0, int mode, LAS float* scr, int lane) {
#pragma unroll 8
    for (int i = 0; i < 64; ++i) { float v = W[(size_t)(k0 + i) * ldn + c0 + lane]; if (g) v *= g[k0 + i]; scr[i * 65 + lane] = v; }
    LDS_WAIT();
    const int c = lane & 7;
#pragma unroll
    for (int it = 0; it < 8; ++it) { const int j = (lane >> 3) + 8 * it; const LAS float* s = scr + (8 * c) * 65 + j;
        u32x4 o; o.x = pk2(s[0], s[65]); o.y = pk2(s[2 * 65], s[3 * 65]); o.z = pk2(s[4 * 65], s[5 * 65]); o.w = pk2(s[6 * 65], s[7 * 65]);
        int dr; if (mode == 0) dr = d0 + j; else { const int jj = (c0 + j) >> 1; dr = 256 * (jj >> 7) + (jj & 127) + 128 * (j & 1); }
        *(u32x4*)(WT + (size_t)dr * K + k0 + 8 * c) = o; }
    LDS_WAIT();
}
__device__ __forceinline__ int win_src_col(int n) { return n < 3072 ? n : (n < 6144 ? n + 16 : n + 24); }

__device__ __forceinline__ void p0_weights(const Args& a, LAS unsigned char* lds, int gw, int NGW, int wave, int lane) {
    LAS float* scr = (LAS float*)(lds + wave * 16640);
    unsigned char* ws = a.ws;
    constexpr int I_WIN = 112 * 32, I_WOUT = 32 * 32, I_WPG = 32 * 32, I_WPP = 32 * 4, I_WGU = 32 * 64 * 32, I_WDN = 32 * 32 * 32;
    constexpr int NITEMS = I_WIN + I_WOUT + I_WPG + I_WPP + I_WGU + I_WDN;
    for (int it = gw; it < NITEMS; it += NGW) {
        int r = it;
        if (r < I_WIN) { const int nb = r >> 5, kb = r & 31; tr_tile(argin(a, 3), DIN, win_src_col(64 * nb), 64 * kb, argin(a, 2), (bf16*)(ws + WS_WIN), DM, 64 * nb, 0, scr, lane); continue; } r -= I_WIN;
        if (r < I_WOUT) { const int nb = r >> 5, kb = r & 31; tr_tile(argin(a, 11), DM, 64 * nb, 64 * kb, nullptr, (bf16*)(ws + WS_WOUT), DM, 64 * nb, 0, scr, lane); continue; } r -= I_WOUT;
        if (r < I_WPG) { const int nb = r >> 5, kb = r & 31; tr_tile(argin(a, 20), DM, 64 * nb, 64 * kb, argin(a, 19), (bf16*)(ws + WS_WPG), DM, 64 * nb, 0, scr, lane); continue; } r -= I_WPG;
        if (r < I_WPP) { const int nb = r >> 2, kb = r & 3; tr_tile(argin(a, 21), DM, 64 * nb, 64 * kb, nullptr, (bf16*)(ws + WS_WPP), PLE, 64 * nb, 0, scr, lane); continue; } r -= I_WPP;
        if (r < I_WGU) { const int e = r >> 11, nb = (r >> 5) & 63, kb = r & 31;
            tr_tile(argin(a, 15) + (size_t)e * DM * 4096, 4096, 64 * nb, 64 * kb, argin(a, 12), (bf16*)(ws + WS_WGU) + (size_t)e * 4096 * DM, DM, 0, 1, scr, lane); continue; } r -= I_WGU;
        { const int e = r >> 10, nb = (r >> 5) & 31, kb = r & 31;
            tr_tile(argin(a, 17) + (size_t)e * DM * DM, DM, 64 * nb, 64 * kb, nullptr, (bf16*)(ws + WS_WDN) + (size_t)e * DM * DM, DM, 64 * nb, 0, scr, lane); }
    }
}

__device__ __forceinline__ void xgate_unit(const Args& a, int u, LAS unsigned char* lds, int tid) {
    asm volatile("" : "+v"(tid));
    unsigned char* sm = a.ws + WS_SMALL;
    const float* x = argin(a, 0); const float* w_in = argin(a, 3); const float* g_mix = argin(a, 2);
    bf16* xb = (bf16*)(a.ws + WS_XB);
    LAS float* Wg = (LAS float*)lds;
    LAS float* Gs = (LAS float*)(lds + 24576);
    LAS float* gl = (LAS float*)(lds + 24576 + 6144);
    LAS float* il = (LAS float*)(lds + 24576 + 6144 + 3072);
    const int rp = tid >> 4, kp = tid & 15, t0 = u * 64;
    float acc0[24], acc1[24]; float ss0 = 0.f, ss1 = 0.f;
#pragma unroll
    for (int c = 0; c < 24; ++c) { acc0[c] = 0.f; acc1[c] = 0.f; }
    const float* xr0 = x + (size_t)(t0 + 2 * rp) * DM; const float* xr1 = xr0 + DM;
    bf16* xo0 = xb + (size_t)(t0 + 2 * rp) * DM; bf16* xo1 = xo0 + DM;
    for (int kc = 0; kc < 8; ++kc) {
        __syncthreads();
        for (int i = 0; i < 12; ++i) { const int idx = tid + 512 * i; const int k = idx / 24, c = idx - k * 24; const int col = c < 16 ? 3072 + c : 6160 + (c - 16); const int kk = kc * 256 + k;
            Wg[idx] = w_in[(size_t)kk * DIN + col] * g_mix[kk]; }
        __syncthreads();
#pragma unroll 1
        for (int j = 0; j < 4; ++j) { const int k4 = 64 * j + 4 * kp; const f32x4 xa = *(const f32x4*)(xr0 + kc * 256 + k4), xc = *(const f32x4*)(xr1 + kc * 256 + k4);
            ss0 += (xa[0] * xa[0] + xa[1] * xa[1]) + (xa[2] * xa[2] + xa[3] * xa[3]); ss1 += (xc[0] * xc[0] + xc[1] * xc[1]) + (xc[2] * xc[2] + xc[3] * xc[3]);
            u32x2 w0; w0.x = pk2(xa[0], xa[1]); w0.y = pk2(xa[2], xa[3]); *(u32x2*)(xo0 + kc * 256 + k4) = w0;
            u32x2 w1; w1.x = pk2(xc[0], xc[1]); w1.y = pk2(xc[2], xc[3]); *(u32x2*)(xo1 + kc * 256 + k4) = w1;
#pragma unroll
            for (int q = 0; q < 4; ++q) { const LAS f32x4* wr = (const LAS f32x4*)(Wg + (k4 + q) * 24);
#pragma unroll
                for (int c4 = 0; c4 < 6; ++c4) { const f32x4 w = wr[c4];
#pragma unroll
                    for (int e = 0; e < 4; ++e) { acc0[4 * c4 + e] += xa[q] * w[e]; acc1[4 * c4 + e] += xc[q] * w[e]; } } } }
    }
#pragma unroll
    for (int o = 1; o < 16; o <<= 1) {
#pragma unroll
        for (int c = 0; c < 24; ++c) { acc0[c] += __shfl_xor(acc0[c], o); acc1[c] += __shfl_xor(acc1[c], o); }
        ss0 += __shfl_xor(ss0, o); ss1 += __shfl_xor(ss1, o); }
    if (kp == 0) { const float r0 = rsqrtf(ss0 * (1.f / DM) + EPS), r1 = rsqrtf(ss1 * (1.f / DM) + EPS);
        float* rs1 = (float*)(sm + SM_RS1); rs1[t0 + 2 * rp] = r0; rs1[t0 + 2 * rp + 1] = r1;
#pragma unroll
        for (int c = 0; c < 24; ++c) { Gs[(2 * rp) * 24 + c] = acc0[c] * r0; Gs[(2 * rp + 1) * 24 + c] = acc1[c] * r1; } }
    __syncthreads();
    if (tid < 64) { const int l = tid, t = t0 + l; float* BETA = (float*)(sm + SM_BETA); float* IC = (float*)(sm + SM_IC);
        const float* a_log = argin(a, 5); const float* dt_b = argin(a, 6); const float* b_i = argin(a, 8); const float* b_f = argin(a, 9);
        for (int h = 0; h < 8; ++h) { const float av = Gs[l * 24 + h]; gl[l * 12 + h] = -expf(a_log[h]) * softplusf(av + dt_b[h]); BETA[t * 8 + h] = 1.f / (1.f + expf(-Gs[l * 24 + 8 + h])); }
        for (int h = 0; h < 4; ++h) { const float ip = 15.f * tanhf((Gs[l * 24 + 16 + h] + b_i[h]) * (1.f / 15.f)); il[l * 4 + h] = ip; IC[t * 4 + h] = ip;
            const float fp = 15.f * tanhf((Gs[l * 24 + 20 + h] + b_f[h]) * (1.f / 15.f)); gl[l * 12 + 8 + h] = -softplusf(-fp); } }
    __syncthreads();
    if (tid < 12) { const int j = tid; float s = 0.f; float* GC = (float*)(sm + SM_GC); float* FC = (float*)(sm + SM_FC);
        for (int l = 0; l < 64; ++l) { s += gl[l * 12 + j]; gl[l * 12 + j] = s; if (j < 8) GC[(t0 + l) * 8 + j] = s; else FC[(t0 + l) * 4 + (j - 8)] = s; }
        if (j >= 8) { const int h = j - 8; float am = -INFINITY; for (int l = 0; l < 64; ++l) am = fmaxf(am, s - gl[l * 12 + j] + il[l * 4 + h]);
            ((float*)(sm + SM_FLAST))[u * 4 + h] = s; ((float*)(sm + SM_AMAX))[u * 4 + h] = am; } }
    __syncthreads();
}

__device__ __forceinline__ void gdn_prep_unit(const Args& a, int ug, LAS unsigned char* lds, int tid, int wid, int lane) {
    asm volatile("" : "+v"(tid), "+v"(lane));
    unsigned char* ws = a.ws; unsigned char* sm = ws + WS_SMALL;
    const bf16* Z = (const bf16*)(ws + WS_Z); const float* conv_w = argin(a, 4);
    LAS bf16* Qs = (LAS bf16*)lds; LAS bf16* Ks = (LAS bf16*)(lds + 17408); LAS bf16* KBGt = (LAS bf16*)(lds + 34816); LAS bf16* VBt = (LAS bf16*)(lds + 53248); LAS bf16* KDt = (LAS bf16*)(lds + 71680);
    LAS float* Mm = (LAS float*)(lds + 90112); LAS bf16* Ti = (LAS bf16*)(lds + 107520); LAS float* gcs = (LAS float*)(lds + 116736); LAS float* bts = (LAS float*)(lds + 116992);
    const int b = ug >> 9, h = (ug >> 6) & 7, c = ug & 63, t0 = b * SEQL + c * 64;
    const int l = tid >> 3, cg = tid & 7;
    const float gcl = ((const float*)(sm + SM_GC))[(t0 + l) * 8 + h], btl = ((const float*)(sm + SM_BETA))[(t0 + l) * 8 + h], gclast = ((const float*)(sm + SM_GC))[(t0 + 63) * 8 + h];
    {
        float qkv[3][16];
#pragma unroll
        for (int tz = 0; tz < 3; ++tz) { const int colz = tz * 1024 + h * 128 + cg * 16;
#pragma unroll
            for (int i = 0; i < 16; ++i) qkv[tz][i] = 0.f;
#pragma unroll
            for (int j = 0; j < 4; ++j) { const int pos = c * 64 + l - 3 + j;
                if (pos >= 0) { const bf16* zr = Z + (size_t)(b * SEQL + pos) * NZ + colz; const u32x4 w0 = *(const u32x4*)zr, w1 = *(const u32x4*)(zr + 8); const float* cw = conv_w + j * 3072 + colz;
                    const f32x4 c0 = *(const f32x4*)cw, c1 = *(const f32x4*)(cw + 4), c2 = *(const f32x4*)(cw + 8), c3 = *(const f32x4*)(cw + 12);
                    qkv[tz][0] += c0[0] * bflo(w0.x); qkv[tz][1] += c0[1] * bfhi(w0.x); qkv[tz][2] += c0[2] * bflo(w0.y); qkv[tz][3] += c0[3] * bfhi(w0.y);
                    qkv[tz][4] += c1[0] * bflo(w0.z); qkv[tz][5] += c1[1] * bfhi(w0.z); qkv[tz][6] += c1[2] * bflo(w0.w); qkv[tz][7] += c1[3] * bfhi(w0.w);
                    qkv[tz][8] += c2[0] * bflo(w1.x); qkv[tz][9] += c2[1] * bfhi(w1.x); qkv[tz][10] += c2[2] * bflo(w1.y); qkv[tz][11] += c2[3] * bfhi(w1.y);
                    qkv[tz][12] += c3[0] * bflo(w1.z); qkv[tz][13] += c3[1] * bfhi(w1.z); qkv[tz][14] += c3[2] * bflo(w1.w); qkv[tz][15] += c3[3] * bfhi(w1.w); } }
#pragma unroll
            for (int i = 0; i < 16; ++i) { const float v = qkv[tz][i]; qkv[tz][i] = v / (1.f + __expf(-v)); } }
        float sq = 0.f, sk = 0.f;
#pragma unroll
        for (int i = 0; i < 16; ++i) { sq += qkv[0][i] * qkv[0][i]; sk += qkv[1][i] * qkv[1][i]; }
#pragma unroll
        for (int o = 1; o < 8; o <<= 1) { sq += __shfl_xor(sq, o); sk += __shfl_xor(sk, o); }
        const float rq = rsqrtf(sq + EPS) * 0.08838834764831845f, rk = rsqrtf(sk + EPS);
        const float eg = expf(gcl), ekd = expf(gclast - gcl);
        unsigned qw[8], kw[8], qdw[8];
#pragma unroll
        for (int i = 0; i < 8; ++i) { const float q0 = qkv[0][2 * i] * rq, q1 = qkv[0][2 * i + 1] * rq, k0 = qkv[1][2 * i] * rk, k1 = qkv[1][2 * i + 1] * rk;
            qw[i] = pk2(q0, q1); kw[i] = pk2(k0, k1); qdw[i] = pk2(q0 * eg, q1 * eg);
            const int d = cg * 16 + 2 * i;
            KBGt[d * 72 + l] = f2bf(k0 * btl * eg); KBGt[(d + 1) * 72 + l] = f2bf(k1 * btl * eg);
            KDt[d * 72 + l] = f2bf(k0 * ekd); KDt[(d + 1) * 72 + l] = f2bf(k1 * ekd);
            VBt[d * 72 + l] = f2bf(qkv[2][2 * i] * btl); VBt[(d + 1) * 72 + l] = f2bf(qkv[2][2 * i + 1] * btl); }
        *(LAS u32x4*)(Qs + l * 136 + cg * 16) = (u32x4){qw[0], qw[1], qw[2], qw[3]}; *(LAS u32x4*)(Qs + l * 136 + cg * 16 + 8) = (u32x4){qw[4], qw[5], qw[6], qw[7]};
        *(LAS u32x4*)(Ks + l * 136 + cg * 16) = (u32x4){kw[0], kw[1], kw[2], kw[3]}; *(LAS u32x4*)(Ks + l * 136 + cg * 16 + 8) = (u32x4){kw[4], kw[5], kw[6], kw[7]};
        bf16* qd = (bf16*)(ws + WS_GQD) + (size_t)ug * 8192 + l * 128 + cg * 16;
        *(u32x4*)qd = (u32x4){qdw[0], qdw[1], qdw[2], qdw[3]}; *(u32x4*)(qd + 8) = (u32x4){qdw[4], qdw[5], qdw[6], qdw[7]};
        if (cg == 0) { gcs[l] = gcl; bts[l] = btl; }
    }
    __syncthreads();
    {
        const int wv = wid & 3; const bool isQ = wid >= 4; const LAS bf16* Ab = isQ ? Qs : Ks;
        f32x4 acc[4];
#pragma unroll
        for (int n = 0; n < 4; ++n) acc[n] = (f32x4){0.f, 0.f, 0.f, 0.f};
#pragma unroll
        for (int ks = 0; ks < 4; ++ks) { const bf16x8 af = frag(Ab, 16 * wv, 136, 32 * ks, lane);
#pragma unroll
            for (int n = 0; n < 4; ++n) acc[n] = MMA16(af, frag(Ks, 16 * n, 136, 32 * ks, lane), acc[n]); }
        bf16* AT = (bf16*)(ws + WS_GAT) + (size_t)ug * 4096;
#pragma unroll
        for (int n = 0; n < 4; ++n)
#pragma unroll
            for (int rg = 0; rg < 4; ++rg) { const int i = 16 * wv + 4 * (lane >> 4) + rg, j = 16 * n + (lane & 15);
                const float dec = (j <= i) ? expf(gcs[i] - gcs[j]) : 0.f;
                if (!isQ) Mm[i * 68 + j] = (j < i) ? bts[i] * acc[n][rg] * dec : 0.f;
                else AT[i * 64 + j] = f2bf(acc[n][rg] * dec); }
    }
    __syncthreads();
    if (wid == 0) {
        float Xc[64];
        unsigned mb = (unsigned)(size_t)Mm, ml = (unsigned)(size_t)(Mm + lane), tb2 = (unsigned)(size_t)(Ti + lane);
        asm volatile("" : "+v"(mb), "+v"(ml), "+v"(tb2));
#pragma unroll
        for (int i = 0; i < 64; ++i) { float s = -*(const LAS float*)(size_t)(ml + (unsigned)(i * 68 * 4));
#pragma unroll
            for (int j4 = 0; j4 < (i + 3) / 4; ++j4) { const f32x4 mv = *(const LAS f32x4*)(size_t)(mb + (unsigned)((i * 68 + 4 * j4) * 4));
#pragma unroll
                for (int q = 0; q < 4; ++q) if (4 * j4 + q < i) s -= mv[q] * Xc[4 * j4 + q]; }
            Xc[i] = s; asm volatile("" ::: "memory"); }
#pragma unroll
        for (int i = 0; i < 64; ++i) *(LAS bf16*)(size_t)(tb2 + (unsigned)(i * 72 * 2)) = f2bf(Xc[i]);
        LDS_WAIT();
        Ti[lane * 72 + lane] = (bf16)0x3f80;
    } else {
        bf16* KD = (bf16*)(ws + WS_GKDT) + (size_t)ug * 8192;
        for (int p = tid - 64; p < 1024; p += 448) { const int row = p >> 3, seg = p & 7; *(u32x4*)(KD + row * 64 + seg * 8) = *(const LAS u32x4*)(KDt + row * 72 + seg * 8); }
    }
    __syncthreads();
    {
        const int wv = wid & 3; const LAS bf16* Bb = wid < 4 ? VBt : KBGt;
        f32x4 acc[8];
#pragma unroll
        for (int n = 0; n < 8; ++n) acc[n] = (f32x4){0.f, 0.f, 0.f, 0.f};
#pragma unroll
        for (int ks = 0; ks < 2; ++ks) { const bf16x8 af = frag(Ti, 16 * wv, 72, 32 * ks, lane);
#pragma unroll
            for (int n = 0; n < 8; ++n) acc[n] = MMA16(af, frag(Bb, 16 * n, 72, 32 * ks, lane), acc[n]); }
        float* U = (float*)(ws + WS_GU) + (size_t)ug * 8192; bf16* W = (bf16*)(ws + WS_GW) + (size_t)ug * 8192;
#pragma unroll
        for (int n = 0; n < 8; ++n)
#pragma unroll
            for (int rg = 0; rg < 4; ++rg) { const int i = 16 * wv + 4 * (lane >> 4) + rg, e = 16 * n + (lane & 15);
                if (wid < 4) U[i * 128 + e] = acc[n][rg]; else W[i * 128 + e] = f2bf(acc[n][rg]); }
        if (tid == 0) ((float*)(sm + SM_GLAST))[ug] = expf(gcs[63]);
    }
    __syncthreads();
}

__device__ __forceinline__ void ml_prep_unit(const Args& a, int um, LAS unsigned char* lds, int tid, int wid, int lane) {
    asm volatile("" : "+v"(tid), "+v"(lane));
    unsigned char* ws = a.ws; unsigned char* sm = ws + WS_SMALL;
    const bf16* Z = (const bf16*)(ws + WS_Z);
    LAS bf16* Qs = (LAS bf16*)lds; LAS bf16* Ks = (LAS bf16*)(lds + 17408); LAS bf16* VTs = (LAS bf16*)(lds + 34816); LAS bf16* KWTs = (LAS bf16*)(lds + 71680);
    LAS float* FL = (LAS float*)(lds + 90112); LAS float* AM = FL + 64; LAS float* fcs = FL + 128; LAS float* ics = FL + 192; LAS float* mis = FL + 256; LAS float* wks = FL + 320; LAS float* scal = FL + 384;
    const int b = um >> 8, h = (um >> 6) & 3, c = um & 63, t0 = b * SEQL + c * 64;
    const int l = tid >> 3, cg = tid & 7;
    {
        const bf16* zr = Z + (size_t)(t0 + l) * NZ;
        const u32x4 q0 = *(const u32x4*)(zr + ZMQ + h * 128 + cg * 16), q1 = *(const u32x4*)(zr + ZMQ + h * 128 + cg * 16 + 8);
        *(LAS u32x4*)(Qs + l * 136 + cg * 16) = q0; *(LAS u32x4*)(Qs + l * 136 + cg * 16 + 8) = q1;
        const u32x4 k0 = *(const u32x4*)(zr + ZMK + h * 128 + cg * 16), k1 = *(const u32x4*)(zr + ZMK + h * 128 + cg * 16 + 8);
        const float sc = 0.08838834764831845f;
        u32x4 ko0, ko1;
        ko0.x = pk2(bflo(k0.x) * sc, bfhi(k0.x) * sc); ko0.y = pk2(bflo(k0.y) * sc, bfhi(k0.y) * sc); ko0.z = pk2(bflo(k0.z) * sc, bfhi(k0.z) * sc); ko0.w = pk2(bflo(k0.w) * sc, bfhi(k0.w) * sc);
        ko1.x = pk2(bflo(k1.x) * sc, bfhi(k1.x) * sc); ko1.y = pk2(bflo(k1.y) * sc, bfhi(k1.y) * sc); ko1.z = pk2(bflo(k1.z) * sc, bfhi(k1.z) * sc); ko1.w = pk2(bflo(k1.w) * sc, bfhi(k1.w) * sc);
        *(LAS u32x4*)(Ks + l * 136 + cg * 16) = ko0; *(LAS u32x4*)(Ks + l * 136 + cg * 16 + 8) = ko1;
#pragma unroll
        for (int s4 = 0; s4 < 4; ++s4) { const u32x4 v = *(const u32x4*)(zr + ZMV + h * 256 + cg * 32 + s4 * 8); const int e0 = cg * 32 + s4 * 8;
            VTs[(e0 + 0) * 72 + l] = (bf16)(v.x & 0xffffu); VTs[(e0 + 1) * 72 + l] = (bf16)(v.x >> 16); VTs[(e0 + 2) * 72 + l] = (bf16)(v.y & 0xffffu); VTs[(e0 + 3) * 72 + l] = (bf16)(v.y >> 16);
            VTs[(e0 + 4) * 72 + l] = (bf16)(v.z & 0xffffu); VTs[(e0 + 5) * 72 + l] = (bf16)(v.z >> 16); VTs[(e0 + 6) * 72 + l] = (bf16)(v.w & 0xffffu); VTs[(e0 + 7) * 72 + l] = (bf16)(v.w >> 16); }
        if (tid < 64) { FL[tid] = ((const float*)(sm + SM_FLAST))[(b * 64 + tid) * 4 + h]; AM[tid] = ((const float*)(sm + SM_AMAX))[(b * 64 + tid) * 4 + h];
            fcs[tid] = ((const float*)(sm + SM_FC))[(t0 + tid) * 4 + h]; ics[tid] = ((const float*)(sm + SM_IC))[(t0 + tid) * 4 + h]; }
    }
    __syncthreads();
    if (tid == 0) { float m = 0.f; for (int j = 0; j < c; ++j) m = fmaxf(FL[j] + m, AM[j]); const float mn = fmaxf(FL[c] + m, AM[c]); const float dec = expf(FL[c] + m - mn);
        scal[0] = m; scal[1] = mn; scal[2] = dec; ((float*)(sm + SM_MDEC))[um] = dec; }
    __syncthreads();
    if (tid < 64) { const float mst = scal[0], mn = scal[1]; float pm = -INFINITY; for (int j = 0; j <= tid; ++j) pm = fmaxf(pm, ics[j] - fcs[j]);
        const float inter = fcs[tid] + mst, mi = fmaxf(fcs[tid] + pm, inter); mis[tid] = mi;
        ((float*)(sm + SM_MSI))[um * 64 + tid] = expf(inter - mi); ((float*)(sm + SM_MEN))[um * 64 + tid] = expf(-mi); wks[tid] = expf(FL[c] - fcs[tid] + ics[tid] - mn); }
    __syncthreads();
    if (wid < 4) {
        f32x4 acc[4];
#pragma unroll
        for (int n = 0; n < 4; ++n) acc[n] = (f32x4){0.f, 0.f, 0.f, 0.f};
#pragma unroll
        for (int ks = 0; ks < 4; ++ks) { const bf16x8 af = frag(Qs, 16 * wid, 136, 32 * ks, lane);
#pragma unroll
            for (int n = 0; n < 4; ++n) acc[n] = MMA16(af, frag(Ks, 16 * n, 136, 32 * ks, lane), acc[n]); }
        bf16* WT = (bf16*)(ws + WS_MWT) + (size_t)um * 4096; float rsum[4] = {0.f, 0.f, 0.f, 0.f};
#pragma unroll
        for (int n = 0; n < 4; ++n)
#pragma unroll
            for (int rg = 0; rg < 4; ++rg) { const int i = 16 * wid + 4 * (lane >> 4) + rg, j = 16 * n + (lane & 15);
                const float wv = (j <= i) ? expf(fcs[i] - fcs[j] + ics[j] - mis[i]) * acc[n][rg] : 0.f; rsum[rg] += wv; WT[i * 64 + j] = f2bf(wv); }
#pragma unroll
        for (int rg = 0; rg < 4; ++rg) { float s = rsum[rg];
#pragma unroll
            for (int o = 1; o < 16; o <<= 1) s += __shfl_xor(s, o);
            if ((lane & 15) == 0) ((float*)(sm + SM_MWS))[um * 64 + 16 * wid + 4 * (lane >> 4) + rg] = s; }
    } else {
        const int t2 = tid - 256, l2 = t2 >> 2, part = t2 & 3; const float wk = wks[l2];
#pragma unroll 8
        for (int i = 0; i < 32; ++i) { const int d = part * 32 + i; KWTs[d * 72 + l2] = f2bf(wk * bf2f(Ks[l2 * 136 + d])); }
    }
    __syncthreads();
    {
        bf16* KW = (bf16*)(ws + WS_MKWT) + (size_t)um * 8192; bf16* VT = (bf16*)(ws + WS_MVT) + (size_t)um * 16384;
        for (int p = tid; p < 1024; p += 512) { const int row = p >> 3, seg = p & 7; *(u32x4*)(KW + row * 64 + seg * 8) = *(const LAS u32x4*)(KWTs + row * 72 + seg * 8); }
        for (int p = tid; p < 2048; p += 512) { const int row = p >> 3, seg = p & 7; *(u32x4*)(VT + row * 64 + seg * 8) = *(const LAS u32x4*)(VTs + row * 72 + seg * 8); }
    }
    __syncthreads();
}

__device__ __forceinline__ void gdn_scan_item(const Args& a, int item, LAS unsigned char* lds, int tid, int wid, int lane) {
    asm volatile("" : "+v"(tid), "+v"(lane));
    unsigned char* ws = a.ws; unsigned char* sm = ws + WS_SMALL;
    LAS bf16* Ws = (LAS bf16*)lds; LAS bf16* QDs = (LAS bf16*)(lds + 17408); LAS bf16* ATs = (LAS bf16*)(lds + 34816); LAS bf16* KDTs = (LAS bf16*)(lds + 44032);
    LAS bf16* STs = (LAS bf16*)(lds + 62464); LAS bf16* VNt = (LAS bf16*)(lds + 79872);
    const int b = item >> 5, h = (item >> 2) & 7, es = item & 3;
    const int ug0 = (b * 8 + h) * 64, tb = b * SEQL;
    const bf16* Wg = (const bf16*)(ws + WS_GW) + (size_t)ug0 * 8192; const bf16* QDg = (const bf16*)(ws + WS_GQD) + (size_t)ug0 * 8192;
    const bf16* KDg = (const bf16*)(ws + WS_GKDT) + (size_t)ug0 * 8192; const bf16* ATg = (const bf16*)(ws + WS_GAT) + (size_t)ug0 * 4096;
    const float* Ug = (const float*)(ws + WS_GU) + (size_t)ug0 * 8192; const float* GL = (const float*)(sm + SM_GLAST) + ug0;
    float* OSC = (float*)(ws + WS_OSC);
    const int et = wid & 1, lt = wid >> 1;
    const int p0 = tid, p1 = tid + 512;
    const int r0 = p0 >> 4, s0 = p0 & 15, r1 = p1 >> 4, s1 = p1 & 15;
    const int ra = p0 >> 3, sa = p0 & 7, rb = p1 >> 3;
    const int uoff = (16 * lt + (lane & 15)) * 128 + es * 32 + 16 * et + 4 * (lane >> 4);
    f32x4 S[2] = {(f32x4){0.f, 0.f, 0.f, 0.f}, (f32x4){0.f, 0.f, 0.f, 0.f}};
    for (int i = tid; i < 32 * 136; i += 512) STs[i] = 0;
    u32x4 pw0, pw1, pq0, pq1, pa, pk0, pk1; f32x4 un; float gln;
#define GDN_LOAD(c) do { pw0 = *(const u32x4*)(Wg + (size_t)(c) * 8192 + r0 * 128 + s0 * 8); pw1 = *(const u32x4*)(Wg + (size_t)(c) * 8192 + r1 * 128 + s1 * 8); \
        pq0 = *(const u32x4*)(QDg + (size_t)(c) * 8192 + r0 * 128 + s0 * 8); pq1 = *(const u32x4*)(QDg + (size_t)(c) * 8192 + r1 * 128 + s1 * 8); \
        pa = *(const u32x4*)(ATg + (size_t)(c) * 4096 + ra * 64 + sa * 8); \
        pk0 = *(const u32x4*)(KDg + (size_t)(c) * 8192 + ra * 64 + sa * 8); pk1 = *(const u32x4*)(KDg + (size_t)(c) * 8192 + rb * 64 + sa * 8); \
        un = *(const f32x4*)(Ug + (size_t)(c) * 8192 + uoff); gln = GL[c]; } while (0)
#define GDN_PUT() do { *(LAS u32x4*)(Ws + r0 * 136 + s0 * 8) = pw0; *(LAS u32x4*)(Ws + r1 * 136 + s1 * 8) = pw1; *(LAS u32x4*)(QDs + r0 * 136 + s0 * 8) = pq0; *(LAS u32x4*)(QDs + r1 * 136 + s1 * 8) = pq1; \
        *(LAS u32x4*)(ATs + ra * 72 + sa * 8) = pa; *(LAS u32x4*)(KDTs + ra * 72 + sa * 8) = pk0; *(LAS u32x4*)(KDTs + rb * 72 + sa * 8) = pk1; } while (0)
    GDN_LOAD(0); GDN_PUT();
    f32x4 ucur = un; float gl = gln; int cur = 0;
    __syncthreads();
    for (int c = 0; c < 64; ++c) {
        if (c < 63) GDN_LOAD(c + 1);
        const LAS bf16* STc = STs + cur * (32 * 136); LAS bf16* STn = STs + (cur ^ 1) * (32 * 136);
        {
            f32x4 P = (f32x4){0.f, 0.f, 0.f, 0.f};
#pragma unroll
            for (int ks = 0; ks < 4; ++ks) P = MMA16(frag(STc, 16 * et, 136, 32 * ks, lane), frag(Ws, 16 * lt, 136, 32 * ks, lane), P);
#pragma unroll
            for (int rg = 0; rg < 4; ++rg) VNt[(16 * et + 4 * (lane >> 4) + rg) * 72 + 16 * lt + (lane & 15)] = f2bf(ucur[rg] - P[rg]);
        }
        __syncthreads();
        {
            f32x4 O = (f32x4){0.f, 0.f, 0.f, 0.f};
#pragma unroll
            for (int ks = 0; ks < 4; ++ks) O = MMA16(frag(QDs, 16 * lt, 136, 32 * ks, lane), frag(STc, 16 * et, 136, 32 * ks, lane), O);
#pragma unroll
            for (int ks = 0; ks < 2; ++ks) O = MMA16(frag(ATs, 16 * lt, 72, 32 * ks, lane), frag(VNt, 16 * et, 72, 32 * ks, lane), O);
            float* op = OSC + (size_t)(tb + c * 64 + 16 * lt + 4 * (lane >> 4)) * DM + h * 128 + es * 32 + 16 * et + (lane & 15);
#pragma unroll
            for (int rg = 0; rg < 4; ++rg) op[(size_t)rg * DM] = O[rg];
        }
#pragma unroll
        for (int e2 = 0; e2 < 2; ++e2) {
            S[e2] = S[e2] * gl;
#pragma unroll
            for (int ks = 0; ks < 2; ++ks) S[e2] = MMA16(frag(VNt, 16 * e2, 72, 32 * ks, lane), frag(KDTs, 16 * wid, 72, 32 * ks, lane), S[e2]);
#pragma unroll
            for (int rg = 0; rg < 4; ++rg) STn[(16 * e2 + 4 * (lane >> 4) + rg) * 136 + 16 * wid + (lane & 15)] = f2bf(S[e2][rg]);
        }
        __syncthreads();
        if (c < 63) { GDN_PUT(); ucur = un; gl = gln; }
        __syncthreads();
        cur ^= 1;
    }
#undef GDN_LOAD
#undef GDN_PUT
}

__device__ __forceinline__ void ml_scan_item(const Args& a, int item, LAS unsigned char* lds, int tid, int wid, int lane) {
    asm volatile("" : "+v"(tid), "+v"(lane));
    unsigned char* ws = a.ws; unsigned char* sm = ws + WS_SMALL;
    LAS bf16* Qs = (LAS bf16*)lds; LAS bf16* WTs = (LAS bf16*)(lds + 17408); LAS bf16* KWTs = (LAS bf16*)(lds + 26624); LAS bf16* VTs = (LAS bf16*)(lds + 45056);
    LAS bf16* CTs = (LAS bf16*)(lds + 49664); LAS float* ns = (LAS float*)(lds + 67072); LAS float* sis = (LAS float*)(lds + 67584); LAS float* wss = (LAS float*)(lds + 67840);
    const int b = item >> 5, h = (item >> 3) & 3, es = item & 7;
    const int um0 = (b * 4 + h) * 64, tb = b * SEQL;
    const bf16* Z = (const bf16*)(ws + WS_Z);
    const bf16* WTg = (const bf16*)(ws + WS_MWT) + (size_t)um0 * 4096; const bf16* KWg = (const bf16*)(ws + WS_MKWT) + (size_t)um0 * 8192; const bf16* VTg = (const bf16*)(ws + WS_MVT) + (size_t)um0 * 16384 + es * 32 * 64;
    const float* SI = (const float*)(sm + SM_MSI) + um0 * 64; const float* WSg = (const float*)(sm + SM_MWS) + um0 * 64; const float* DEC = (const float*)(sm + SM_MDEC) + um0;
    float* OSC = (float*)(ws + WS_OSC); float* DEN = (float*)(sm + SM_DEN);
    const int et = wid & 1, lt = wid >> 1;
    const int p0 = tid, p1 = tid + 512;
    const int r0 = p0 >> 4, s0 = p0 & 15, r1 = p1 >> 4, s1 = p1 & 15;
    const int ra = p0 >> 3, sa = p0 & 7, rb = p1 >> 3;
    f32x4 C[2] = {(f32x4){0.f, 0.f, 0.f, 0.f}, (f32x4){0.f, 0.f, 0.f, 0.f}};
    float nreg = 0.f;
    for (int i = tid; i < 32 * 136; i += 512) CTs[i] = 0;
    if (tid < 128) ns[tid] = 0.f;
    u32x4 pq0, pq1, pw, pk0, pk1, pv; float psi = 0.f, pws = 0.f, decn;
#define ML_LOAD(c) do { pq0 = *(const u32x4*)(Z + (size_t)(tb + (c) * 64 + r0) * NZ + ZMQ + h * 128 + s0 * 8); pq1 = *(const u32x4*)(Z + (size_t)(tb + (c) * 64 + r1) * NZ + ZMQ + h * 128 + s1 * 8); \
        pw = *(const u32x4*)(WTg + (size_t)(c) * 4096 + ra * 64 + sa * 8); pk0 = *(const u32x4*)(KWg + (size_t)(c) * 8192 + ra * 64 + sa * 8); pk1 = *(const u32x4*)(KWg + (size_t)(c) * 8192 + rb * 64 + sa * 8); \
        if (tid < 256) pv = *(const u32x4*)(VTg + (size_t)(c) * 16384 + ra * 64 + sa * 8); if (tid < 64) { psi = SI[(c) * 64 + tid]; pws = WSg[(c) * 64 + tid]; } decn = DEC[c]; } while (0)
#define ML_PUT() do { *(LAS u32x4*)(Qs + r0 * 136 + s0 * 8) = pq0; *(LAS u32x4*)(Qs + r1 * 136 + s1 * 8) = pq1; *(LAS u32x4*)(WTs + ra * 72 + sa * 8) = pw; \
        *(LAS u32x4*)(KWTs + ra * 72 + sa * 8) = pk0; *(LAS u32x4*)(KWTs + rb * 72 + sa * 8) = pk1; if (tid < 256) *(LAS u32x4*)(VTs + ra * 72 + sa * 8) = pv; \
        if (tid < 64) { sis[tid] = psi; wss[tid] = pws; } } while (0)
    ML_LOAD(0); ML_PUT();
    float dec = decn; int cur = 0;
    __syncthreads();
    for (int c = 0; c < 64; ++c) {
        if (c < 63) ML_LOAD(c + 1);
        const LAS bf16* CTc = CTs + cur * (32 * 136); LAS bf16* CTn = CTs + (cur ^ 1) * (32 * 136);
        {
            f32x4 N = (f32x4){0.f, 0.f, 0.f, 0.f};
#pragma unroll
            for (int ks = 0; ks < 4; ++ks) N = MMA16(frag(Qs, 16 * lt, 136, 32 * ks, lane), frag(CTc, 16 * et, 136, 32 * ks, lane), N);
#pragma unroll
            for (int rg = 0; rg < 4; ++rg) N[rg] *= sis[16 * lt + 4 * (lane >> 4) + rg];
#pragma unroll
            for (int ks = 0; ks < 2; ++ks) N = MMA16(frag(WTs, 16 * lt, 72, 32 * ks, lane), frag(VTs, 16 * et, 72, 32 * ks, lane), N);
            float* op = OSC + (size_t)(tb + c * 64 + 16 * lt + 4 * (lane >> 4)) * DM + 1024 + h * 256 + es * 32 + 16 * et + (lane & 15);
#pragma unroll
            for (int rg = 0; rg < 4; ++rg) op[(size_t)rg * DM] = N[rg];
        }
        if (es == 0) {
            const int l = tid >> 3, part = tid & 7; float s = 0.f;
#pragma unroll
            for (int i = 0; i < 16; ++i) s += bf2f(Qs[l * 136 + part * 16 + i]) * ns[part * 16 + i];
#pragma unroll
            for (int o = 1; o < 8; o <<= 1) s += __shfl_xor(s, o);
            if (part == 0) DEN[(size_t)(tb + c * 64 + l) * 4 + h] = sis[l] * s + wss[l];
        }
#pragma unroll
        for (int e2 = 0; e2 < 2; ++e2) {
            C[e2] = C[e2] * dec;
#pragma unroll
            for (int ks = 0; ks < 2; ++ks) C[e2] = MMA16(frag(VTs, 16 * e2, 72, 32 * ks, lane), frag(KWTs, 16 * wid, 72, 32 * ks, lane), C[e2]);
#pragma unroll
            for (int rg = 0; rg < 4; ++rg) CTn[(16 * e2 + 4 * (lane >> 4) + rg) * 136 + 16 * wid + (lane & 15)] = f2bf(C[e2][rg]);
        }
        float nnew = 0.f;
        if (tid < 128) { float s = 0.f;
#pragma unroll
            for (int i = 0; i < 64; ++i) s += bf2f(KWTs[tid * 72 + i]);
            nnew = dec * nreg + s; }
        __syncthreads();
        if (tid < 128) { nreg = nnew; ns[tid] = nnew; }
        if (c < 63) { ML_PUT(); dec = decn; }
        __syncthreads();
        cur ^= 1;
    }
#undef ML_LOAD
#undef ML_PUT
}

__device__ __forceinline__ void router_unit(const Args& a, int u, LAS unsigned char* lds, int tid) {
    asm volatile("" : "+v"(tid));
    unsigned char* ws = a.ws; unsigned char* sm = ws + WS_SMALL;
    const float* H1 = (const float*)(ws + WS_H1); const float* w_r = argin(a, 13); const float* g_ffn = argin(a, 12);
    LAS float* Wg = (LAS float*)lds;
    LAS float* Ls = (LAS float*)(lds + 32768);
    LAS int* sel = (LAS int*)(lds + 32768 + 8448);
    LAS int* rks = (LAS int*)(lds + 32768 + 8448 + 1024);
    const int rp = tid >> 4, kp = tid & 15, t0 = u * 64;
    float acc0[32], acc1[32];
#pragma unroll
    for (int c = 0; c < 32; ++c) { acc0[c] = 0.f; acc1[c] = 0.f; }
    const float* xr0 = H1 + (size_t)(t0 + 2 * rp) * DM; const float* xr1 = xr0 + DM;
    for (int kc = 0; kc < 8; ++kc) {
        __syncthreads();
        for (int i = 0; i < 16; ++i) { const int idx = tid + 512 * i; const int kk = kc * 256 + (idx >> 5); Wg[idx] = w_r[(size_t)kk * 32 + (idx & 31)] * g_ffn[kk]; }
        __syncthreads();
#pragma unroll 1
        for (int j = 0; j < 4; ++j) { const int k4 = 64 * j + 4 * kp; const f32x4 xa = *(const f32x4*)(xr0 + kc * 256 + k4), xc = *(const f32x4*)(xr1 + kc * 256 + k4);
#pragma unroll
            for (int q = 0; q < 4; ++q) { const LAS f32x4* wr = (const LAS f32x4*)(Wg + (k4 + q) * 32);
#pragma unroll
                for (int c4 = 0; c4 < 8; ++c4) { const f32x4 w = wr[c4];
#pragma unroll
                    for (int e = 0; e < 4; ++e) { acc0[4 * c4 + e] += xa[q] * w[e]; acc1[4 * c4 + e] += xc[q] * w[e]; } } } }
    }
    const float* SSQ = (const float*)(sm + SM_SSQ1);
    float ss0 = SSQ[(size_t)(t0 + 2 * rp) * 32 + kp] + SSQ[(size_t)(t0 + 2 * rp) * 32 + 16 + kp], ss1 = SSQ[(size_t)(t0 + 2 * rp + 1) * 32 + kp] + SSQ[(size_t)(t0 + 2 * rp + 1) * 32 + 16 + kp];
#pragma unroll
    for (int o = 1; o < 16; o <<= 1) {
#pragma unroll
        for (int c = 0; c < 32; ++c) { acc0[c] += __shfl_xor(acc0[c], o); acc1[c] += __shfl_xor(acc1[c], o); }
        ss0 += __shfl_xor(ss0, o); ss1 += __shfl_xor(ss1, o); }
    if (kp == 0) { const float r0 = rsqrtf(ss0 * (1.f / DM) + EPS), r1 = rsqrtf(ss1 * (1.f / DM) + EPS); const float* b_r = argin(a, 14);
        float* RS2 = (float*)(sm + SM_RS2); RS2[t0 + 2 * rp] = r0; RS2[t0 + 2 * rp + 1] = r1;
#pragma unroll
        for (int c = 0; c < 32; ++c) { Ls[(2 * rp) * 33 + c] = acc0[c] * r0 + b_r[c]; Ls[(2 * rp + 1) * 33 + c] = acc1[c] * r1 + b_r[c]; } }
    __syncthreads();
    if (tid < 64) { const int l = tid, t = t0 + l; float tv[4]; int ti[4];
        for (int k = 0; k < 4; ++k) { float best = -INFINITY; int bi = 0; for (int c = 0; c < 32; ++c) { const float v = Ls[l * 33 + c]; if (v > best) { best = v; bi = c; } } tv[k] = best; ti[k] = bi; Ls[l * 33 + bi] = -INFINITY; }
        const float e1 = expf(tv[1] - tv[0]), e2 = expf(tv[2] - tv[0]), e3 = expf(tv[3] - tv[0]); const float inv = 1.f / (1.f + e1 + e2 + e3);
        int* TOPI = (int*)(sm + SM_TOPI); float* TOPG = (float*)(sm + SM_TOPG);
        TOPI[t * 4 + 0] = ti[0]; TOPI[t * 4 + 1] = ti[1]; TOPI[t * 4 + 2] = ti[2]; TOPI[t * 4 + 3] = ti[3];
        TOPG[t * 4 + 0] = inv; TOPG[t * 4 + 1] = e1 * inv; TOPG[t * 4 + 2] = e2 * inv; TOPG[t * 4 + 3] = e3 * inv;
        sel[l * 4 + 0] = ti[0]; sel[l * 4 + 1] = ti[1]; sel[l * 4 + 2] = ti[2]; sel[l * 4 + 3] = ti[3]; }
    __syncthreads();
    if (tid < 32) { int cnt = 0; for (int i = 0; i < 256; ++i) if (sel[i] == tid) rks[i] = cnt++;
        ((int*)(sm + SM_UCNT))[u * 32 + tid] = cnt; atomicAdd((int*)(ws + WS_CTL) + CW_CNTE + tid, cnt); }
    __syncthreads();
    if (tid < 256) ((int*)(sm + SM_LRANK))[t0 * 4 + tid] = rks[tid];
    __syncthreads();
}

constexpr int NPHASE = 13;
__global__ void __launch_bounds__(NWAVES * 64, 2) mk_fwd(Args args) {
    extern __shared__ __attribute__((aligned(16))) unsigned char lds_raw[];
    LAS unsigned char* lds = (LAS unsigned char*)lds_raw;
    volatile LAS unsigned* MISC = (volatile LAS unsigned*)(lds + MISC_OFF);
    const int tid = threadIdx.x, lane = tid & 63, wave = __builtin_amdgcn_readfirstlane(tid >> 6);
    const int G = gridDim.x, bx = blockIdx.x;
    unsigned char* ws = args.ws; unsigned char* sm = ws + WS_SMALL;
    const int gw = bx * NWAVES + wave, NGW = G * NWAVES;
    for (int u = tid; u < 64; u += NWAVES * 64) MISC[u] = 0u;
    __syncthreads();
#if MK_SPLIT
#define GRID_BAR() do { } while (0)
#else
    XcdBarrier bar = xcd_barrier_post((unsigned*)(ws + WS_CTL) + CW_BAR, MISC + 8);
#define GRID_BAR() xcd_barrier(bar)
#endif
    const int lo = args.ph_lo, hi = args.ph_hi;
#ifndef PH_MASK
#define PH_MASK 0xffffffffu
#endif
#define IN(k) ((((PH_MASK) >> (k)) & 1u) && lo <= (k) && (k) < hi)
#define BOTH(k) (IN(k) && IN((k) + 1))

    if (IN(0)) {
        for (int u = bx; u < NCHT; u += G) xgate_unit(args, u, lds, tid);
        __syncthreads();
        p0_weights(args, lds, gw, NGW, wave, lane);
        { const float* p = argin(args, 1); bf16* pb = (bf16*)(ws + WS_PB);
          for (size_t i = (size_t)bx * 512 + tid; i < (size_t)NTOK * PLE / 4; i += (size_t)G * 512) { const f32x4 v = *(const f32x4*)(p + 4 * i); u32x2 w; w.x = pk2(v[0], v[1]); w.y = pk2(v[2], v[3]); *(u32x2*)(pb + 4 * i) = w; } }
        if (BOTH(0)) GRID_BAR();
    }
    if (IN(1)) {
        { pg8::Gemm g{(const bf16*)(ws + WS_XB), (const bf16*)(ws + WS_WIN), DM, 0, nullptr}; pg8::Order S; S.init(NTOK / 256, NZ / 256, G, bx, nullptr);
          pg8::EpiZ E{(bf16*)(ws + WS_Z), NZ, (const float*)(sm + SM_RS1)};
          pg8::gemm_phase<pg8::EpiZ, false, true>(lds, g, S, E); }
        { pg8::Gemm g{(const bf16*)(ws + WS_PB), (const bf16*)(ws + WS_WPP), PLE, 0, nullptr}; pg8::Order S; S.init(NTOK / 256, DM / 256, G, bx, nullptr);
          pg8::EpiPe E{(bf16*)(ws + WS_PE), (float*)(sm + SM_PESSQ)};
          pg8::gemm_phase<pg8::EpiPe, false, true>(lds, g, S, E); }
        if (BOTH(1)) GRID_BAR();
    }
    if (IN(2)) {
        for (int u = bx; u < 3072; u += G) {
#if !defined(P2_ONLY) || P2_ONLY == 1
            if (u < 2048) gdn_prep_unit(args, u, lds, tid, wave, lane);
#endif
#if !defined(P2_ONLY) || P2_ONLY == 2
            if (u >= 2048) ml_prep_unit(args, u - 2048, lds, tid, wave, lane);
#endif
        }
        if (BOTH(2)) GRID_BAR();
    }
    if (IN(3)) {
        for (int it = bx; it < 256; it += G) { if (it < 128) gdn_scan_item(args, it, lds, tid, wave, lane); else ml_scan_item(args, it - 128, lds, tid, wave, lane); __syncthreads(); }
        if (BOTH(3)) GRID_BAR();
    }
    if (IN(4)) {
        const float* OSC = (const float*)(ws + WS_OSC); const bf16* Z = (const bf16*)(ws + WS_Z); bf16* Y = (bf16*)(ws + WS_Y);
        const float* gn = argin(args, 7); const float* mn = argin(args, 10); const float* DEN = (const float*)(sm + SM_DEN); const float* MEN = (const float*)(sm + SM_MEN);
        for (int t = gw; t < NTOK; t += NGW) { const int b = t >> 12, s = t & 4095, c = s >> 6, l = s & 63;
            for (int h = 0; h < 8; ++h) { const f32x2 o = *(const f32x2*)(OSC + (size_t)t * DM + h * 128 + 2 * lane); const float r = rsqrtf(wave_sum(o[0] * o[0] + o[1] * o[1]) * (1.f / 128.f) + EPS);
                const unsigned gz = *(const unsigned*)(Z + (size_t)t * NZ + ZG + h * 128 + 2 * lane); const f32x2 gv = *(const f32x2*)(gn + 2 * lane);
                const float z0 = bflo(gz), z1 = bfhi(gz);
                *(unsigned*)(Y + (size_t)t * DM + h * 128 + 2 * lane) = pk2(o[0] * r * gv[0] * (z0 * sigm(z0)), o[1] * r * gv[1] * (z1 * sigm(z1))); }
            for (int h = 0; h < 4; ++h) { f32x4 n4 = *(const f32x4*)(OSC + (size_t)t * DM + 1024 + h * 256 + 4 * lane);
                const float dn = fmaxf(fabsf(DEN[(size_t)t * 4 + h]), MEN[((b * 4 + h) * 64 + c) * 64 + l]); n4 = n4 * (1.f / dn);
                const float r = rsqrtf(wave_sum((n4[0] * n4[0] + n4[1] * n4[1]) + (n4[2] * n4[2] + n4[3] * n4[3])) * (1.f / 256.f) + EPS);
                const u32x2 mo = *(const u32x2*)(Z + (size_t)t * NZ + ZMO + h * 256 + 4 * lane); const f32x4 nw = *(const f32x4*)(mn + h * 256 + 4 * lane);
                u32x2 w; w.x = pk2(n4[0] * r * nw[0] * sigm(bflo(mo.x)), n4[1] * r * nw[1] * sigm(bfhi(mo.x))); w.y = pk2(n4[2] * r * nw[2] * sigm(bflo(mo.y)), n4[3] * r * nw[3] * sigm(bfhi(mo.y)));
                *(u32x2*)(Y + (size_t)t * DM + 1024 + h * 256 + 4 * lane) = w; } }
        if (BOTH(4)) GRID_BAR();
    }
    if (IN(5)) {
        pg8::Gemm g{(const bf16*)(ws + WS_Y), (const bf16*)(ws + WS_WOUT), DM, 0, nullptr}; pg8::Order S; S.init(NTOK / 256, DM / 256, G, bx, nullptr);
        pg8::EpiOut E{argin(args, 0), (float*)(ws + WS_H1), (bf16*)(ws + WS_H1B), (float*)(sm + SM_SSQ1)};
        pg8::gemm_phase<pg8::EpiOut, false, true>(lds, g, S, E);
        if (BOTH(5)) GRID_BAR();
    }
    if (IN(6)) {
        for (int u = bx; u < NCHT; u += G) router_unit(args, u, lds, tid);
        if (BOTH(6)) GRID_BAR();
    }
    if (IN(7)) {
        LAS int* ps = (LAS int*)lds; LAS int* up = ps + 32; LAS int* cn = ps + 64;
        const int* CNTE = (const int*)(ws + WS_CTL) + CW_CNTE; const int* UCNT = (const int*)(sm + SM_UCNT);
        int* ROWTOK = (int*)(sm + SM_ROWTOK); float* ROWGATE = (float*)(sm + SM_ROWGATE); float* ROWRS = (float*)(sm + SM_ROWRS);
        if (tid == 0) { int acc = 0; for (int e = 0; e < 32; ++e) { const int cnt = CNTE[e]; ps[e] = acc; cn[e] = cnt; acc += ((cnt + 255) >> 8) << 8; } }
        __syncthreads();
        for (int u = bx; u < NCHT; u += G) {
            if (tid < 32) { int s = 0; for (int v = 0; v < u; ++v) s += UCNT[v * 32 + tid]; up[tid] = s; }
            __syncthreads();
            if (tid < 256) { const int ai = u * 256 + tid, t = ai >> 2; const int e = ((const int*)(sm + SM_TOPI))[ai]; const int dest = ps[e] + up[e] + ((const int*)(sm + SM_LRANK))[ai];
                ROWTOK[dest] = t; ROWGATE[dest] = ((const float*)(sm + SM_TOPG))[ai]; ROWRS[dest] = ((const float*)(sm + SM_RS2))[t]; ((int*)(sm + SM_DEST))[ai] = dest; }
            __syncthreads();
        }
        for (int e = bx; e < 32; e += G) { const int c0 = cn[e], c1 = ((c0 + 255) >> 8) << 8; for (int p = c0 + tid; p < c1; p += 512) { ROWTOK[ps[e] + p] = 0; ROWGATE[ps[e] + p] = 0.f; ROWRS[ps[e] + p] = 0.f; } }
        if (BOTH(7)) GRID_BAR();
    }
    if (IN(8) || IN(9)) {
        LAS int* tile_e = (LAS int*)(lds + MISC_OFF + 1024); LAS int* meta = (LAS int*)(lds + MISC_OFF + 512);
        if (tid == 0) { const int* CNTE = (const int*)(ws + WS_CTL) + CW_CNTE; int idx = 0; for (int e = 0; e < 32; ++e) { const int nt = (CNTE[e] + 255) >> 8; for (int i = 0; i < nt; ++i) tile_e[idx++] = e; } meta[0] = idx; }
        __syncthreads();
        const int n_mt = meta[0];
        if (IN(8)) {
            pg8::Gemm g{(const bf16*)(ws + WS_H1B), (const bf16*)(ws + WS_WGU), DM, (size_t)4096 * DM * 2, (const int*)(sm + SM_ROWTOK)}; pg8::Order S; S.init(n_mt, 16, G, bx, tile_e);
            pg8::EpiMoe1 E{(bf16*)(ws + WS_ACT), argin(args, 16), (const float*)(sm + SM_ROWRS)};
            pg8::gemm_phase<pg8::EpiMoe1, true, true>(lds, g, S, E);
            if (BOTH(8)) GRID_BAR();
        }
        if (IN(9)) {
            pg8::Gemm g{(const bf16*)(ws + WS_ACT), (const bf16*)(ws + WS_WDN), DM, (size_t)DM * DM * 2, nullptr}; pg8::Order S; S.init(n_mt, 8, G, bx, tile_e);
            pg8::EpiMoe2 E{(bf16*)(ws + WS_YB), argin(args, 18), (const float*)(sm + SM_ROWGATE)};
            pg8::gemm_phase<pg8::EpiMoe2, false, true>(lds, g, S, E);
            if (BOTH(9)) GRID_BAR();
        }
    }
    if (IN(10)) {
        const float* H1 = (const float*)(ws + WS_H1); const bf16* YB = (const bf16*)(ws + WS_YB); float* H2 = (float*)(ws + WS_H2); bf16* H2B = (bf16*)(ws + WS_H2B);
        const int* DEST = (const int*)(sm + SM_DEST); const float* PESSQ = (const float*)(sm + SM_PESSQ);
        for (int t = gw; t < NTOK; t += NGW) { const int d0 = DEST[t * 4], d1 = DEST[t * 4 + 1], d2 = DEST[t * 4 + 2], d3 = DEST[t * 4 + 3]; float ss = 0.f;
#pragma unroll
            for (int j = 0; j < 8; ++j) { const int col = 4 * lane + 256 * j; f32x4 hv = *(const f32x4*)(H1 + (size_t)t * DM + col);
                const u32x2 y0 = *(const u32x2*)(YB + (size_t)d0 * DM + col), y1 = *(const u32x2*)(YB + (size_t)d1 * DM + col), y2 = *(const u32x2*)(YB + (size_t)d2 * DM + col), y3 = *(const u32x2*)(YB + (size_t)d3 * DM + col);
                hv[0] += (bflo(y0.x) + bflo(y1.x)) + (bflo(y2.x) + bflo(y3.x)); hv[1] += (bfhi(y0.x) + bfhi(y1.x)) + (bfhi(y2.x) + bfhi(y3.x));
                hv[2] += (bflo(y0.y) + bflo(y1.y)) + (bflo(y2.y) + bflo(y3.y)); hv[3] += (bfhi(y0.y) + bfhi(y1.y)) + (bfhi(y2.y) + bfhi(y3.y));
                *(f32x4*)(H2 + (size_t)t * DM + col) = hv; u32x2 w; w.x = pk2(hv[0], hv[1]); w.y = pk2(hv[2], hv[3]); *(u32x2*)(H2B + (size_t)t * DM + col) = w;
                ss += (hv[0] * hv[0] + hv[1] * hv[1]) + (hv[2] * hv[2] + hv[3] * hv[3]); }
            ss = wave_sum(ss); const float ps = wave_sum(lane < 32 ? PESSQ[(size_t)t * 32 + lane] : 0.f);
            if (lane == 0) { ((float*)(sm + SM_RS3))[t] = rsqrtf(ss * (1.f / DM) + EPS); ((float*)(sm + SM_RSPE))[t] = rsqrtf(ps * (1.f / DM) + EPS); } }
        if (BOTH(10)) GRID_BAR();
    }
    if (IN(11)) {
        pg8::Gemm g{(const bf16*)(ws + WS_H2B), (const bf16*)(ws + WS_WPG), DM, 0, nullptr}; pg8::Order S; S.init(NTOK / 256, DM / 256, G, bx, nullptr);
        pg8::EpiPg E{(const float*)(ws + WS_H2), (const bf16*)(ws + WS_PE), (const float*)(sm + SM_RS3), (const float*)(sm + SM_RSPE), argin(args, 22), (float*)(ws + WS_H3), (float*)(sm + SM_SSQ3)};
        pg8::gemm_phase<pg8::EpiPg, false, true>(lds, g, S, E);
        if (BOTH(11)) GRID_BAR();
    }
#ifdef DBG_OUT
    if (IN(12)) {
        for (int t = gw; t < NTOK; t += NGW) {
#pragma unroll
            for (int j = 0; j < 8; ++j) { const int col = 4 * lane + 256 * j; f32x4 v;
#if DBG_OUT == 1
                { const u32x2 w = *(const u32x2*)((const bf16*)(ws + WS_Z) + (size_t)t * NZ + col); v = (f32x4){bflo(w.x), bfhi(w.x), bflo(w.y), bfhi(w.y)}; }
#elif DBG_OUT == 3
                v = *(const f32x4*)((const float*)(ws + WS_OSC) + (size_t)t * DM + col);
#elif DBG_OUT == 2
                { const size_t idx = (size_t)t * 1024 + (col & 1023);
                  if (col < 1024) v = *(const f32x4*)((const float*)(ws + WS_GU) + idx);
                  else { for (int q = 0; q < 4; ++q) { const size_t ix = idx + q; float a = bf2f(((const bf16*)(ws + WS_MVT))[ix]) + bf2f(((const bf16*)(ws + WS_MKWT))[ix & 8388607]) + bf2f(((const bf16*)(ws + WS_MWT))[ix & 4194303])
                      + bf2f(((const bf16*)(ws + WS_GW))[ix]) + bf2f(((const bf16*)(ws + WS_GKDT))[ix]) + bf2f(((const bf16*)(ws + WS_GQD))[ix]) + bf2f(((const bf16*)(ws + WS_GAT))[ix & 8388607])
                      + ((const float*)(sm + SM_MSI))[ix & 65535] + ((const float*)(sm + SM_MEN))[ix & 65535] + ((const float*)(sm + SM_MWS))[ix & 65535] + ((const float*)(sm + SM_GLAST))[ix & 2047] + ((const float*)(sm + SM_MDEC))[ix & 1023];
                      v[q] = a; } } }
#elif DBG_OUT == 31
                v = col < 1024 ? *(const f32x4*)((const float*)(ws + WS_OSC) + (size_t)t * DM + col) : (f32x4){0.f, 0.f, 0.f, 0.f};
#elif DBG_OUT == 32
                v = col >= 1024 ? *(const f32x4*)((const float*)(ws + WS_OSC) + (size_t)t * DM + col) : (f32x4){0.f, 0.f, 0.f, 0.f};
#elif DBG_OUT == 5
                v = *(const f32x4*)((const float*)(ws + WS_H1) + (size_t)t * DM + col);
#elif DBG_OUT == 10
                v = *(const f32x4*)((const float*)(ws + WS_H2) + (size_t)t * DM + col);
#endif
                *(f32x4*)(args.out + (size_t)t * DM + col) = v; } }
    }
#else
    if (IN(12)) {
        const float* H3 = (const float*)(ws + WS_H3); const float* SSQ3 = (const float*)(sm + SM_SSQ3); const float* gf = argin(args, 23);
        for (int t = gw; t < NTOK; t += NGW) { const float r = rsqrtf(wave_sum(lane < 32 ? SSQ3[(size_t)t * 32 + lane] : 0.f) * (1.f / DM) + EPS);
#pragma unroll
            for (int j = 0; j < 8; ++j) { const int col = 4 * lane + 256 * j; const f32x4 hv = *(const f32x4*)(H3 + (size_t)t * DM + col), gv = *(const f32x4*)(gf + col);
                *(f32x4*)(args.out + (size_t)t * DM + col) = hv * gv * r; } }
    }
#endif
#ifdef DBG_DET
    if (lo == 13) {
        unsigned long long s1 = 0ull, s2 = 0ull;
        auto acc_region = [&](const unsigned* p, size_t nwords) { for (size_t i = (size_t)bx * 512 + tid; i < nwords; i += (size_t)G * 512) { const unsigned w = p[i]; s1 += w; s2 += (unsigned long long)w * ((unsigned)i | 1u); } };
#if DBG_DET == 0
        acc_region((const unsigned*)(ws + WS_WIN), (size_t)(WS_Z - WS_WIN) / 4);
        acc_region((const unsigned*)(sm + SM_RS1), (size_t)(SM_GLAST - SM_RS1) / 4);
#elif DBG_DET == 1
        acc_region((const unsigned*)(ws + WS_Z), (size_t)(WS_GW - WS_Z) / 4);
        acc_region((const unsigned*)(sm + SM_PESSQ), (size_t)(2 << 20) / 4);
#elif DBG_DET == 2
        acc_region((const unsigned*)(ws + WS_GW), (size_t)(WS_OSC - WS_GW) / 4);
        acc_region((const unsigned*)(sm + SM_GLAST), (size_t)(SM_DEN - SM_GLAST) / 4);
#elif DBG_DET == 3
        acc_region((const unsigned*)(ws + WS_OSC), (size_t)(WS_Y - WS_OSC) / 4);
        acc_region((const unsigned*)(sm + SM_DEN), (size_t)(256 << 10) / 4);
#endif
        for (int o = 1; o < 64; o <<= 1) { s1 += __shfl_xor(s1, o); s2 += __shfl_xor(s2, o); }
        if (lane == 0) { unsigned long long* slot = (unsigned long long*)(ws + WS_CTL) + 8192 + 2 * args.aux; atomicAdd(slot, s1); atomicAdd(slot + 1, s2); }
    }
    if (lo == 14) {
        const unsigned long long* slot = (const unsigned long long*)(ws + WS_CTL) + 8192;
        const float v = (slot[0] == slot[2] && slot[1] == slot[3]) ? 0.f : 3.f;
        for (size_t i = (size_t)bx * 512 + tid; i < (size_t)NTOK * DM; i += (size_t)G * 512) args.out[i] = v;
    }
#endif
#undef IN
#undef BOTH
}

extern "C" void kernel_launch(void* const* d_in, const int* in_sizes, int n_in, void* d_out, int out_size, void* d_ws, size_t ws_size, hipStream_t stream) {
    static int grid = 0;
    if (grid == 0) {
        if (n_in != 24 || out_size != NTOK * DM || ws_size < WS_END) { fprintf(stderr, "kernel_launch: unexpected problem (n_in %d, out %d, ws %zu)\n", n_in, out_size, ws_size); grid = -1; return; }
        int dev = 0, cus = 0, per_cu = 0;
        if (hipGetDevice(&dev) != hipSuccess || hipDeviceGetAttribute(&cus, hipDeviceAttributeMultiprocessorCount, dev) != hipSuccess) { grid = -1; return; }
        if (hipFuncSetAttribute((const void*)mk_fwd, hipFuncAttributeMaxDynamicSharedMemorySize, LDS_BYTES) != hipSuccess) { fprintf(stderr, "kernel_launch: hipFuncSetAttribute failed\n"); grid = -1; return; }
        if (hipOccupancyMaxActiveBlocksPerMultiprocessor(&per_cu, (const void*)mk_fwd, NWAVES * 64, LDS_BYTES) != hipSuccess || per_cu < 1) fprintf(stderr, "kernel_launch: occupancy query reports %d\n", per_cu);
        (void)hipGetLastError();
        grid = cus;
    }
    if (grid < 0) return;
    (void)hipMemsetAsync((char*)d_ws + WS_CTL, 0, CTL_ZERO_BYTES, stream);
    Args a{};
    for (int i = 0; i < 24; ++i) a.in[i] = (const float*)d_in[i];
    a.out = (float*)d_out; a.ws = (unsigned char*)d_ws;
#ifdef DBG_DET
    for (int rep = 0; rep < 2; ++rep) {
        for (int ph = 0; ph <= DBG_DET; ++ph) { a.ph_lo = ph; a.ph_hi = ph + 1; hipLaunchKernelGGL(mk_fwd, dim3(grid), dim3(NWAVES * 64), LDS_BYTES, stream, a); }
        a.ph_lo = 13; a.ph_hi = 13; a.aux = rep; hipLaunchKernelGGL(mk_fwd, dim3(grid), dim3(NWAVES * 64), LDS_BYTES, stream, a); a.aux = 0;
    }
    a.ph_lo = 14; a.ph_hi = 14; hipLaunchKernelGGL(mk_fwd, dim3(grid), dim3(NWAVES * 64), LDS_BYTES, stream, a);
    return;
#endif
#if MK_SPLIT
    for (int ph = 0; ph < NPHASE; ++ph) { a.ph_lo = ph; a.ph_hi = ph + 1; hipLaunchKernelGGL(mk_fwd, dim3(grid), dim3(NWAVES * 64), LDS_BYTES, stream, a); }
#else
    a.ph_lo = 0; a.ph_hi = NPHASE; hipLaunchKernelGGL(mk_fwd, dim3(grid), dim3(NWAVES * 64), LDS_BYTES, stream, a);
#endif
}
```

```cpp
#include <hip/hip_runtime.h>
#include <cstdio>
#include <cstdint>


#ifndef DUP_AUX
#define DUP_AUX 0
#endif
#ifndef P3_DUP
#define P3_DUP 0
#endif
#ifndef P2_DUP
#define P2_DUP 0
#endif
#ifndef MK_SPLIT
#define DUP_MASK 0x0u
#define MK_SPLIT 0
#endif

#define LAS __attribute__((address_space(3)))
typedef unsigned short bf16;
typedef short bf16x8 __attribute__((ext_vector_type(8)));
typedef float f32x4 __attribute__((ext_vector_type(4)));
typedef float f32x2 __attribute__((ext_vector_type(2)));
typedef unsigned u32x4 __attribute__((ext_vector_type(4)));
typedef unsigned u32x2 __attribute__((ext_vector_type(2)));
typedef int i32x8 __attribute__((ext_vector_type(8)));
typedef int i32x4 __attribute__((ext_vector_type(4)));

constexpr int NTOK = 16384, DM = 2048, SEQL = 4096, NCHT = 256  ;
constexpr int DIN = 7192, NZ = 7168, PLE = 256, NEXP = 32;
constexpr int ZQ = 0, ZK = 1024, ZV = 2048, ZG = 3072, ZMQ = 4096, ZMK = 4608, ZMV = 5120, ZMO = 6144;
constexpr int MAXROWS = 73728;
constexpr float EPS = 1e-6f;

constexpr size_t MiB = 1ull << 20;
constexpr size_t WS_CTL = 0, CTL_ZERO_BYTES = 1 * MiB;
constexpr size_t WS_WIN = 1 * MiB, WS_WOUT = 29 * MiB, WS_WPG = 37 * MiB, WS_WPP = 45 * MiB, WS_WGU = 46 * MiB, WS_WDN = 558 * MiB;
constexpr size_t WS_XB = 814 * MiB, WS_PB = 878 * MiB, WS_Z = 886 * MiB, WS_PE = 1110 * MiB;
constexpr size_t WS_GW = 1174 * MiB, WS_GQD = 1206 * MiB, WS_GKDT = 1238 * MiB, WS_GAT = 1270 * MiB, WS_GU = 1286 * MiB;
constexpr size_t WS_MWT = 1350 * MiB, WS_MKWT = 1358 * MiB, WS_MVT = 1374 * MiB;
constexpr size_t WS_OSC = 1406 * MiB, WS_Y = 1534 * MiB, WS_H1 = 1598 * MiB, WS_H1B = 1726 * MiB;
constexpr size_t WS_ACT = 1790 * MiB, WS_YB = 2078 * MiB, WS_H2 = 2366 * MiB, WS_H2B = 2494 * MiB, WS_H3 = 2558 * MiB;
constexpr size_t WS_SMALL = 2686 * MiB;
constexpr size_t WS_WSK = 3038 * MiB;
constexpr size_t WS_GAP = 2718 * MiB, WS_GBB = 2782 * MiB, WS_GSS = 2846 * MiB, WS_MBM = 2910 * MiB, WS_MCS = 2974 * MiB, WS_END = 3039 * MiB;
constexpr size_t SM_RS1 = 0, SM_GC = 64 << 10, SM_BETA = SM_GC + (512 << 10), SM_FC = SM_BETA + (512 << 10), SM_IC = SM_FC + (256 << 10);
constexpr size_t SM_FLAST = SM_IC + (256 << 10), SM_AMAX = SM_FLAST + 4096, SM_GLAST = SM_AMAX + 4096;
constexpr size_t SM_MSI = SM_GLAST + 8192, SM_MEN = SM_MSI + (256 << 10), SM_MWS = SM_MEN + (256 << 10), SM_MDEC = SM_MWS + (256 << 10);
constexpr size_t SM_DEN = SM_MDEC + 4096, SM_PESSQ = SM_DEN + (256 << 10), SM_SSQ1 = SM_PESSQ + (2 << 20), SM_SSQ3 = SM_SSQ1 + (2 << 20);
constexpr size_t SM_RS2 = SM_SSQ3 + (2 << 20), SM_RS3 = SM_RS2 + (64 << 10), SM_RSPE = SM_RS3 + (64 << 10);
constexpr size_t SM_TOPI = SM_RSPE + (64 << 10), SM_TOPG = SM_TOPI + (256 << 10), SM_LRANK = SM_TOPG + (256 << 10), SM_DEST = SM_LRANK + (256 << 10);
constexpr size_t SM_UCNT = SM_DEST + (256 << 10), SM_ROWTOK = SM_UCNT + (32 << 10), SM_ROWGATE = SM_ROWTOK + (288 << 10), SM_ROWRS = SM_ROWGATE + (288 << 10);
constexpr size_t SM_MKS = SM_ROWRS + (288 << 10), SM_MNS = SM_MKS + (512 << 10);
constexpr size_t SM_END = SM_MNS + (512 << 10);
static_assert(SM_END <= 32 * MiB, "small arrays");
constexpr int CW_BAR = 4096, CW_CNTE = 8192, CW_POOL = 8320;

constexpr int RING_BYTES = 131072, MISC_OFF = 139264, LDS_BYTES = 155648;
constexpr int NWAVES = 8;
constexpr int GN_LDS = 134144;

typedef __bf16 bf16v2_t __attribute__((ext_vector_type(2)));
__device__ __forceinline__ unsigned pk2(float lo, float hi) { const f32x2 v = {lo, hi}; return __builtin_bit_cast(unsigned, __builtin_convertvector(v, bf16v2_t)); }
__device__ __forceinline__ bf16 f2bf(float f) { return __builtin_bit_cast(unsigned short, (__bf16)f); }
__device__ __forceinline__ unsigned pk4_fp8(float a, float b, float c, float d) { unsigned w = 0u; w = __builtin_amdgcn_cvt_pk_fp8_f32(a, b, w, false); w = __builtin_amdgcn_cvt_pk_fp8_f32(c, d, w, true); return w; }
constexpr float W8_SCALE = 32.f; constexpr int W8_E8M0 = 0x7a7a7a7a;
constexpr float ACT8_SCALE = 4.f; constexpr int ACT8_E8M0 = 0x7d7d7d7d;
constexpr int ONE_E8M0 = 0x7f7f7f7f;
constexpr float YB8_SCALE = 16.f;
constexpr float Y8_SCALE = 16.f; constexpr int Y8_E8M0 = 0x7b7b7b7b;
__device__ __forceinline__ float bf2f(bf16 b) { return __uint_as_float(((unsigned)b) << 16); }
__device__ __forceinline__ float bflo(unsigned w) { return __uint_as_float(w << 16); }
__device__ __forceinline__ float bfhi(unsigned w) { return __uint_as_float(w & 0xffff0000u); }
__device__ __forceinline__ float wave_sum(float v) {
#pragma unroll
    for (int o = 1; o < 64; o <<= 1) v += __shfl_xor(v, o);
    return v;
}
__device__ __forceinline__ float sigm(float x) { return __builtin_amdgcn_rcpf(1.f + __expf(-x)); }
__device__ __forceinline__ float softplusf(float x) { return fmaxf(x, 0.f) + log1pf(expf(-fabsf(x))); }
#define LDS_WAIT() asm volatile("s_waitcnt lgkmcnt(0)" ::: "memory")

#define XB_TMO      128
#define XB_XCNT(j)  (256  + 64 * (j))
#define XB_XSUB(j)  (1280 + 64 * (j))
#define XB_XGEN(j)  (2304 + 64 * (j))
#define XB_TOP      3328
#define XB_TOPGEN   3392
#define XCD_BAR_WORDS 3456
#define XB_SPIN_CAP (1u << 18)
__device__ __forceinline__ unsigned xb_ld(unsigned* p)              { return __hip_atomic_load(p, __ATOMIC_RELAXED, __HIP_MEMORY_SCOPE_AGENT); }
__device__ __forceinline__ unsigned xb_add(unsigned* p, unsigned v) { return __hip_atomic_fetch_add(p, v, __ATOMIC_RELAXED, __HIP_MEMORY_SCOPE_AGENT); }
__device__ __forceinline__ unsigned xb_xcc_id() { return (unsigned)__builtin_amdgcn_s_getreg((3 << 11) | 20) & 0xFu; }
#define XB_SPIN(cond, bar) do { unsigned _sp = 0; while (cond) { __builtin_amdgcn_s_sleep(1); \
    if ((++_sp & 255u) == 0u) { if (xb_ld(&(bar)[XB_TMO])) break; if (_sp > XB_SPIN_CAP) { atomicAdd(&(bar)[XB_TMO], 1u); break; } } } } while (0)
struct XcdBarrier { unsigned* bar; unsigned x; volatile LAS unsigned* st; };
__device__ __forceinline__ XcdBarrier xcd_barrier_post(unsigned* bar, volatile LAS unsigned* st, bool tid0) {
    XcdBarrier b; b.bar = bar; b.x = xb_xcc_id(); b.st = st;
    if (tid0) (void)xb_add(&bar[XB_XCNT(b.x)], 1u);
    return b;
}
__device__ __forceinline__ void xcd_barrier_complete(unsigned* bar, unsigned x, unsigned& nloc, unsigned& nx) {
    const unsigned G = gridDim.x * gridDim.y * gridDim.z;
    unsigned sum, cnt, mine, sp = 0u;
    for (;;) {
        sum = 0u; cnt = 0u; mine = 0u;
#pragma unroll
        for (unsigned j = 0; j < 16; ++j) { const unsigned c = xb_ld(&bar[XB_XCNT(j)]); sum += c; cnt += (c > 0u) ? 1u : 0u; mine = (j == x) ? c : mine; }
        if (sum == G) break;
        __builtin_amdgcn_s_sleep(1);
        if ((++sp & 255u) == 0u) { if (xb_ld(&bar[XB_TMO])) break; if (sp > XB_SPIN_CAP) { atomicAdd(&bar[XB_TMO], 1u); break; } }
    }
    nloc = mine > 0u ? mine : 1u; nx = cnt > 0u ? cnt : 1u;
}
__device__ __forceinline__ void xcd_barrier(const XcdBarrier& b, bool tid0) {
    asm volatile("s_waitcnt vmcnt(0)" ::: "memory");
    __syncthreads();
    if (tid0) {
        unsigned* bar = b.bar;
        __builtin_amdgcn_s_waitcnt(0);
        unsigned nloc = b.st[0], nx = b.st[1];
        if (nloc == 0u) { xcd_barrier_complete(bar, b.x, nloc, nx); b.st[0] = nloc; b.st[1] = nx; }
        const unsigned old = xb_add(&bar[XB_XSUB(b.x)], 1u);
        const unsigned gen = old / nloc;
        if (old + 1u == (gen + 1u) * nloc) {
            __builtin_amdgcn_fence(__ATOMIC_RELEASE, "agent");
            asm volatile("s_waitcnt vmcnt(0)" ::: "memory");
            const unsigned og = xb_add(&bar[XB_TOP], 1u);
            const unsigned tg = og / nx;
            if (og + 1u == (tg + 1u) * nx) xb_add(&bar[XB_TOPGEN], 1u);
            else XB_SPIN(xb_ld(&bar[XB_TOPGEN]) == tg, bar);
            __builtin_amdgcn_fence(__ATOMIC_ACQUIRE, "agent");
            xb_add(&bar[XB_XGEN(b.x)], 1u);
            asm volatile("s_waitcnt vmcnt(0)" ::: "memory");
        } else {
            XB_SPIN(xb_ld(&bar[XB_XGEN(b.x)]) == gen, bar);
            __builtin_amdgcn_fence(__ATOMIC_ACQUIRE, "agent");
            asm volatile("s_waitcnt vmcnt(0)" ::: "memory");
        }
    }
    __syncthreads();
}

namespace pg8 {
constexpr int BM = 256, BK = 64, HALF = 128, HTB = HALF * BK * 2, STAGE_BYTES = 8 * HTB, NXCD = 8, WGM = 8;
__host__ __device__ __forceinline__ int lds_byte(int r, int c) { const int st = (r >> 4) * 2 + (c >> 5), rr = r & 15, cc = c & 31, ob = rr * 64 + cc * 2; return st * 1024 + (ob ^ (((ob >> 9) & 1) << 5)); }
__host__ __device__ __forceinline__ void stage_rc(int b, int& R, int& C) { const int st = b / 1024, sb = b % 1024, swz = sb ^ (((sb >> 9) & 1) << 5); R = (st >> 1) * 16 + swz / 64; C = (st & 1) * 32 + (swz % 64) / 2; }
__host__ __device__ __forceinline__ int perm32(int rho) { const int n = rho >> 4, i = rho & 15; return 8 * (i >> 2) + 4 * n + (i & 3); }
struct Unit { int pm, pn, e; };
struct Gemm { const void* A; const void* Bt; int K; size_t bstride; const int* rowtab; int sclA, sclB; };
struct Order {
    int nM, nN, nwg, G, c; const LAS int* tile_e;
    __device__ __forceinline__ void init(int nM_, int nN_, int G_, int c_, const LAS int* te) { nM = nM_; nN = nN_; nwg = nM * nN; G = G_; c = c_; tile_e = te; }
    __device__ __forceinline__ bool next(int i, Unit& u) const {
        const long L = (long)i * G + c; if (L >= nwg) return false;
        int wgid = (int)L; { const int q = nwg / NXCD, r = nwg % NXCD, xcd = wgid % NXCD, off = wgid / NXCD; wgid = (xcd < r ? xcd * (q + 1) : r * (q + 1) + (xcd - r) * q) + off; }
        const int nig = WGM * nN, gid = wgid / nig, fm = gid * WGM, gsz = (nM - fm) < WGM ? (nM - fm) : WGM;
        u.pm = fm + ((wgid % nig) % gsz); u.pn = (wgid % nig) / gsz; u.e = tile_e ? tile_e[u.pm] : 0; return true;
    }
};

template <class Epi, bool GATHER, bool ALIGN_EPI, bool FP8 = false>
__device__ __forceinline__ void gemm_phase(LAS unsigned char* lds, const Gemm g, const Order& S, const Epi& E, const int tid) {
    const int wid = __builtin_amdgcn_readfirstlane(tid >> 6), lane = tid & 63, wr = wid >> 2, wc = wid & 3, fr = lane & 15, fq = lane >> 4;
    const int K = g.K, nt = K / 128;
    unsigned voffA[2], voffB[2]; int Rg[2], Cg[2];
#pragma unroll
    for (int i = 0; i < 2; ++i) { int R, C; stage_rc(tid * 16 + i * 8192, R, C); const int Rb = Epi::PERM ? ((R & ~31) + perm32(R & 31)) : R;
        voffA[i] = (unsigned)(R * K + C * 2); voffB[i] = (unsigned)(Rb * K + C * 2); Rg[i] = R; Cg[i] = C; }
    unsigned vAc[2][2], vAn[2][2];
    const size_t kstep = (size_t)128;
    const size_t hstep = (size_t)HALF * K;
    const size_t tstep = 2 * hstep;
    const unsigned ldsw = (unsigned)wid * 1024u;
    const int aoff = lds_byte(wr * 64 + fr, fq * 8), boff = lds_byte(wc * 32 + fr, fq * 8);
    const int lc1 = 2 * (fq & 1);
    const int aoff8a = lds_byte(wr * 64 + fr, (fq >> 1) * 32 + lc1 * 8), aoff8b = lds_byte(wr * 64 + fr, (fq >> 1) * 32 + (lc1 ^ 1) * 8);
    const int boff8a = lds_byte(wc * 32 + fr, (fq >> 1) * 32 + lc1 * 8), boff8b = lds_byte(wc * 32 + fr, (fq >> 1) * 32 + (lc1 ^ 1) * 8);
#define PG8_SA(b, h) (((b) * 2 + (h)) * HTB)
#define PG8_SB(b, h) ((4 + (b) * 2 + (h)) * HTB)
#define PG8_STAGE(bufoff, gbase, voff) do { _Pragma("unroll") for (int _i = 0; _i < 2; ++_i) \
        __builtin_amdgcn_global_load_lds((const unsigned*)((const char*)(gbase) + (voff)[_i]), (LAS unsigned*)(lds + (bufoff) + ldsw + _i * 8192), 16, 0, 0); } while (0)
#define PG8_STAGE_A(bufoff, kp, h, nx) do { if constexpr (GATHER) { _Pragma("unroll") for (int _i = 0; _i < 2; ++_i) { const unsigned _vo = (nx) ? vAn[h][_i] : vAc[h][_i]; \
        __builtin_amdgcn_global_load_lds((const unsigned*)((const char*)(kp) + _vo), (LAS unsigned*)(lds + (bufoff) + ldsw + _i * 8192), 16, 0, 0); } } \
        else { PG8_STAGE(bufoff, (kp) + (h) * hstep, voffA); } } while (0)
#define PG8_LD8(base, o1, o2) __builtin_shufflevector(*(const LAS i32x4*)(lds + (base) + (o1)), *(const LAS i32x4*)(lds + (base) + (o2)), 0, 1, 2, 3, 4, 5, 6, 7)
#define PG8_LDA(dst, b, h) do { if constexpr (FP8) { _Pragma("unroll") for (int m = 0; m < 4; ++m) dst##8[m] = PG8_LD8(PG8_SA(b, h) + m * 2048, aoff8a, aoff8b); } \
        else { _Pragma("unroll") for (int m = 0; m < 4; ++m) _Pragma("unroll") for (int k = 0; k < 2; ++k) dst[m][k] = *(const LAS bf16x8*)(lds + PG8_SA(b, h) + aoff + m * 2048 + k * 1024); } } while (0)
#define PG8_LDB(dst, b, h) do { if constexpr (FP8) { _Pragma("unroll") for (int n = 0; n < 2; ++n) dst##8[n] = PG8_LD8(PG8_SB(b, h) + n * 2048, boff8a, boff8b); } \
        else { _Pragma("unroll") for (int n = 0; n < 2; ++n) _Pragma("unroll") for (int k = 0; k < 2; ++k) dst[n][k] = *(const LAS bf16x8*)(lds + PG8_SB(b, h) + boff + n * 2048 + k * 1024); } } while (0)
#define PG8_MMA(ai, bj, At, Bt) do { __builtin_amdgcn_s_setprio(1); if constexpr (FP8) { _Pragma("unroll") for (int m = 0; m < 4; ++m) _Pragma("unroll") for (int n = 0; n < 2; ++n) \
        asm volatile("v_mfma_scale_f32_16x16x128_f8f6f4 %0, %1, %2, %0, %3, %4 op_sel_hi:[0,0,0]" : "+v"(acc[ai][bj][m][n]) : "v"(Bt##8[n]), "v"(At##8[m]), "v"(sclBv), "v"(sclAv)); } \
        else { _Pragma("unroll") for (int m = 0; m < 4; ++m) _Pragma("unroll") for (int n = 0; n < 2; ++n) _Pragma("unroll") for (int k = 0; k < 2; ++k) \
        acc[ai][bj][m][n] = __builtin_amdgcn_mfma_f32_16x16x32_bf16(Bt[n][k], At[m][k], acc[ai][bj][m][n], 0, 0, 0); } __builtin_amdgcn_s_setprio(0); } while (0)
#define PG8_WAIT_V(n) asm volatile("s_waitcnt vmcnt(" #n ")" ::: "memory")
#define PG8_WAIT_L(n) asm volatile("s_waitcnt lgkmcnt(" #n ")" ::: "memory")
#define PG8_BAR __builtin_amdgcn_s_barrier()
#define PG8_SCHED __builtin_amdgcn_sched_barrier(0)
#define PG8_GOFF(dst, u) do { if constexpr (GATHER) { _Pragma("unroll") for (int _h = 0; _h < 2; ++_h) _Pragma("unroll") for (int _i = 0; _i < 2; ++_i) \
        dst[_h][_i] = (unsigned)g.rowtab[(u).pm * BM + _h * HALF + Rg[_i]] * (unsigned)K + (unsigned)(Cg[_i] * 2); } } while (0)
    Unit cur, nxt; int ui = 0;
    if (!S.next(0, cur)) return;
    f32x4 acc[2][2][4][2];
#pragma unroll
    for (int a = 0; a < 2; ++a)
#pragma unroll
        for (int b = 0; b < 2; ++b)
#pragma unroll
            for (int m = 0; m < 4; ++m)
#pragma unroll
                for (int n = 0; n < 2; ++n) acc[a][b][m][n] = (f32x4){0.f, 0.f, 0.f, 0.f};
    bf16x8 At[4][2], B0[2][2], B1[2][2]; i32x8 At8[4], B08[2], B18[2];
    const int sclAv = g.sclA, sclBv = g.sclB;
    PG8_GOFF(vAc, cur);
#pragma unroll
    for (int _h = 0; _h < 2; ++_h)
#pragma unroll
        for (int _i = 0; _i < 2; ++_i) vAn[_h][_i] = vAc[_h][_i];
    const char* cA = GATHER ? (const char*)g.A : (const char*)g.A + (size_t)cur.pm * tstep;
    const char* cB = (const char*)g.Bt + (size_t)cur.e * g.bstride + (size_t)cur.pn * tstep;
    PG8_STAGE(PG8_SB(0, 0), cB, voffB); PG8_STAGE(PG8_SB(0, 1), cB + hstep, voffB); PG8_STAGE_A(PG8_SA(0, 0), cA, 0, false); PG8_STAGE_A(PG8_SA(0, 1), cA, 1, false);
    if (wr == 1) PG8_BAR;
    PG8_WAIT_V(2); PG8_BAR;
    PG8_STAGE(PG8_SB(1, 0), cB + kstep, voffB); PG8_STAGE_A(PG8_SA(1, 0), cA + kstep, 0, false); PG8_STAGE(PG8_SB(1, 1), cB + hstep + kstep, voffB);
    PG8_WAIT_V(6); PG8_BAR;
    for (;;) {
        const bool has_next = S.next(ui + 1, nxt);
        if (has_next) { PG8_GOFF(vAn, nxt); }
        const char* nA = GATHER ? (const char*)g.A : (has_next ? (const char*)g.A + (size_t)nxt.pm * tstep : cA);
        const char* nB = has_next ? (const char*)g.Bt + (size_t)nxt.e * g.bstride + (size_t)nxt.pn * tstep : cB;
        for (int t = 0; t < nt; t += 2) {
            const bool last = (t == nt - 2);
            const char* a1 = cA + (size_t)(t + 1) * kstep;
            const char* a2 = last ? nA : cA + (size_t)(t + 2) * kstep; const char* b2 = last ? nB : cB + (size_t)(t + 2) * kstep;
            const char* a3 = a2 + kstep; const char* b3 = b2 + kstep;
            PG8_LDB(B0, 0, 0); PG8_LDB(B1, 0, 1); PG8_SCHED; PG8_LDA(At, 0, 0); PG8_STAGE_A(PG8_SA(1, 1), a1, 1, false);
            PG8_WAIT_V(8); PG8_WAIT_L(0); PG8_BAR; PG8_MMA(0, 0, At, B0); PG8_MMA(0, 1, At, B1); PG8_BAR; PG8_SCHED;
            PG8_LDA(At, 0, 1); PG8_STAGE(PG8_SB(0, 0), b2, voffB); PG8_STAGE(PG8_SB(0, 1), b2 + hstep, voffB); PG8_STAGE_A(PG8_SA(0, 0), a2, 0, last);
            PG8_WAIT_V(8); PG8_WAIT_L(0); PG8_BAR; PG8_MMA(1, 0, At, B0); PG8_MMA(1, 1, At, B1); PG8_BAR; PG8_SCHED;
            PG8_LDB(B0, 1, 0); PG8_LDB(B1, 1, 1); PG8_SCHED; PG8_LDA(At, 1, 0); PG8_STAGE_A(PG8_SA(0, 1), a2, 1, last);
            PG8_WAIT_V(8); PG8_WAIT_L(0); PG8_BAR; PG8_MMA(0, 0, At, B0); PG8_MMA(0, 1, At, B1); PG8_BAR; PG8_SCHED;
            PG8_LDA(At, 1, 1); PG8_STAGE(PG8_SB(1, 0), b3, voffB); PG8_STAGE(PG8_SB(1, 1), b3 + hstep, voffB); PG8_STAGE_A(PG8_SA(1, 0), a3, 0, last);
            PG8_WAIT_V(8); PG8_WAIT_L(0); PG8_BAR; PG8_MMA(1, 0, At, B0); PG8_MMA(1, 1, At, B1); PG8_BAR; PG8_SCHED;
        }
        if constexpr (ALIGN_EPI) { if (wr == 0) PG8_BAR; }
        E(acc, cur, wr, wc, fr, fq);
        if (!has_next) break;
#pragma unroll
        for (int a = 0; a < 2; ++a)
#pragma unroll
            for (int b = 0; b < 2; ++b)
#pragma unroll
                for (int m = 0; m < 4; ++m)
#pragma unroll
                    for (int n = 0; n < 2; ++n) acc[a][b][m][n] = (f32x4){0.f, 0.f, 0.f, 0.f};
        cur = nxt; cA = nA; cB = nB; ++ui;
#pragma unroll
        for (int _h = 0; _h < 2; ++_h)
#pragma unroll
            for (int _i = 0; _i < 2; ++_i) vAc[_h][_i] = vAn[_h][_i];
        if constexpr (ALIGN_EPI) { if (wr == 1) PG8_BAR; }
    }
    PG8_WAIT_V(0);
    if constexpr (!ALIGN_EPI) { if (wr == 0) PG8_BAR; }
    PG8_BAR;
#undef PG8_SA
#undef PG8_SB
#undef PG8_STAGE
#undef PG8_STAGE_A
#undef PG8_LDA
#undef PG8_LDB
#undef PG8_MMA
#undef PG8_LD8
#undef PG8_WAIT_V
#undef PG8_WAIT_L
#undef PG8_BAR
#undef PG8_SCHED
#undef PG8_GOFF
}

typedef const f32x4 (&AccRef)[2][2][4][2];

struct EpiZ {
    static constexpr bool PERM = true;
    bf16* Z; int ldc; const float* rs;
    __device__ __forceinline__ void operator()(AccRef acc, const Unit& u, int wr, int wc, int fr, int fq) const {
        const int row0 = u.pm * BM + wr * 64 + fr, col0 = u.pn * BM + wc * 32 + 8 * fq;
#pragma unroll
        for (int ai = 0; ai < 2; ++ai)
#pragma unroll
            for (int m = 0; m < 4; ++m) { const int r = row0 + ai * HALF + m * 16; const float s = rs[r]; bf16* rowp = Z + (size_t)r * ldc + col0;
#pragma unroll
                for (int bj = 0; bj < 2; ++bj) { const f32x4 v0 = acc[ai][bj][m][0] * s, v1 = acc[ai][bj][m][1] * s;
                    u32x4 w; w.x = pk2(v0[0], v0[1]); w.y = pk2(v0[2], v0[3]); w.z = pk2(v1[0], v1[1]); w.w = pk2(v1[2], v1[3]);
                    *(u32x4*)(rowp + bj * HALF) = w; } }
    }
};
struct EpiPe {
    static constexpr bool PERM = true;
    bf16* O; float* ssq;
    __device__ __forceinline__ void operator()(AccRef acc, const Unit& u, int wr, int wc, int fr, int fq) const {
        const int row0 = u.pm * BM + wr * 64 + fr, col0 = u.pn * BM + wc * 32 + 8 * fq;
#pragma unroll
        for (int ai = 0; ai < 2; ++ai)
#pragma unroll
            for (int m = 0; m < 4; ++m) { const int r = row0 + ai * HALF + m * 16; bf16* rowp = O + (size_t)r * DM + col0; float ss = 0.f;
#pragma unroll
                for (int bj = 0; bj < 2; ++bj) { const f32x4 v0 = acc[ai][bj][m][0], v1 = acc[ai][bj][m][1];
                    ss += (v0[0] * v0[0] + v0[1] * v0[1]) + (v0[2] * v0[2] + v0[3] * v0[3]) + (v1[0] * v1[0] + v1[1] * v1[1]) + (v1[2] * v1[2] + v1[3] * v1[3]);
                    u32x4 w; w.x = pk2(v0[0], v0[1]); w.y = pk2(v0[2], v0[3]); w.z = pk2(v1[0], v1[1]); w.w = pk2(v1[2], v1[3]);
                    *(u32x4*)(rowp + bj * HALF) = w; }
                ss += __shfl_xor(ss, 16); ss += __shfl_xor(ss, 32);
                if (fq == 0) ssq[(size_t)r * 32 + u.pn * 4 + wc] = ss; }
    }
};
struct EpiOut {
    static constexpr bool PERM = false;
    const float* X; float* H; float* ssq;
    __device__ __forceinline__ void operator()(AccRef acc, const Unit& u, int wr, int wc, int fr, int fq) const {
        const int row0 = u.pm * BM + wr * 64 + fr, col0 = u.pn * BM + wc * 32 + 4 * fq;
#pragma unroll
        for (int ai = 0; ai < 2; ++ai)
#pragma unroll
            for (int m2 = 0; m2 < 2; ++m2) { f32x4 xv[2][2][2];
#pragma unroll
                for (int mm = 0; mm < 2; ++mm) { const size_t off = (size_t)(row0 + ai * HALF + (2 * m2 + mm) * 16) * DM + col0;
#pragma unroll
                    for (int bj = 0; bj < 2; ++bj)
#pragma unroll
                        for (int n = 0; n < 2; ++n) xv[mm][bj][n] = *(const f32x4*)(X + off + bj * HALF + n * 16); }
                asm volatile("" ::: "memory");
#pragma unroll
                for (int mm = 0; mm < 2; ++mm) { const int m = 2 * m2 + mm, r = row0 + ai * HALF + m * 16; const size_t off = (size_t)r * DM + col0; float ss = 0.f;
#pragma unroll
                    for (int bj = 0; bj < 2; ++bj)
#pragma unroll
                        for (int n = 0; n < 2; ++n) { const f32x4 h = xv[mm][bj][n] + acc[ai][bj][m][n]; *(f32x4*)(H + off + bj * HALF + n * 16) = h; ss += (h[0] * h[0] + h[1] * h[1]) + (h[2] * h[2] + h[3] * h[3]); }
                    ss += __shfl_xor(ss, 16); ss += __shfl_xor(ss, 32);
                    if (fq == 0) ssq[(size_t)r * 32 + u.pn * 4 + wc] = ss; } }
    }
};
struct EpiMoe1 {
    static constexpr bool PERM = true;
    unsigned char* ACT; const float* bgu;
    __device__ __forceinline__ void operator()(AccRef acc, const Unit& u, int wr, int wc, int fr, int fq) const {
        const int row0 = u.pm * BM + wr * 64 + fr, j0 = u.pn * HALF + wc * 32 + 8 * fq;
        const float* bp = bgu + (size_t)u.e * 4096 + 2 * j0;
        const f32x4 b0 = *(const f32x4*)(bp), b1 = *(const f32x4*)(bp + 4), b2 = *(const f32x4*)(bp + 8), b3 = *(const f32x4*)(bp + 12);
        const float bg[8] = {b0[0], b0[2], b1[0], b1[2], b2[0], b2[2], b3[0], b3[2]}, bu[8] = {b0[1], b0[3], b1[1], b1[3], b2[1], b2[3], b3[1], b3[3]};
#pragma unroll
        for (int ai = 0; ai < 2; ++ai)
#pragma unroll
            for (int m = 0; m < 4; ++m) { const int r = row0 + ai * HALF + m * 16; float o[8];
#pragma unroll
                for (int n = 0; n < 2; ++n)
#pragma unroll
                    for (int q = 0; q < 4; ++q) { float gt = acc[ai][0][m][n][q] + bg[4 * n + q], up = acc[ai][1][m][n][q] + bu[4 * n + q];
                        gt = fminf(gt, 7.f); up = fminf(fmaxf(up, -7.f), 7.f); o[4 * n + q] = gt * sigm(1.702f * gt) * (up + 1.f) * ACT8_SCALE; }
                u32x2 w; w.x = pk4_fp8(o[0], o[1], o[2], o[3]); w.y = pk4_fp8(o[4], o[5], o[6], o[7]);
                *(u32x2*)(ACT + (size_t)r * DM + j0) = w; }
    }
};
struct EpiMoe2 {
    static constexpr bool PERM = true;
    unsigned char* YB; const float* bdn; const float* rowgate;
    __device__ __forceinline__ void operator()(AccRef acc, const Unit& u, int wr, int wc, int fr, int fq) const {
        const int row0 = u.pm * BM + wr * 64 + fr, col0 = u.pn * BM + wc * 32 + 8 * fq;
        const float* bp = bdn + (size_t)u.e * DM + col0;
        f32x4 bv[2][2];
#pragma unroll
        for (int bj = 0; bj < 2; ++bj)
#pragma unroll
            for (int n = 0; n < 2; ++n) bv[bj][n] = *(const f32x4*)(bp + bj * HALF + 4 * n);
#pragma unroll
        for (int ai = 0; ai < 2; ++ai)
#pragma unroll
            for (int m = 0; m < 4; ++m) { const int r = row0 + ai * HALF + m * 16; const float gt = rowgate[r] * YB8_SCALE; unsigned char* rowp = YB + (size_t)r * DM + col0;
#pragma unroll
                for (int bj = 0; bj < 2; ++bj) { const f32x4 v0 = (acc[ai][bj][m][0] + bv[bj][0]) * gt, v1 = (acc[ai][bj][m][1] + bv[bj][1]) * gt;
                    *(u32x2*)(rowp + bj * HALF) = (u32x2){pk4_fp8(v0[0], v0[1], v0[2], v0[3]), pk4_fp8(v1[0], v1[1], v1[2], v1[3])}; } }
    }
};
struct EpiPg {
    static constexpr bool PERM = true;
    const bf16* H2; const bf16* PE; const float* rs3; const float* rspe; const float* gpost; bf16* H3; float* ssq;
    __device__ __forceinline__ void operator()(AccRef acc, const Unit& u, int wr, int wc, int fr, int fq) const {
        const int row0 = u.pm * BM + wr * 64 + fr, col0 = u.pn * BM + wc * 32 + 8 * fq;
#pragma unroll
        for (int ai = 0; ai < 2; ++ai)
#pragma unroll
            for (int m = 0; m < 4; ++m) { const int r = row0 + ai * HALF + m * 16; const size_t off = (size_t)r * DM + col0; const float s3 = rs3[r], sp = rspe[r]; float ss = 0.f;
#pragma unroll
                for (int bj = 0; bj < 2; ++bj) { const size_t o = off + bj * HALF; const f32x4 gp0 = *(const f32x4*)(gpost + col0 + bj * HALF), gp1 = *(const f32x4*)(gpost + col0 + bj * HALF + 4);
                    const u32x4 pw = *(const u32x4*)(PE + o), hw = *(const u32x4*)(H2 + o); const f32x4 a0 = acc[ai][bj][m][0] * s3, a1 = acc[ai][bj][m][1] * s3;
                    float h[8];
                    h[0] = bflo(hw.x) + sigm(a0[0]) * (bflo(pw.x) * sp * gp0[0]); h[1] = bfhi(hw.x) + sigm(a0[1]) * (bfhi(pw.x) * sp * gp0[1]);
                    h[2] = bflo(hw.y) + sigm(a0[2]) * (bflo(pw.y) * sp * gp0[2]); h[3] = bfhi(hw.y) + sigm(a0[3]) * (bfhi(pw.y) * sp * gp0[3]);
                    h[4] = bflo(hw.z) + sigm(a1[0]) * (bflo(pw.z) * sp * gp1[0]); h[5] = bfhi(hw.z) + sigm(a1[1]) * (bfhi(pw.z) * sp * gp1[1]);
                    h[6] = bflo(hw.w) + sigm(a1[2]) * (bflo(pw.w) * sp * gp1[2]); h[7] = bfhi(hw.w) + sigm(a1[3]) * (bfhi(pw.w) * sp * gp1[3]);
                    *(u32x4*)(H3 + o) = (u32x4){pk2(h[0], h[1]), pk2(h[2], h[3]), pk2(h[4], h[5]), pk2(h[6], h[7])};
                    ss += ((h[0] * h[0] + h[1] * h[1]) + (h[2] * h[2] + h[3] * h[3])) + ((h[4] * h[4] + h[5] * h[5]) + (h[6] * h[6] + h[7] * h[7])); }
                ss += __shfl_xor(ss, 16); ss += __shfl_xor(ss, 32);
                if (fq == 0) ssq[(size_t)r * 32 + u.pn * 4 + wc] = ss; }
    }
};
}

__device__ __forceinline__ bf16x8 frag(const LAS bf16* base, int row0, int ld, int k0, int lane) {
    return *(const LAS bf16x8*)(base + (row0 + (lane & 15)) * ld + k0 + 8 * (lane >> 4));
}
#define MMA16(a, b, c) __builtin_amdgcn_mfma_f32_16x16x32_bf16(a, b, c, 0, 0, 0)

struct Args { const float* in[24]; float* out; unsigned char* ws; int ph_lo, ph_hi, aux, pad; };
__device__ __forceinline__ const float* argin(const Args& a, int k) { asm volatile("" : "+s"(k)); return a.in[k]; }

__device__ __forceinline__ void tr_tile(const float* W, int ldn, int c0, int k0, const float* g, bf16* WT, int K, int d0, int mode, int lane) {
    const int kk = lane >> 4, n4 = lane & 15;
    const float* src = W + (size_t)(k0 + 16 * kk) * ldn + c0 + 4 * n4;
    f32x4 v[16];
#pragma unroll
    for (int i = 0; i < 16; ++i) v[i] = __builtin_nontemporal_load((const f32x4*)(src + (size_t)i * ldn));
    if (g) { const f32x4* gp = (const f32x4*)(g + k0 + 16 * kk);
#pragma unroll
        for (int i4 = 0; i4 < 4; ++i4) { const f32x4 gv = gp[i4];
#pragma unroll
            for (int e = 0; e < 4; ++e) v[4 * i4 + e] = v[4 * i4 + e] * gv[e]; } }
#pragma unroll
    for (int q = 0; q < 4; ++q) { const int j = 4 * n4 + q; int dr; if (mode == 0) dr = d0 + j; else { const int jj = (c0 + j) >> 1; dr = 256 * (jj >> 7) + (jj & 127) + 128 * (j & 1); }
        u32x4 o0, o1;
        o0.x = pk2(v[0][q], v[1][q]); o0.y = pk2(v[2][q], v[3][q]); o0.z = pk2(v[4][q], v[5][q]); o0.w = pk2(v[6][q], v[7][q]);
        o1.x = pk2(v[8][q], v[9][q]); o1.y = pk2(v[10][q], v[11][q]); o1.z = pk2(v[12][q], v[13][q]); o1.w = pk2(v[14][q], v[15][q]);
        bf16* dst = WT + (size_t)dr * K + k0 + 16 * kk; *(u32x4*)dst = o0; *(u32x4*)(dst + 8) = o1; }
}
__device__ __forceinline__ int win_src_col(int n) { return n < 3072 ? n : (n < 6144 ? n + 16 : n + 24); }

__device__ __forceinline__ void p0_weights(const Args& a, int gw, int NGW, int lane) {
    unsigned char* ws = a.ws;
    constexpr int I_WIN = 112 * 32, I_WPP = 32 * 4, I_WOUT = 32 * 32;
    for (int it = gw; it < I_WIN + I_WPP + I_WOUT; it += NGW) {
        int r = it;
        if (r >= I_WIN + I_WPP) { r -= I_WIN + I_WPP; const int kb = r >> 5, nb = r & 31; tr_tile(argin(a, 11), DM, 64 * nb, 64 * kb, nullptr, (bf16*)(ws + WS_WOUT), DM, 64 * nb, 0, lane); continue; }
        if (r < I_WIN) { const int kb = r / 112, nb = r - kb * 112; tr_tile(argin(a, 3), DIN, win_src_col(64 * nb), 64 * kb, argin(a, 2), (bf16*)(ws + WS_WIN), DM, 64 * nb, 0, lane); continue; } r -= I_WIN;
        { const int kb = r >> 5, nb = r & 31; tr_tile(argin(a, 21), DM, 64 * nb, 64 * kb, nullptr, (bf16*)(ws + WS_WPP), PLE, 64 * nb, 0, lane); }
    }
}
constexpr int POOL_WGU = 32 * 16 * 16, POOL_WDN = 32 * 16 * 8, POOL_WPG = 16 * 8, NPOOL = POOL_WGU + POOL_WDN + POOL_WPG;
struct PoolTile { const float* W; const float* g; unsigned char* WT; int ldn, c0, k0, d0, mode; };
__device__ __forceinline__ void pool_tile_desc(const Args& a, int r, PoolTile& t) {
    unsigned char* ws = a.ws;
    if (r < POOL_WGU) { const int e = r >> 8, kb = (r >> 4) & 15, nb = r & 15; t.W = argin(a, 15) + (size_t)e * DM * 4096; t.g = argin(a, 12); t.WT = ws + WS_WGU + (size_t)e * 4096 * DM; t.ldn = 4096; t.c0 = 256 * nb; t.k0 = 128 * kb; t.d0 = 0; t.mode = 1; return; } r -= POOL_WGU;
    if (r < POOL_WDN) { const int e = r >> 7, kb = (r >> 3) & 15, nb = r & 7; t.W = argin(a, 17) + (size_t)e * DM * DM; t.g = nullptr; t.WT = ws + WS_WDN + (size_t)e * DM * DM; t.ldn = DM; t.c0 = 256 * nb; t.k0 = 128 * kb; t.d0 = 256 * nb; t.mode = 0; return; } r -= POOL_WDN;
    { const int kb = r >> 3, nb = r & 7; t.W = argin(a, 20); t.g = argin(a, 19); t.WT = ws + WS_WPG; t.ldn = DM; t.c0 = 256 * nb; t.k0 = 128 * kb; t.d0 = 256 * nb; t.mode = 0; }
}
#define POOL_LOAD(t, v) do { const float* _src = (t).W + (size_t)((t).k0 + 16 * wid) * (t).ldn + (t).c0 + 4 * lane; _Pragma("unroll") for (int _i = 0; _i < 16; ++_i) (v)[_i] = *(const f32x4*)(_src + (size_t)_i * (t).ldn); } while (0)
__device__ __forceinline__ void convert_pool(const Args& a, LAS unsigned char* lds, int tid, int wid, int lane) {
    unsigned* ctr = (unsigned*)(a.ws + WS_CTL) + CW_POOL + (a.aux == 6 ? 64 : 0);
    LAS unsigned char* T = lds;
    LAS int* nxt = (LAS int*)(lds + 40960);
    f32x4 v[16]; PoolTile cur, nx; int have;
    if (tid == 0) nxt[0] = (int)__hip_atomic_fetch_add(ctr, 1u, __ATOMIC_RELAXED, __HIP_MEMORY_SCOPE_AGENT);
    __syncthreads();
    int r = __builtin_amdgcn_readfirstlane(nxt[0]); have = r < NPOOL;
    if (have) { pool_tile_desc(a, r, cur); POOL_LOAD(cur, v); }
    int slot = 1;
    while (have) {
        if (tid == 0) nxt[slot] = (int)__hip_atomic_fetch_add(ctr, 1u, __ATOMIC_RELAXED, __HIP_MEMORY_SCOPE_AGENT);
        { f32x4 gs[4];
#pragma unroll
          for (int i4 = 0; i4 < 4; ++i4) gs[i4] = cur.g ? *(const f32x4*)(cur.g + cur.k0 + 16 * wid + 4 * i4) * W8_SCALE : (f32x4){W8_SCALE, W8_SCALE, W8_SCALE, W8_SCALE};
#pragma unroll
          for (int i = 0; i < 16; ++i) v[i] = v[i] * gs[i >> 2][i & 3];
#pragma unroll
          for (int q = 0; q < 4; ++q) { u32x4 o;
              o.x = pk4_fp8(v[0][q], v[1][q], v[2][q], v[3][q]); o.y = pk4_fp8(v[4][q], v[5][q], v[6][q], v[7][q]); o.z = pk4_fp8(v[8][q], v[9][q], v[10][q], v[11][q]); o.w = pk4_fp8(v[12][q], v[13][q], v[14][q], v[15][q]);
              *(LAS u32x4*)(T + (4 * lane + q) * 128 + ((wid ^ (lane & 7)) << 4)) = o; } }
        __syncthreads();
        const int rn = __builtin_amdgcn_readfirstlane(nxt[slot]); const int have_n = rn < NPOOL;
        if (have_n) { pool_tile_desc(a, rn, nx); POOL_LOAD(nx, v); }
#pragma unroll
        for (int it = 0; it < 4; ++it) { const int row = 32 * wid + 8 * it + (lane >> 3), c = lane & 7;
            const u32x4 o = *(const LAS u32x4*)(T + row * 128 + ((c ^ ((row >> 2) & 7)) << 4));
            int dr; if (cur.mode == 0) dr = cur.d0 + row; else { const int jj = (cur.c0 + row) >> 1; dr = 256 * (jj >> 7) + (jj & 127) + 128 * (row & 1); }
            *(u32x4*)(cur.WT + (size_t)dr * DM + cur.k0 + 16 * c) = o; }
        __syncthreads();
        cur = nx; have = have_n; slot ^= 1;
    }
}
#undef POOL_LOAD

template <class Side>
__device__ __forceinline__ void skinny_mfma(const float* A, const bf16* Whi, const bf16* Wlo, LAS float* red, LAS float* Ls, int tid, int wid, int lane, const Side& side) {
    const int g4 = lane >> 4, c15 = lane & 15;
    f32x4 acc[4][2];
#pragma unroll
    for (int rt = 0; rt < 4; ++rt) { acc[rt][0] = (f32x4){0.f, 0.f, 0.f, 0.f}; acc[rt][1] = (f32x4){0.f, 0.f, 0.f, 0.f}; }
    const float* ap = A + (size_t)c15 * DM + 256 * wid + 8 * g4;
    const bf16* bh = Whi + (size_t)c15 * DM + 256 * wid + 8 * g4; const bf16* bl = Wlo + (size_t)c15 * DM + 256 * wid + 8 * g4;
    f32x4 av[2][4][2]; u32x4 bv[2][2][2];
#define SK_LOAD(buf, ks) do { _Pragma("unroll") for (int rt = 0; rt < 4; ++rt) { av[buf][rt][0] = *(const f32x4*)(ap + (size_t)(16 * rt) * DM + 32 * (ks)); av[buf][rt][1] = *(const f32x4*)(ap + (size_t)(16 * rt) * DM + 32 * (ks) + 4); } \
        _Pragma("unroll") for (int ct = 0; ct < 2; ++ct) { bv[buf][ct][0] = *(const u32x4*)(bh + (size_t)(16 * ct) * DM + 32 * (ks)); bv[buf][ct][1] = *(const u32x4*)(bl + (size_t)(16 * ct) * DM + 32 * (ks)); } } while (0)
    SK_LOAD(0, 0);
#pragma unroll
    for (int ks = 0; ks < 8; ++ks) { const int cb = ks & 1;
        if (ks < 7) SK_LOAD(cb ^ 1, ks + 1);
#pragma unroll
        for (int rt = 0; rt < 4; ++rt) { const f32x4 v0 = av[cb][rt][0], v1 = av[cb][rt][1];
            side(rt, 256 * wid + 32 * ks + 8 * g4, v0, v1);
            u32x4 hi, lo; hi.x = pk2(v0[0], v0[1]); hi.y = pk2(v0[2], v0[3]); hi.z = pk2(v1[0], v1[1]); hi.w = pk2(v1[2], v1[3]);
            lo.x = pk2(v0[0] - bflo(hi.x), v0[1] - bfhi(hi.x)); lo.y = pk2(v0[2] - bflo(hi.y), v0[3] - bfhi(hi.y)); lo.z = pk2(v1[0] - bflo(hi.z), v1[1] - bfhi(hi.z)); lo.w = pk2(v1[2] - bflo(hi.w), v1[3] - bfhi(hi.w));
            const bf16x8 ah = __builtin_bit_cast(bf16x8, hi), al = __builtin_bit_cast(bf16x8, lo);
#pragma unroll
            for (int ct = 0; ct < 2; ++ct) { const bf16x8 wh = __builtin_bit_cast(bf16x8, bv[cb][ct][0]), wl = __builtin_bit_cast(bf16x8, bv[cb][ct][1]);
                acc[rt][ct] = MMA16(ah, wh, acc[rt][ct]); acc[rt][ct] = MMA16(al, wh, acc[rt][ct]); acc[rt][ct] = MMA16(ah, wl, acc[rt][ct]); } } }
#undef SK_LOAD
#pragma unroll
    for (int rt = 0; rt < 4; ++rt)
#pragma unroll
        for (int ct = 0; ct < 2; ++ct)
#pragma unroll
            for (int rg = 0; rg < 4; ++rg) red[(wid * 64 + 16 * rt + 4 * g4 + rg) * 33 + 16 * ct + c15] = acc[rt][ct][rg];
    __syncthreads();
    { const int row = tid >> 3, n4 = (tid & 7) * 4;
#pragma unroll
      for (int q = 0; q < 4; ++q) { float s = 0.f;
#pragma unroll
          for (int w = 0; w < 8; ++w) s += red[(w * 64 + row) * 33 + n4 + q];
          Ls[row * 33 + n4 + q] = s; } }
    __syncthreads();
}

__device__ __forceinline__ void xgate_unit(const Args& a, int u, LAS unsigned char* lds, int tid, int wid, int lane) {
    asm volatile("" : "+v"(tid), "+v"(lane));
    unsigned char* sm = a.ws + WS_SMALL;
    LAS float* red = (LAS float*)lds; LAS float* Gs = (LAS float*)(lds + 67584); LAS float* gl = (LAS float*)(lds + 67584 + 8448); LAS float* il = gl + 64 * 12;
    const int t0 = u * 64;
    skinny_mfma(argin(a, 0) + (size_t)t0 * DM, (const bf16*)(a.ws + WS_WSK), (const bf16*)(a.ws + WS_WSK) + 32 * DM, red, Gs, tid, wid, lane, [](int, int, const f32x4&, const f32x4&) {});
    if (tid < 64) { const int l = tid, t = t0 + l; float* BETA = (float*)(sm + SM_BETA); float* IC = (float*)(sm + SM_IC); const float rs = ((const float*)(sm + SM_RS1))[t];
        const float* a_log = argin(a, 5); const float* dt_b = argin(a, 6); const float* b_i = argin(a, 8); const float* b_f = argin(a, 9);
        for (int h = 0; h < 8; ++h) { const float av = Gs[l * 33 + h] * rs; gl[l * 12 + h] = -expf(a_log[h]) * softplusf(av + dt_b[h]); BETA[t * 8 + h] = 1.f / (1.f + expf(-Gs[l * 33 + 8 + h] * rs)); }
        for (int h = 0; h < 4; ++h) { const float ip = 15.f * tanhf((Gs[l * 33 + 16 + h] * rs + b_i[h]) * (1.f / 15.f)); il[l * 4 + h] = ip; IC[t * 4 + h] = ip;
            const float fp = 15.f * tanhf((Gs[l * 33 + 20 + h] * rs + b_f[h]) * (1.f / 15.f)); gl[l * 12 + 8 + h] = -softplusf(-fp); } }
    __syncthreads();
    {
        float* GC = (float*)(sm + SM_GC); float* FC = (float*)(sm + SM_FC);
        for (int j = wid; j < 12; j += 8) { float v = gl[lane * 12 + j];
#pragma unroll
            for (int off = 1; off < 64; off <<= 1) { const float vp = __shfl_up(v, off); if (lane >= off) v += vp; }
            if (j < 8) GC[(t0 + lane) * 8 + j] = v; else { const int h = j - 8; FC[(t0 + lane) * 4 + h] = v; const float tot = __shfl(v, 63); float am = tot - v + il[lane * 4 + h];
#pragma unroll
                for (int off = 1; off < 64; off <<= 1) am = fmaxf(am, __shfl_xor(am, off));
                if (lane == 0) { ((float*)(sm + SM_FLAST))[u * 4 + h] = tot; ((float*)(sm + SM_AMAX))[u * 4 + h] = am; } } }
    }
    __syncthreads();
}

__device__ __forceinline__ int tsw(int row, int l, int sh) { return row * 72 + ((((l >> 3) ^ (row >> sh)) & 7) << 3) + (l & 7); }
__device__ __forceinline__ bf16x8 fragsw(const LAS bf16* base, int rt  , int ks, int lane, int sh) {
    return *(const LAS bf16x8*)(base + (16 * rt + (lane & 15)) * 72 + ((((4 * ks + (lane >> 4)) ^ ((16 * rt) >> sh)) & 7) << 3));
}
#define MMA4F(a, b, c) __builtin_amdgcn_mfma_f32_16x16x4f32(a, b, c, 0, 0, 0)

struct GdnPre { u32x4 z[3]; f32x4 cw; };
#define GDN_ZLOAD(ugx, tz, R) do { const int _b = (ugx) >> 9, _h = ((ugx) >> 6) & 7, _c = (ugx) & 63; const bf16* _zb = (const bf16*)(a.ws + WS_Z) + ((long)(_b * SEQL + _c * 64 - 3)) * NZ + (tz) * 1024 + _h * 128 + (tid & 15) * 8; \
        _Pragma("unroll") for (int _k = 0; _k < 3; ++_k) { const int _r = (tid >> 4) + 32 * _k; const bool _ok = (_k < 2 || tid < 48) && (_c * 64 - 3 + _r >= 0); \
            (R)[_k] = _ok ? *(const u32x4*)(_zb + (long)_r * NZ) : (u32x4){0u, 0u, 0u, 0u}; } } while (0)
#define GDN_ZPUT(R, ZSx) do { *(LAS u32x4*)((ZSx) + ((tid >> 4)) * 136 + (tid & 15) * 8) = (R)[0]; *(LAS u32x4*)((ZSx) + ((tid >> 4) + 32) * 136 + (tid & 15) * 8) = (R)[1]; \
        if (tid < 48) *(LAS u32x4*)((ZSx) + ((tid >> 4) + 64) * 136 + (tid & 15) * 8) = (R)[2]; } while (0)
#define GDN_CWLOAD(ugx, dst) do { if (tid < 384) { const int _h = ((ugx) >> 6) & 7, _tj = tid >> 5; (dst) = *(const f32x4*)(argin(a, 4) + (_tj & 3) * 3072 + (_tj >> 2) * 1024 + _h * 128 + (tid & 31) * 4); } } while (0)
#define GDN_CONV(tz, ZSx, out) do { _Pragma("unroll") for (int _i = 0; _i < 16; ++_i) (out)[_i] = 0.f; \
        _Pragma("unroll") for (int _j = 0; _j < 4; ++_j) { const LAS bf16* _zr = (ZSx) + (l + _j) * 136 + cg * 16; const u32x4 _w0 = *(const LAS u32x4*)_zr, _w1 = *(const LAS u32x4*)(_zr + 8); \
            const LAS float* _cw = CWs + ((tz) * 4 + _j) * 128 + cg * 16; const f32x4 _c0 = *(const LAS f32x4*)_cw, _c1 = *(const LAS f32x4*)(_cw + 4), _c2 = *(const LAS f32x4*)(_cw + 8), _c3 = *(const LAS f32x4*)(_cw + 12); \
            (out)[0] += _c0[0] * bflo(_w0.x); (out)[1] += _c0[1] * bfhi(_w0.x); (out)[2] += _c0[2] * bflo(_w0.y); (out)[3] += _c0[3] * bfhi(_w0.y); \
            (out)[4] += _c1[0] * bflo(_w0.z); (out)[5] += _c1[1] * bfhi(_w0.z); (out)[6] += _c1[2] * bflo(_w0.w); (out)[7] += _c1[3] * bfhi(_w0.w); \
            (out)[8] += _c2[0] * bflo(_w1.x); (out)[9] += _c2[1] * bfhi(_w1.x); (out)[10] += _c2[2] * bflo(_w1.y); (out)[11] += _c2[3] * bfhi(_w1.y); \
            (out)[12] += _c3[0] * bflo(_w1.z); (out)[13] += _c3[1] * bfhi(_w1.z); (out)[14] += _c3[2] * bflo(_w1.w); (out)[15] += _c3[3] * bfhi(_w1.w); } \
        _Pragma("unroll") for (int _i = 0; _i < 16; ++_i) { const float _v = (out)[_i]; (out)[_i] = _v * __builtin_amdgcn_rcpf(1.f + __expf(-_v)); } } while (0)

__device__ __forceinline__ void gdn_prep_unit(const Args& a, int ug, int ug_next, GdnPre& pre, LAS unsigned char* lds, int tid, int wid, int lane) {
    asm volatile("" : "+v"(tid), "+v"(lane));
    unsigned char* ws = a.ws; unsigned char* sm = ws + WS_SMALL;
    LAS bf16* KDt = (LAS bf16*)lds; LAS bf16* KBGt = (LAS bf16*)(lds + 18432); LAS bf16* VBt = (LAS bf16*)(lds + 36864); LAS bf16* Qs = (LAS bf16*)(lds + 55296); LAS bf16* Ks = (LAS bf16*)(lds + 72704);
    LAS bf16* GTt = (LAS bf16*)(lds + 55296); LAS bf16* Ti = (LAS bf16*)(lds + 73728); LAS bf16* TiT = (LAS bf16*)(lds + 82944);
    LAS float* Mm = (LAS float*)(lds + 92160); LAS float* TT = (LAS float*)(lds + 109568); LAS float* Td = (LAS float*)(lds + 126976); LAS float* gcs = (LAS float*)(lds + 134752); LAS float* bts = (LAS float*)(lds + 135008);
    LAS bf16* ZS0 = (LAS bf16*)(lds + 92160); LAS bf16* ZS1 = (LAS bf16*)(lds + 110384); LAS float* CWs = (LAS float*)(lds + 128608);
    const int b = ug >> 9, h = (ug >> 6) & 7, c = ug & 63, t0 = b * SEQL + c * 64;
    const int l = tid >> 3, cg = tid & 7, g4 = lane >> 4, c15 = lane & 15;
    const float gcl = ((const float*)(sm + SM_GC))[(t0 + l) * 8 + h], btl = ((const float*)(sm + SM_BETA))[(t0 + l) * 8 + h], gclast = ((const float*)(sm + SM_GC))[(t0 + 63) * 8 + h];
    {
        float qv[16], kv[16], vv[16]; u32x4 R[3];
        GDN_ZPUT(pre.z, ZS0); if (tid < 384) *(LAS f32x4*)(CWs + 4 * tid) = pre.cw;
        GDN_ZLOAD(ug, 1, R);
        __syncthreads();
        GDN_CONV(0, ZS0, qv);
        GDN_ZPUT(R, ZS1); GDN_ZLOAD(ug, 2, R);
        __syncthreads();
        GDN_CONV(1, ZS1, kv);
        GDN_ZPUT(R, ZS0);
        if (ug_next >= 0) { GDN_ZLOAD(ug_next, 0, pre.z); GDN_CWLOAD(ug_next, pre.cw); }
        __syncthreads();
        GDN_CONV(2, ZS0, vv);
        float sq = 0.f, sk = 0.f;
#pragma unroll
        for (int i = 0; i < 16; ++i) { sq += qv[i] * qv[i]; sk += kv[i] * kv[i]; }
#pragma unroll
        for (int o = 1; o < 8; o <<= 1) { sq += __shfl_xor(sq, o); sk += __shfl_xor(sk, o); }
        const float rq = rsqrtf(sq + EPS) * 0.08838834764831845f, rk = rsqrtf(sk + EPS);
        const float eg = expf(gcl), ekd = expf(gclast - gcl);
        unsigned qw[8], kw[8], qdw[8];
#pragma unroll
        for (int i = 0; i < 8; ++i) { const float q0 = qv[2 * i] * rq, q1 = qv[2 * i + 1] * rq, k0 = kv[2 * i] * rk, k1 = kv[2 * i + 1] * rk;
            qw[i] = pk2(q0, q1); kw[i] = pk2(k0, k1); qdw[i] = pk2(q0 * eg, q1 * eg);
            const int d = cg * 16 + 2 * i;
            KBGt[tsw(d, l, 4)] = f2bf(k0 * btl * eg); KBGt[tsw(d + 1, l, 4)] = f2bf(k1 * btl * eg);
            KDt[tsw(d, l, 4)] = f2bf(k0 * ekd); KDt[tsw(d + 1, l, 4)] = f2bf(k1 * ekd);
            VBt[tsw(d, l, 4)] = f2bf(vv[2 * i] * btl); VBt[tsw(d + 1, l, 4)] = f2bf(vv[2 * i + 1] * btl); }
        *(LAS u32x4*)(Qs + l * 136 + cg * 16) = (u32x4){qw[0], qw[1], qw[2], qw[3]}; *(LAS u32x4*)(Qs + l * 136 + cg * 16 + 8) = (u32x4){qw[4], qw[5], qw[6], qw[7]};
        *(LAS u32x4*)(Ks + l * 136 + cg * 16) = (u32x4){kw[0], kw[1], kw[2], kw[3]}; *(LAS u32x4*)(Ks + l * 136 + cg * 16 + 8) = (u32x4){kw[4], kw[5], kw[6], kw[7]};
        bf16* qd = (bf16*)(ws + WS_GQD) + (size_t)ug * 8192 + l * 128 + cg * 16;
        *(u32x4*)qd = (u32x4){qdw[0], qdw[1], qdw[2], qdw[3]}; *(u32x4*)(qd + 8) = (u32x4){qdw[4], qdw[5], qdw[6], qdw[7]};
        if (cg == 0) { gcs[l] = gcl; bts[l] = btl; }
    }
    __syncthreads();
    {
        const int wv = wid & 3; const bool isQ = wid >= 4; const LAS bf16* Ab = isQ ? Qs : Ks;
        f32x4 acc[4];
#pragma unroll
        for (int n = 0; n < 4; ++n) acc[n] = (f32x4){0.f, 0.f, 0.f, 0.f};
#pragma unroll
        for (int ks = 0; ks < 4; ++ks) { const bf16x8 af = frag(Ab, 16 * wv, 136, 32 * ks, lane);
#pragma unroll
            for (int n = 0; n < 4; ++n) acc[n] = MMA16(af, frag(Ks, 16 * n, 136, 32 * ks, lane), acc[n]); }
        bf16* AT = (bf16*)(ws + WS_GAT) + (size_t)ug * 4096;
#pragma unroll
        for (int n = 0; n < 4; ++n)
#pragma unroll
            for (int rg = 0; rg < 4; ++rg) { const int i = 16 * wv + 4 * g4 + rg, j = 16 * n + c15;
                const float dec = (j <= i) ? __expf(gcs[i] - gcs[j]) : 0.f;
                if (!isQ) Mm[i * 68 + j] = (j < i) ? bts[i] * acc[n][rg] * dec : 0.f;
                else AT[i * 64 + j] = f2bf(acc[n][rg] * dec); }
    }
    __syncthreads();
    if (wid == 0) {
        const int blk = g4;
        unsigned mb = (unsigned)(size_t)(Mm + (16 * blk) * 68 + 16 * blk), ml = mb + 4u * (unsigned)c15;
        asm volatile("" : "+v"(mb), "+v"(ml));
        float X[16];
#pragma unroll
        for (int i = 0; i < 16; ++i) { float s = -*(const LAS float*)(size_t)(ml + (unsigned)(i * 68 * 4));
#pragma unroll
            for (int j4 = 0; j4 < (i + 3) / 4; ++j4) { const f32x4 mv = *(const LAS f32x4*)(size_t)(mb + (unsigned)((i * 68 + 4 * j4) * 4));
#pragma unroll
                for (int q = 0; q < 4; ++q) if (4 * j4 + q < i) s -= mv[q] * X[4 * j4 + q]; }
            X[i] = s; }
        const float cf = (float)c15;
#pragma unroll
        for (int i = 0; i < 16; ++i) { X[i] += fmaxf(0.f, 1.f - fabsf(cf - (float)i)); Td[(blk * 16 + i) * 20 + c15] = X[i]; Ti[(16 * blk + i) * 72 + 16 * blk + c15] = f2bf(X[i]); }
        LAS float* ttp = TT + (16 * blk + c15) * 68 + 16 * blk; LAS bf16* tip = TiT + (16 * blk + c15) * 72 + 16 * blk;
#pragma unroll
        for (int i4 = 0; i4 < 4; ++i4) *(LAS f32x4*)(ttp + 4 * i4) = (f32x4){X[4 * i4], X[4 * i4 + 1], X[4 * i4 + 2], X[4 * i4 + 3]};
        *(LAS u32x4*)tip = (u32x4){pk2(X[0], X[1]), pk2(X[2], X[3]), pk2(X[4], X[5]), pk2(X[6], X[7])}; *(LAS u32x4*)(tip + 8) = (u32x4){pk2(X[8], X[9]), pk2(X[10], X[11]), pk2(X[12], X[13]), pk2(X[14], X[15])};
    } else if (wid >= 4) {
        for (int p = tid - 256; p < 384; p += 256) { const int arr = p / 192, q = p - arr * 192, bi6 = q >> 5, r = (q & 31) >> 1, hf = q & 1;
            const int bi = bi6 < 3 ? 0 : (bi6 < 5 ? 1 : 2), bj = bi6 < 3 ? bi6 + 1 : (bi6 < 5 ? bi6 - 1 : 3);
            if (arr) *(LAS u32x4*)(TiT + (16 * bj + r) * 72 + 16 * bi + 8 * hf) = (u32x4){0u, 0u, 0u, 0u};
            else *(LAS u32x4*)(Ti + (16 * bi + r) * 72 + 16 * bj + 8 * hf) = (u32x4){0u, 0u, 0u, 0u}; }
    }
    __syncthreads();
#pragma unroll
    for (int dg = 1; dg < 4; ++dg) {
        if (wid < 4 - dg) { const int bi = wid + dg, bj = wid;
            f32x4 P = (f32x4){0.f, 0.f, 0.f, 0.f};
            for (int k = bj; k < bi; ++k) { const f32x4 a4 = *(const LAS f32x4*)(Mm + (16 * bi + c15) * 68 + 16 * k + 4 * g4), b4 = *(const LAS f32x4*)(TT + (16 * bj + c15) * 68 + 16 * k + 4 * g4);
#pragma unroll
                for (int s = 0; s < 4; ++s) P = MMA4F(a4[s], b4[s], P); }
            const f32x4 t4 = *(const LAS f32x4*)(Td + (bi * 16 + c15) * 20 + 4 * g4);
            f32x4 Q = (f32x4){0.f, 0.f, 0.f, 0.f};
#pragma unroll
            for (int s = 0; s < 4; ++s) Q = MMA4F(t4[s], P[s], Q);
            Q = -Q;
            *(LAS f32x4*)(TT + (16 * bj + c15) * 68 + 16 * bi + 4 * g4) = Q;
            *(LAS u32x2*)(TiT + (16 * bj + c15) * 72 + 16 * bi + 4 * g4) = (u32x2){pk2(Q[0], Q[1]), pk2(Q[2], Q[3])};
#pragma unroll
            for (int rg = 0; rg < 4; ++rg) Ti[(16 * bi + 4 * g4 + rg) * 72 + 16 * bj + c15] = f2bf(Q[rg]);
        }
        __syncthreads();
    }
    {
        const int wv = wid & 3; const LAS bf16* Bb = wid < 4 ? VBt : KBGt; bf16* OUT = (bf16*)(ws + (wid < 4 ? WS_GU : WS_GW)) + (size_t)ug * 8192;
#pragma unroll
        for (int e2 = 0; e2 < 2; ++e2) { const int en = 2 * wv + e2; f32x4 acc[4];
#pragma unroll
            for (int it = 0; it < 4; ++it) acc[it] = (f32x4){0.f, 0.f, 0.f, 0.f};
#pragma unroll
            for (int ks = 0; ks < 2; ++ks) { const bf16x8 af = fragsw(Bb, en, ks, lane, 4);
#pragma unroll
                for (int it = 0; it < 4; ++it) acc[it] = MMA16(af, frag(Ti, 16 * it, 72, 32 * ks, lane), acc[it]); }
#pragma unroll
            for (int it = 0; it < 4; ++it) { const u32x2 pv = (u32x2){pk2(acc[it][0], acc[it][1]), pk2(acc[it][2], acc[it][3])};
                *(u32x2*)(OUT + (((en * 4 + it) * 64) + lane) * 4) = pv; } }
    }
    {
        const int mt = wid & 3;
#pragma unroll
        for (int d4 = 0; d4 < 4; ++d4) { const int dn = (wid >> 2) * 4 + d4; f32x4 acc = (f32x4){0.f, 0.f, 0.f, 0.f};
#pragma unroll
            for (int ks = 0; ks < 2; ++ks) acc = MMA16(frag(TiT, 16 * mt, 72, 32 * ks, lane), fragsw(KDt, dn, ks, lane, 4), acc);
            *(LAS u32x2*)(GTt + (16 * dn + c15) * 72 + 16 * mt + 4 * g4) = (u32x2){pk2(acc[0], acc[1]), pk2(acc[2], acc[3])}; }
        if (tid == 0) ((float*)(sm + SM_GLAST))[ug] = expf(gcs[63]);
    }
    __syncthreads();
    {
        bf16* AP = (bf16*)(ws + WS_GAP) + (size_t)ug * 16384; bf16* BB = (bf16*)(ws + WS_GBB) + (size_t)ug * 16384;
        bf16x8 kf[2], gf[2];
#pragma unroll
        for (int ks = 0; ks < 2; ++ks) { kf[ks] = fragsw(KBGt, wid, ks, lane, 4); gf[ks] = frag(GTt, 16 * wid, 72, 32 * ks, lane); }
#pragma unroll
        for (int n = 0; n < 8; ++n) { f32x4 a1 = (f32x4){0.f, 0.f, 0.f, 0.f}, b1 = (f32x4){0.f, 0.f, 0.f, 0.f};
#pragma unroll
            for (int ks = 0; ks < 2; ++ks) { a1 = MMA16(kf[ks], frag(GTt, 16 * n, 72, 32 * ks, lane), a1); b1 = MMA16(gf[ks], fragsw(VBt, n, ks, lane, 4), b1); }
            *(u32x2*)(AP + (((n * 4 + (wid >> 1)) * 64) + ((2 * wid + (g4 >> 1)) & 3) * 16 + c15) * 8 + 4 * (g4 & 1)) = (u32x2){pk2(-a1[0], -a1[1]), pk2(-a1[2], -a1[3])};
            *(u32x2*)(BB + (((((n >> 1) * 8 + wid) * 2 + (n & 1)) * 64) + lane) * 4) = (u32x2){pk2(b1[0], b1[1]), pk2(b1[2], b1[3])}; }
    }
    __syncthreads();
}

struct MlPre { u32x4 q0, q1, k0, k1, v[4]; float fl, am, fc, ic; };
#define ML_PREP_LOAD(umx, P) do { const int _b = (umx) >> 8, _h = ((umx) >> 6) & 3, _c = (umx) & 63, _t0 = _b * SEQL + _c * 64; const bf16* _zr = (const bf16*)(a.ws + WS_Z) + (size_t)(_t0 + (tid >> 3)) * NZ; const int _cg = tid & 7; \
        (P).q0 = *(const u32x4*)(_zr + ZMQ + _h * 128 + _cg * 16); (P).q1 = *(const u32x4*)(_zr + ZMQ + _h * 128 + _cg * 16 + 8); (P).k0 = *(const u32x4*)(_zr + ZMK + _h * 128 + _cg * 16); (P).k1 = *(const u32x4*)(_zr + ZMK + _h * 128 + _cg * 16 + 8); \
        _Pragma("unroll") for (int _s = 0; _s < 4; ++_s) (P).v[_s] = *(const u32x4*)(_zr + ZMV + _h * 256 + _cg * 32 + _s * 8); \
        if (tid < 64) { const unsigned char* _sm = a.ws + WS_SMALL; (P).fl = ((const float*)(_sm + SM_FLAST))[(_b * 64 + tid) * 4 + _h]; (P).am = ((const float*)(_sm + SM_AMAX))[(_b * 64 + tid) * 4 + _h]; \
            (P).fc = ((const float*)(_sm + SM_FC))[(_t0 + tid) * 4 + _h]; (P).ic = ((const float*)(_sm + SM_IC))[(_t0 + tid) * 4 + _h]; } } while (0)
__device__ __forceinline__ void ml_prep_unit(const Args& a, int um, int um_next, MlPre& pre, LAS unsigned char* lds, int tid, int wid, int lane) {
    asm volatile("" : "+v"(tid), "+v"(lane));
    unsigned char* ws = a.ws; unsigned char* sm = ws + WS_SMALL;
    LAS bf16* Qs = (LAS bf16*)lds; LAS bf16* Ks = (LAS bf16*)(lds + 17408); LAS bf16* VTs = (LAS bf16*)(lds + 34816); LAS bf16* KWTs = (LAS bf16*)(lds + 71680);
    LAS float* FL = (LAS float*)(lds + 90112); LAS float* AM = FL + 64; LAS float* fcs = FL + 128; LAS float* ics = FL + 192; LAS float* mis = FL + 256; LAS float* wks = FL + 320;
    const int c = um & 63;
    const int l = tid >> 3, cg = tid & 7, g4 = lane >> 4, c15 = lane & 15;
    {
        const u32x4 q0 = pre.q0, q1 = pre.q1, k0 = pre.k0, k1 = pre.k1;
        *(LAS u32x4*)(Qs + l * 136 + cg * 16) = q0; *(LAS u32x4*)(Qs + l * 136 + cg * 16 + 8) = q1;
        const float sc = 0.08838834764831845f;
        u32x4 ko0, ko1;
        ko0.x = pk2(bflo(k0.x) * sc, bfhi(k0.x) * sc); ko0.y = pk2(bflo(k0.y) * sc, bfhi(k0.y) * sc); ko0.z = pk2(bflo(k0.z) * sc, bfhi(k0.z) * sc); ko0.w = pk2(bflo(k0.w) * sc, bfhi(k0.w) * sc);
        ko1.x = pk2(bflo(k1.x) * sc, bfhi(k1.x) * sc); ko1.y = pk2(bflo(k1.y) * sc, bfhi(k1.y) * sc); ko1.z = pk2(bflo(k1.z) * sc, bfhi(k1.z) * sc); ko1.w = pk2(bflo(k1.w) * sc, bfhi(k1.w) * sc);
        *(LAS u32x4*)(Ks + l * 136 + cg * 16) = ko0; *(LAS u32x4*)(Ks + l * 136 + cg * 16 + 8) = ko1;
#pragma unroll
        for (int s4 = 0; s4 < 4; ++s4) { const u32x4 v = pre.v[s4]; const int e0 = cg * 32 + s4 * 8;
            VTs[tsw(e0 + 0, l, 5)] = (bf16)(v.x & 0xffffu); VTs[tsw(e0 + 1, l, 5)] = (bf16)(v.x >> 16); VTs[tsw(e0 + 2, l, 5)] = (bf16)(v.y & 0xffffu); VTs[tsw(e0 + 3, l, 5)] = (bf16)(v.y >> 16);
            VTs[tsw(e0 + 4, l, 5)] = (bf16)(v.z & 0xffffu); VTs[tsw(e0 + 5, l, 5)] = (bf16)(v.z >> 16); VTs[tsw(e0 + 6, l, 5)] = (bf16)(v.w & 0xffffu); VTs[tsw(e0 + 7, l, 5)] = (bf16)(v.w >> 16); }
        if (tid < 64) { FL[tid] = pre.fl; AM[tid] = pre.am; fcs[tid] = pre.fc; ics[tid] = pre.ic; }
        if (um_next >= 0) ML_PREP_LOAD(um_next, pre);
    }
    __syncthreads();
    if (tid < 64) {
        float A = FL[tid], B = AM[tid], v = ics[tid] - fcs[tid];
#pragma unroll
        for (int off = 1; off < 64; off <<= 1) { const float Ap = __shfl_up(A, off), Bp = __shfl_up(B, off), vp = __shfl_up(v, off);
            if (tid >= off) { B = fmaxf(Bp + A, B); A = Ap + A; v = fmaxf(v, vp); } }
        const float mm = fmaxf(A, B);
        float mprev = __shfl_up(mm, 1); if (tid == 0) mprev = 0.f;
        const float mst = __shfl(mprev, c), mn = __shfl(mm, c), flc = FL[c];
        if (tid == 0) ((float*)(sm + SM_MDEC))[um] = expf(flc + mst - mn);
        const float inter = fcs[tid] + mst, mi = fmaxf(fcs[tid] + v, inter); mis[tid] = mi;
        ((float*)(sm + SM_MSI))[um * 64 + tid] = expf(inter - mi); ((float*)(sm + SM_MEN))[um * 64 + tid] = expf(-mi); wks[tid] = expf(flc - fcs[tid] + ics[tid] - mn); }
    __syncthreads();
    if (wid < 4) {
        f32x4 acc[4];
#pragma unroll
        for (int n = 0; n < 4; ++n) acc[n] = (f32x4){0.f, 0.f, 0.f, 0.f};
#pragma unroll
        for (int ks = 0; ks < 4; ++ks) { const bf16x8 af = frag(Qs, 16 * wid, 136, 32 * ks, lane);
#pragma unroll
            for (int n = 0; n < 4; ++n) acc[n] = MMA16(af, frag(Ks, 16 * n, 136, 32 * ks, lane), acc[n]); }
        bf16* WT = (bf16*)(ws + WS_MWT) + (size_t)um * 4096; float rsum[4] = {0.f, 0.f, 0.f, 0.f};
#pragma unroll
        for (int n = 0; n < 4; ++n)
#pragma unroll
            for (int rg = 0; rg < 4; ++rg) { const int i = 16 * wid + 4 * g4 + rg, j = 16 * n + c15;
                const float wv = (j <= i) ? __expf(fcs[i] - fcs[j] + ics[j] - mis[i]) * acc[n][rg] : 0.f; rsum[rg] += wv; WT[i * 64 + j] = f2bf(wv); }
#pragma unroll
        for (int rg = 0; rg < 4; ++rg) { float s = rsum[rg];
#pragma unroll
            for (int o = 1; o < 16; o <<= 1) s += __shfl_xor(s, o);
            if (c15 == 0) ((float*)(sm + SM_MWS))[um * 64 + 16 * wid + 4 * g4 + rg] = s; }
    } else {
        const int t2 = tid - 256, l2 = t2 >> 2, part = t2 & 3; const float wk = wks[l2];
#pragma unroll 8
        for (int i = 0; i < 32; ++i) { const int d = part * 32 + i; KWTs[tsw(d, l2, 5)] = f2bf(wk * bf2f(Ks[l2 * 136 + d])); }
    }
    __syncthreads();
    {
        bf16* BM = (bf16*)(ws + WS_MBM) + (size_t)um * 32768;
        bf16x8 kf[2];
#pragma unroll
        for (int ks = 0; ks < 2; ++ks) kf[ks] = fragsw(KWTs, wid, ks, lane, 5);
#pragma unroll
        for (int n = 0; n < 16; ++n) { f32x4 b1 = (f32x4){0.f, 0.f, 0.f, 0.f};
#pragma unroll
            for (int ks = 0; ks < 2; ++ks) b1 = MMA16(kf[ks], fragsw(VTs, n, ks, lane, 5), b1);
            *(u32x2*)(BM + (((n * 8 + wid) * 64) + lane) * 4) = (u32x2){pk2(b1[0], b1[1]), pk2(b1[2], b1[3])}; }
        if (tid < 128) { float s = 0.f;
#pragma unroll
            for (int c8 = 0; c8 < 8; ++c8) { const u32x4 kv = *(const LAS u32x4*)(KWTs + tid * 72 + c8 * 8); s += (bflo(kv.x) + bfhi(kv.x)) + (bflo(kv.y) + bfhi(kv.y)) + (bflo(kv.z) + bfhi(kv.z)) + (bflo(kv.w) + bfhi(kv.w)); }
            ((float*)(sm + SM_MKS))[um * 128 + tid] = s; }
        bf16* VT = (bf16*)(ws + WS_MVT) + (size_t)um * 16384;
        for (int p = tid; p < 2048; p += 512) { const int row = p >> 3, seg = p & 7; *(u32x4*)(VT + row * 64 + seg * 8) = *(const LAS u32x4*)(VTs + row * 72 + ((seg ^ (row >> 5)) & 7) * 8); }
    }
    __syncthreads();
}

__device__ __forceinline__ void gdn_scan_item(const Args& a, int item, LAS unsigned char* lds, int tid, int wid, int lane) {
    asm volatile("" : "+v"(tid), "+v"(lane));
    unsigned char* ws = a.ws; unsigned char* sm = ws + WS_SMALL;
    LAS bf16* STs = (LAS bf16*)lds;
    LAS float* gls = (LAS float*)(lds + 8704);
    const int bh = item >> 3, n = item & 7, g4 = lane >> 4, c15 = lane & 15;
    const int ug0 = bh * 64;
    const size_t toff = (size_t)ug0 * 16384 + (size_t)(((((n >> 1) * 8 + wid) * 2 + (n & 1)) * 64) + lane) * 4;
    const bf16* APl = (const bf16*)(ws + WS_GAP) + (size_t)ug0 * 16384 + wid * 2048 + lane * 8;
    const bf16* BBl = (const bf16*)(ws + WS_GBB) + toff; bf16* SSl = (bf16*)(ws + WS_GSS) + toff;
    f32x4 S = (f32x4){0.f, 0.f, 0.f, 0.f};
    for (int i = tid; i < 16 * 136; i += 512) STs[i] = 0;
    if (tid < 64) gls[tid] = ((const float*)(sm + SM_GLAST))[ug0 + tid];
    u32x4 ap[8][4]; u32x2 bb[8];
#define GS_FILL(st, c) do { const bf16* _pa = APl + (size_t)(c) * 16384; const bf16* _pb = BBl + (size_t)(c) * 16384; \
        asm volatile("global_load_dwordx4 %0, %5, off\n\tglobal_load_dwordx4 %1, %5, off offset:1024\n\tglobal_load_dwordx4 %2, %5, off offset:2048\n\tglobal_load_dwordx4 %3, %5, off offset:3072\n\t" \
                     "global_load_dwordx2 %4, %6, off" \
                     : "=&v"(ap[st][0]), "=&v"(ap[st][1]), "=&v"(ap[st][2]), "=&v"(ap[st][3]), "=&v"(bb[st]) : "v"(_pa), "v"(_pb) : "memory"); } while (0)
#pragma unroll
    for (int st = 0; st < 8; ++st) GS_FILL(st, st);
    int cur = 0;
    __syncthreads();
    for (int c0 = 0; c0 < 64; c0 += 8) {
#pragma unroll
        for (int st = 0; st < 8; ++st) { const int c = c0 + st;
            asm volatile("s_waitcnt vmcnt(30)" : "+v"(ap[st][0]), "+v"(ap[st][1]), "+v"(ap[st][2]), "+v"(ap[st][3]), "+v"(bb[st]) :: "memory");
            const LAS bf16* STc = STs + cur * (16 * 136); LAS bf16* STn = STs + (cur ^ 1) * (16 * 136);
            const float gl = gls[c];
            *(u32x2*)(SSl + (size_t)c * 16384) = (u32x2){pk2(S[0], S[1]), pk2(S[2], S[3])};
            f32x4 acc; acc[0] = gl * S[0] + bflo(bb[st].x); acc[1] = gl * S[1] + bfhi(bb[st].x); acc[2] = gl * S[2] + bflo(bb[st].y); acc[3] = gl * S[3] + bfhi(bb[st].y);
#pragma unroll
            for (int ks = 0; ks < 4; ++ks) acc = MMA16(__builtin_bit_cast(bf16x8, ap[st][ks]), frag(STc, 0, 136, 32 * ks, lane), acc);
            S = acc; *(LAS u32x2*)(STn + c15 * 136 + 16 * wid + 4 * g4) = (u32x2){pk2(acc[0], acc[1]), pk2(acc[2], acc[3])};
            { const int cn = c + 8 < 64 ? c + 8 : 63; GS_FILL(st, cn); }
            __syncthreads();
            cur ^= 1;
        }
    }
    asm volatile("s_waitcnt vmcnt(0)" ::: "memory");
#undef GS_FILL
}
__device__ __forceinline__ void ml_scan_item(const Args& a, int item, int tid) {
    unsigned char* ws = a.ws; unsigned char* sm = ws + WS_SMALL;
    const int bh = item >> 4, part = item & 15, um0 = bh * 64; const size_t el = (size_t)part * 2048 + (size_t)tid * 4;
    const bf16* BM = (const bf16*)(ws + WS_MBM) + (size_t)um0 * 32768 + el; bf16* CS = (bf16*)(ws + WS_MCS) + (size_t)um0 * 32768 + el;
    const float* DEC = (const float*)(sm + SM_MDEC) + um0; const float* KS = (const float*)(sm + SM_MKS) + um0 * 128; float* NS = (float*)(sm + SM_MNS) + um0 * 128;
    float C[4] = {0.f, 0.f, 0.f, 0.f}; float n = 0.f; const bool don = (part == 0 && tid < 128);
    for (int c0 = 0; c0 < 64; c0 += 16) {
        u32x2 bv[16]; float dc[16], kv[16];
#pragma unroll
        for (int j = 0; j < 16; ++j) { bv[j] = *(const u32x2*)(BM + (size_t)(c0 + j) * 32768); dc[j] = DEC[c0 + j]; kv[j] = don ? KS[(c0 + j) * 128 + tid] : 0.f; }
#pragma unroll
        for (int j = 0; j < 16; ++j) {
            *(u32x2*)(CS + (size_t)(c0 + j) * 32768) = (u32x2){pk2(C[0], C[1]), pk2(C[2], C[3])};
            if (don) { NS[(c0 + j) * 128 + tid] = n; n = dc[j] * n + kv[j]; }
            C[0] = dc[j] * C[0] + bflo(bv[j].x); C[1] = dc[j] * C[1] + bfhi(bv[j].x); C[2] = dc[j] * C[2] + bflo(bv[j].y); C[3] = dc[j] * C[3] + bfhi(bv[j].y); }
    }
}

struct GdnOutPre { u32x4 s4[4], w2[2], q2[2], a1, z0, z1; u32x2 u4[4]; };
#define GDN_OUT_LOAD(ugx, P) do { const bf16* _S = (const bf16*)(a.ws + WS_GSS) + (size_t)(ugx) * 16384; const bf16* _W = (const bf16*)(a.ws + WS_GW) + (size_t)(ugx) * 8192; const bf16* _Q = (const bf16*)(a.ws + WS_GQD) + (size_t)(ugx) * 8192; \
        const bf16* _A = (const bf16*)(a.ws + WS_GAT) + (size_t)(ugx) * 4096; const bf16* _U = (const bf16*)(a.ws + WS_GU) + (size_t)(ugx) * 8192; \
        _Pragma("unroll") for (int _i = 0; _i < 4; ++_i) (P).s4[_i] = *(const u32x4*)(_S + (tid + 512 * _i) * 8); \
        _Pragma("unroll") for (int _i = 0; _i < 2; ++_i) { const int _p = tid + 512 * _i; (P).w2[_i] = *(const u32x4*)(_W + _p * 8); (P).q2[_i] = *(const u32x4*)(_Q + (_p >> 4) * 128 + (_p & 15) * 8); } \
        (P).a1 = *(const u32x4*)(_A + (tid >> 3) * 64 + (tid & 7) * 8); \
        _Pragma("unroll") for (int _lt = 0; _lt < 4; ++_lt) (P).u4[_lt] = *(const u32x2*)(_U + ((((tid >> 6) * 4 + _lt) * 64) + (tid & 63)) * 4); \
        { const int _b = (ugx) >> 9, _h = ((ugx) >> 6) & 7, _c = (ugx) & 63; const bf16* _zr = (const bf16*)(a.ws + WS_Z) + (size_t)(_b * SEQL + _c * 64 + (tid >> 3)) * NZ + ZG + _h * 128 + (tid & 7) * 16; \
          (P).z0 = *(const u32x4*)_zr; (P).z1 = *(const u32x4*)(_zr + 8); } } while (0)
__device__ __forceinline__ void gdn_out_unit(const Args& a, int ug, int ug_next, GdnOutPre& pre, LAS unsigned char* lds, int tid, int wid, int lane) {
    asm volatile("" : "+v"(tid), "+v"(lane));
    unsigned char* ws = a.ws;
    LAS bf16* Ss = (LAS bf16*)lds; LAS bf16* Ws = (LAS bf16*)(lds + 34816); LAS bf16* QDs = (LAS bf16*)(lds + 52224); LAS bf16* ATs = (LAS bf16*)(lds + 69632); LAS bf16* VNt = (LAS bf16*)(lds + 78848);
    LAS float* Os = (LAS float*)lds;
    const int b = ug >> 9, h = (ug >> 6) & 7, c = ug & 63, t0 = b * SEQL + c * 64, g4 = lane >> 4, c15 = lane & 15;
    u32x2 u4r[4]; u32x4 z0, z1;
    {
#pragma unroll
        for (int i = 0; i < 4; ++i) { const int p = tid + 512 * i;
#pragma unroll
            for (int hq = 0; hq < 2; ++hq) { const int q = 2 * p + hq, lr = q & 63, et = (q >> 6) & 1, w = (q >> 7) & 7, es = q >> 10;
                *(LAS u32x2*)(Ss + (es * 32 + 16 * et + (lr & 15)) * 136 + 16 * w + 4 * (lr >> 4)) = hq ? (u32x2){pre.s4[i].z, pre.s4[i].w} : (u32x2){pre.s4[i].x, pre.s4[i].y}; } }
#pragma unroll
        for (int i = 0; i < 2; ++i) { const int p = tid + 512 * i; *(LAS u32x4*)(QDs + (p >> 4) * 136 + (p & 15) * 8) = pre.q2[i];
#pragma unroll
            for (int hq = 0; hq < 2; ++hq) { const int q = 2 * p + hq, lr = q & 63, it = (q >> 6) & 3, en = q >> 8;
                *(LAS u32x2*)(Ws + (16 * it + (lr & 15)) * 136 + 16 * en + 4 * (lr >> 4)) = hq ? (u32x2){pre.w2[i].z, pre.w2[i].w} : (u32x2){pre.w2[i].x, pre.w2[i].y}; } }
        *(LAS u32x4*)(ATs + (tid >> 3) * 72 + (tid & 7) * 8) = pre.a1;
#pragma unroll
        for (int lt = 0; lt < 4; ++lt) u4r[lt] = pre.u4[lt];
        z0 = pre.z0; z1 = pre.z1;
        if (ug_next >= 0) GDN_OUT_LOAD(ug_next, pre);
    }
    __syncthreads();
    f32x4 O[4];
    {
        bf16x8 sf[4];
#pragma unroll
        for (int ks = 0; ks < 4; ++ks) sf[ks] = frag(Ss, 16 * wid, 136, 32 * ks, lane);
#pragma unroll
        for (int lt = 0; lt < 4; ++lt) { f32x4 P = (f32x4){0.f, 0.f, 0.f, 0.f}; const u32x2 u4 = u4r[lt];
#pragma unroll
            for (int ks = 0; ks < 4; ++ks) P = MMA16(sf[ks], frag(Ws, 16 * lt, 136, 32 * ks, lane), P);
            const float v0 = bflo(u4.x) - P[0], v1 = bfhi(u4.x) - P[1], v2 = bflo(u4.y) - P[2], v3 = bfhi(u4.y) - P[3];
            LAS bf16* vp = VNt + (16 * wid + 4 * g4) * 72 + 16 * lt + c15; vp[0] = f2bf(v0); vp[72] = f2bf(v1); vp[144] = f2bf(v2); vp[216] = f2bf(v3); }
        LDS_WAIT();
#pragma unroll
        for (int lt = 0; lt < 4; ++lt) { f32x4 o = (f32x4){0.f, 0.f, 0.f, 0.f};
#pragma unroll
            for (int ks = 0; ks < 4; ++ks) o = MMA16(frag(QDs, 16 * lt, 136, 32 * ks, lane), sf[ks], o);
#pragma unroll
            for (int ks = 0; ks < 2; ++ks) o = MMA16(frag(ATs, 16 * lt, 72, 32 * ks, lane), frag(VNt, 16 * wid, 72, 32 * ks, lane), o);
            O[lt] = o; }
    }
    __syncthreads();
#pragma unroll
    for (int lt = 0; lt < 4; ++lt)
#pragma unroll
        for (int rg = 0; rg < 4; ++rg) Os[(16 * lt + 4 * g4 + rg) * 132 + 16 * wid + c15] = O[lt][rg];
    __syncthreads();
    {
        const int l = tid >> 3, cg = tid & 7; const LAS f32x4* op = (const LAS f32x4*)(Os + l * 132 + cg * 16);
        const f32x4 o0 = op[0], o1 = op[1], o2 = op[2], o3 = op[3];
        float ss = ((o0[0] * o0[0] + o0[1] * o0[1]) + (o0[2] * o0[2] + o0[3] * o0[3])) + ((o1[0] * o1[0] + o1[1] * o1[1]) + (o1[2] * o1[2] + o1[3] * o1[3]))
                 + ((o2[0] * o2[0] + o2[1] * o2[1]) + (o2[2] * o2[2] + o2[3] * o2[3])) + ((o3[0] * o3[0] + o3[1] * o3[1]) + (o3[2] * o3[2] + o3[3] * o3[3]));
#pragma unroll
        for (int o = 1; o < 8; o <<= 1) ss += __shfl_xor(ss, o);
        const float r = rsqrtf(ss * (1.f / 128.f) + EPS);
        const LAS float* gn = (const LAS float*)(lds + GN_LDS) + cg * 16; const f32x4 g0 = *(const LAS f32x4*)gn, g1 = *(const LAS f32x4*)(gn + 4), g2 = *(const LAS f32x4*)(gn + 8), g3 = *(const LAS f32x4*)(gn + 12);
#define GY(ov, gv, zw, k) pk2(ov[2 * (k)] * r * gv[2 * (k)] * (bflo(zw) * sigm(bflo(zw))), ov[2 * (k) + 1] * r * gv[2 * (k) + 1] * (bfhi(zw) * sigm(bfhi(zw))))
        bf16* yp = (bf16*)(ws + WS_Y) + (size_t)(t0 + l) * DM + h * 128 + cg * 16;
        *(u32x4*)yp = (u32x4){GY(o0, g0, z0.x, 0), GY(o0, g0, z0.y, 1), GY(o1, g1, z0.z, 0), GY(o1, g1, z0.w, 1)};
        *(u32x4*)(yp + 8) = (u32x4){GY(o2, g2, z1.x, 0), GY(o2, g2, z1.y, 1), GY(o3, g3, z1.z, 0), GY(o3, g3, z1.w, 1)};
#undef GY
    }
    __syncthreads();
}
struct MlOutPre { u32x4 c4[8], q2[2], v4[4], w1; float nsv, siv; };
#define ML_OUT_LOAD(umx, P) do { const int _b = (umx) >> 8, _h = ((umx) >> 6) & 3, _c = (umx) & 63, _t0 = _b * SEQL + _c * 64; \
        const bf16* _C = (const bf16*)(a.ws + WS_MCS) + (size_t)(umx) * 32768; const bf16* _Z = (const bf16*)(a.ws + WS_Z); const bf16* _WT = (const bf16*)(a.ws + WS_MWT) + (size_t)(umx) * 4096; const bf16* _VT = (const bf16*)(a.ws + WS_MVT) + (size_t)(umx) * 16384; \
        _Pragma("unroll") for (int _i = 0; _i < 8; ++_i) { const int _p = tid + 512 * _i; (P).c4[_i] = *(const u32x4*)(_C + _p * 8); } \
        _Pragma("unroll") for (int _i = 0; _i < 2; ++_i) { const int _p = tid + 512 * _i; (P).q2[_i] = *(const u32x4*)(_Z + (size_t)(_t0 + (_p >> 4)) * NZ + ZMQ + _h * 128 + (_p & 15) * 8); } \
        _Pragma("unroll") for (int _i = 0; _i < 4; ++_i) { const int _p = tid + 512 * _i; (P).v4[_i] = *(const u32x4*)(_VT + (_p >> 3) * 64 + (_p & 7) * 8); } \
        (P).w1 = *(const u32x4*)(_WT + (tid >> 3) * 64 + (tid & 7) * 8); \
        (P).nsv = tid < 128 ? ((const float*)(a.ws + WS_SMALL + SM_MNS))[(umx) * 128 + tid] : 0.f; (P).siv = tid < 64 ? ((const float*)(a.ws + WS_SMALL + SM_MSI))[(umx) * 64 + tid] : 0.f; } while (0)
__device__ __forceinline__ void ml_out_unit(const Args& a, int um, int um_next, MlOutPre& pre, LAS unsigned char* lds, int tid, int wid, int lane) {
    asm volatile("" : "+v"(tid), "+v"(lane));
    unsigned char* ws = a.ws; unsigned char* sm = ws + WS_SMALL;
    LAS bf16* Cs = (LAS bf16*)lds; LAS bf16* Qs = (LAS bf16*)(lds + 69632); LAS bf16* WTs = (LAS bf16*)(lds + 87040); LAS bf16* VTs = (LAS bf16*)(lds + 96256);
    LAS float* ns = (LAS float*)(lds + 133120); LAS float* sis = ns + 128; LAS float* dns = ns + 192;
    LAS float* Hs = (LAS float*)lds;
    const int b = um >> 8, h = (um >> 6) & 3, c = um & 63, t0 = b * SEQL + c * 64, g4 = lane >> 4, c15 = lane & 15;
    u32x4 zo[4];
    { const bf16* zr0 = (const bf16*)(ws + WS_Z) + (size_t)(t0 + (tid >> 3)) * NZ + ZMO + h * 256 + (tid & 7) * 32;
#pragma unroll
      for (int i = 0; i < 4; ++i) zo[i] = *(const u32x4*)(zr0 + 8 * i); }
    {
#pragma unroll
        for (int i = 0; i < 8; ++i) { const int p = tid + 512 * i;
#pragma unroll
            for (int hq = 0; hq < 2; ++hq) { const int q = 2 * p + hq, lr = q & 63, w = (q >> 6) & 7, n = q >> 9;
                *(LAS u32x2*)(Cs + (16 * n + (lr & 15)) * 136 + 16 * w + 4 * (lr >> 4)) = hq ? (u32x2){pre.c4[i].z, pre.c4[i].w} : (u32x2){pre.c4[i].x, pre.c4[i].y}; } }
#pragma unroll
        for (int i = 0; i < 2; ++i) { const int p = tid + 512 * i; *(LAS u32x4*)(Qs + (p >> 4) * 136 + (p & 15) * 8) = pre.q2[i]; }
#pragma unroll
        for (int i = 0; i < 4; ++i) { const int p = tid + 512 * i; *(LAS u32x4*)(VTs + (p >> 3) * 72 + (p & 7) * 8) = pre.v4[i]; }
        *(LAS u32x4*)(WTs + (tid >> 3) * 72 + (tid & 7) * 8) = pre.w1;
        if (tid < 128) ns[tid] = pre.nsv;
        if (tid < 64) sis[tid] = pre.siv;
        if (um_next >= 0) ML_OUT_LOAD(um_next, pre);
    }
    __syncthreads();
    {
        const int l = tid >> 3, part = tid & 7; float s = 0.f;
#pragma unroll
        for (int hq = 0; hq < 2; ++hq) { const u32x4 qv = *(const LAS u32x4*)(Qs + l * 136 + part * 16 + 8 * hq); const f32x4 n0 = *(const LAS f32x4*)(ns + part * 16 + 8 * hq), n1 = *(const LAS f32x4*)(ns + part * 16 + 8 * hq + 4);
            s += (bflo(qv.x) * n0[0] + bfhi(qv.x) * n0[1]) + (bflo(qv.y) * n0[2] + bfhi(qv.y) * n0[3]) + (bflo(qv.z) * n1[0] + bfhi(qv.z) * n1[1]) + (bflo(qv.w) * n1[2] + bfhi(qv.w) * n1[3]); }
#pragma unroll
        for (int o = 1; o < 8; o <<= 1) s += __shfl_xor(s, o);
        if (part == 0) dns[l] = 1.f / fmaxf(fabsf(sis[l] * s + ((const float*)(sm + SM_MWS))[um * 64 + l]), ((const float*)(sm + SM_MEN))[um * 64 + l]);
    }
    f32x4 N[2][4];
#pragma unroll
    for (int e2 = 0; e2 < 2; ++e2) { const int et = 2 * wid + e2; bf16x8 cf[4];
#pragma unroll
        for (int ks = 0; ks < 4; ++ks) cf[ks] = frag(Cs, 16 * et, 136, 32 * ks, lane);
#pragma unroll
        for (int lt = 0; lt < 4; ++lt) { f32x4 n4 = (f32x4){0.f, 0.f, 0.f, 0.f};
#pragma unroll
            for (int ks = 0; ks < 4; ++ks) n4 = MMA16(frag(Qs, 16 * lt, 136, 32 * ks, lane), cf[ks], n4);
#pragma unroll
            for (int rg = 0; rg < 4; ++rg) n4[rg] *= sis[16 * lt + 4 * g4 + rg];
#pragma unroll
            for (int ks = 0; ks < 2; ++ks) n4 = MMA16(frag(WTs, 16 * lt, 72, 32 * ks, lane), frag(VTs, 16 * et, 72, 32 * ks, lane), n4);
            N[e2][lt] = n4; } }
    __syncthreads();
#pragma unroll
    for (int e2 = 0; e2 < 2; ++e2)
#pragma unroll
        for (int lt = 0; lt < 4; ++lt)
#pragma unroll
            for (int rg = 0; rg < 4; ++rg) { const int l = 16 * lt + 4 * g4 + rg; Hs[l * 260 + 16 * (2 * wid + e2) + c15] = N[e2][lt][rg] * dns[l]; }
    __syncthreads();
    {
        const int l = tid >> 3, cg = tid & 7; const LAS f32x4* hp = (const LAS f32x4*)(Hs + l * 260 + cg * 32);
        f32x4 hv[8]; float ss = 0.f;
#pragma unroll
        for (int i = 0; i < 8; ++i) { hv[i] = hp[i]; ss += (hv[i][0] * hv[i][0] + hv[i][1] * hv[i][1]) + (hv[i][2] * hv[i][2] + hv[i][3] * hv[i][3]); }
#pragma unroll
        for (int o = 1; o < 8; o <<= 1) ss += __shfl_xor(ss, o);
        const float r = rsqrtf(ss * (1.f / 256.f) + EPS);
        const LAS float* mn = (const LAS float*)(lds + GN_LDS + 512) + h * 256 + cg * 32;
        bf16* yp = (bf16*)(ws + WS_Y) + (size_t)(t0 + l) * DM + 1024 + h * 256 + cg * 32;
#pragma unroll
        for (int i = 0; i < 4; ++i) { const u32x4 zw = zo[i]; const f32x4 m0 = *(const LAS f32x4*)(mn + 8 * i), m1 = *(const LAS f32x4*)(mn + 8 * i + 4); const f32x4 h0 = hv[2 * i], h1 = hv[2 * i + 1];
            u32x4 y; y.x = pk2(h0[0] * r * m0[0] * sigm(bflo(zw.x)), h0[1] * r * m0[1] * sigm(bfhi(zw.x))); y.y = pk2(h0[2] * r * m0[2] * sigm(bflo(zw.y)), h0[3] * r * m0[3] * sigm(bfhi(zw.y)));
            y.z = pk2(h1[0] * r * m1[0] * sigm(bflo(zw.z)), h1[1] * r * m1[1] * sigm(bfhi(zw.z))); y.w = pk2(h1[2] * r * m1[2] * sigm(bflo(zw.w)), h1[3] * r * m1[3] * sigm(bfhi(zw.w)));
            *(u32x4*)(yp + 8 * i) = y; }
    }
    __syncthreads();
}

__device__ __forceinline__ void router_unit(const Args& a, int u, LAS unsigned char* lds, int tid, int wid, int lane) {
    asm volatile("" : "+v"(tid), "+v"(lane));
    unsigned char* ws = a.ws; unsigned char* sm = ws + WS_SMALL;
    const float* H1 = (const float*)(ws + WS_H1);
    LAS float* red = (LAS float*)lds; LAS float* Ls = (LAS float*)(lds + 67584); LAS int* sel = (LAS int*)(lds + 67584 + 8448); LAS int* rks = sel + 256; LAS float* rsl = (LAS float*)(rks + 256);
    const int t0 = u * 64, g4 = lane >> 4, c15 = lane & 15;
    if (tid < 64) { const float* SSQ = (const float*)(sm + SM_SSQ1) + (size_t)(t0 + tid) * 32; float s = 0.f;
#pragma unroll
        for (int q = 0; q < 8; ++q) { const f32x4 v = *(const f32x4*)(SSQ + 4 * q); s += (v[0] + v[1]) + (v[2] + v[3]); }
        const float r = rsqrtf(s * (1.f / DM) + EPS); rsl[tid] = r; ((float*)(sm + SM_RS2))[t0 + tid] = r; }
    __syncthreads();
    float rr[4];
#pragma unroll
    for (int rt = 0; rt < 4; ++rt) rr[rt] = rsl[16 * rt + c15];
    unsigned char* qb = ws + WS_H1B + (size_t)(t0 + c15) * DM;
    skinny_mfma(H1 + (size_t)t0 * DM, (const bf16*)(ws + WS_WSK) + 64 * DM, (const bf16*)(ws + WS_WSK) + 96 * DM, red, Ls, tid, wid, lane,
        [&](int rt, int k, const f32x4& v0, const f32x4& v1) { const float r = rr[rt];
            *(u32x2*)(qb + (size_t)(16 * rt) * DM + k) = (u32x2){pk4_fp8(v0[0] * r, v0[1] * r, v0[2] * r, v0[3] * r), pk4_fp8(v1[0] * r, v1[1] * r, v1[2] * r, v1[3] * r)}; });
    if (tid < 64) { const int l = tid, t = t0 + l; float tv[4]; int ti[4]; const float r = rsl[l]; const float* b_r = argin(a, 14);
        float lg[32];
#pragma unroll
        for (int c4 = 0; c4 < 8; ++c4) { const f32x4 bq = *(const f32x4*)(b_r + 4 * c4);
#pragma unroll
            for (int e = 0; e < 4; ++e) lg[4 * c4 + e] = Ls[l * 33 + 4 * c4 + e] * r + bq[e]; }
        unsigned taken = 0u;
#pragma unroll
        for (int k = 0; k < 4; ++k) { float best = -INFINITY; int bi = 0;
#pragma unroll
            for (int c = 0; c < 32; ++c) { const bool ok = !((taken >> c) & 1u) && lg[c] > best; best = ok ? lg[c] : best; bi = ok ? c : bi; }
            tv[k] = best; ti[k] = bi; taken |= 1u << bi; }
        const float e1 = expf(tv[1] - tv[0]), e2 = expf(tv[2] - tv[0]), e3 = expf(tv[3] - tv[0]); const float inv = 1.f / (1.f + e1 + e2 + e3);
        int* TOPI = (int*)(sm + SM_TOPI); float* TOPG = (float*)(sm + SM_TOPG);
        *(i32x4*)(TOPI + t * 4) = (i32x4){ti[0], ti[1], ti[2], ti[3]};
        *(f32x4*)(TOPG + t * 4) = (f32x4){inv, e1 * inv, e2 * inv, e3 * inv};
        sel[l * 4 + 0] = ti[0]; sel[l * 4 + 1] = ti[1]; sel[l * 4 + 2] = ti[2]; sel[l * 4 + 3] = ti[3]; }
    __syncthreads();
    int my_e = 0, my_lr = 0;
    if (tid < 256) {
        my_e = sel[tid];
#pragma unroll 4
        for (int e = 0; e < 32; ++e) { const unsigned long long m = __ballot(my_e == e); if (my_e == e) my_lr = __popcll(m & ((1ull << lane) - 1ull)); if (lane == 0) rks[wid * 32 + e] = __popcll(m); }
    }
    __syncthreads();
    if (tid < 256) { int rk = my_lr; for (int w = 0; w < wid; ++w) rk += rks[w * 32 + my_e]; ((int*)(sm + SM_LRANK))[t0 * 4 + tid] = rk; }
    if (tid < 32) { const int cnt = (rks[tid] + rks[32 + tid]) + (rks[64 + tid] + rks[96 + tid]);
        ((int*)(sm + SM_UCNT))[u * 32 + tid] = cnt; atomicAdd((int*)(ws + WS_CTL) + CW_CNTE + tid, cnt); }
    __syncthreads();
}

constexpr int NPHASE = 13;
__global__ void __launch_bounds__(NWAVES * 64, 2) mk_fwd(Args args) {
    extern __shared__ __attribute__((aligned(16))) unsigned char lds_raw[];
    LAS unsigned char* lds = (LAS unsigned char*)lds_raw;
    volatile LAS unsigned* MISC = (volatile LAS unsigned*)(lds + MISC_OFF);
    const int wave = __builtin_amdgcn_readfirstlane((int)threadIdx.x >> 6);
#define PHASE_IDS int lane_; asm volatile("v_mbcnt_lo_u32_b32 %0, -1, 0\n\tv_mbcnt_hi_u32_b32 %0, -1, %0" : "=v"(lane_)); const int tid = wave * 64 + lane_; const int lane = lane_; (void)lane;
    const int G = gridDim.x, bx = blockIdx.x;
    unsigned char* ws = args.ws; unsigned char* sm = ws + WS_SMALL;
    const int gw = bx * NWAVES + wave, NGW = G * NWAVES;
    { PHASE_IDS for (int u = tid; u < 64; u += NWAVES * 64) MISC[u] = 0u; }
    __syncthreads();
#if MK_SPLIT
#define GRID_BAR() do { } while (0)
#else
    XcdBarrier bar; { PHASE_IDS bar = xcd_barrier_post((unsigned*)(ws + WS_CTL) + CW_BAR, MISC + 8, tid == 0); }
#define GRID_BAR() xcd_barrier(bar, tid == 0)
#endif
#if MK_SPLIT
    const int lo = args.ph_lo, hi = args.ph_hi;
#else
    constexpr int lo = 0, hi = NPHASE;
#endif
#ifndef PH_MASK
#define PH_MASK 0xffffffffu
#endif
#define IN(k) ((((PH_MASK) >> (k)) & 1u) && lo <= (k) && (k) < hi)
#define BOTH(k) (IN(k) && IN((k) + 1))

    if (IN(0)) {
        PHASE_IDS
        {
            const float* x = argin(args, 0); bf16* xb = (bf16*)(ws + WS_XB);
            for (int t = gw; t < NTOK; t += NGW) { float ss = 0.f;
#pragma unroll
                for (int j = 0; j < 8; ++j) { const int col = 4 * lane + 256 * j; const f32x4 v = *(const f32x4*)(x + (size_t)t * DM + col); ss += (v[0] * v[0] + v[1] * v[1]) + (v[2] * v[2] + v[3] * v[3]);
                    *(u32x2*)(xb + (size_t)t * DM + col) = (u32x2){pk2(v[0], v[1]), pk2(v[2], v[3])}; }
                ss = wave_sum(ss); if (lane == 0) ((float*)(sm + SM_RS1))[t] = rsqrtf(ss * (1.f / DM) + EPS); } }
        {
            const float* w_in = argin(args, 3); const float* g_mix = argin(args, 2); const float* w_r = argin(args, 13); const float* g_ffn = argin(args, 12); bf16* wsk = (bf16*)(ws + WS_WSK);
            for (int i = bx * 512 + tid; i < 2 * 32 * DM; i += G * 512) { const int which = i >> 16, n = (i >> 11) & 31, k = i & 2047; float v;
                if (which == 0) { const int col = n < 16 ? 3072 + n : 6160 + (n - 16); v = n < 24 ? w_in[(size_t)k * DIN + col] * g_mix[k] : 0.f; } else v = w_r[(size_t)k * 32 + n] * g_ffn[k];
                const bf16 hi = f2bf(v); wsk[(size_t)(which * 64 + n) * DM + k] = hi; wsk[(size_t)(which * 64 + 32 + n) * DM + k] = f2bf(v - bf2f(hi)); } }
        p0_weights(args, gw, NGW, lane);
        { const float* p = argin(args, 1); bf16* pb = (bf16*)(ws + WS_PB);
          for (size_t i = (size_t)bx * 512 + tid; i < (size_t)NTOK * PLE / 4; i += (size_t)G * 512) { const f32x4 v = *(const f32x4*)(p + 4 * i); u32x2 w; w.x = pk2(v[0], v[1]); w.y = pk2(v[2], v[3]); *(u32x2*)(pb + 4 * i) = w; } }
        if (BOTH(0)) GRID_BAR();
    }
    if (IN(1)) {
        PHASE_IDS
        const int GA = (G == 256) ? 160 : G;
        if (args.aux == 6) { if (bx >= GA) { PHASE_IDS __syncthreads(); convert_pool(args, lds, tid, wave, lane); } }
        else {
        if (GA == G || bx >= GA) { const int u0 = (GA == G) ? bx : bx - GA, us = (GA == G) ? G : G - GA; for (int u = u0; u < NCHT; u += us) xgate_unit(args, u, lds, tid, wave, lane); }
        if (bx < GA) {
            { pg8::Gemm g{ws + WS_XB, ws + WS_WIN, DM * 2, 0, nullptr, 0, 0}; pg8::Order S; S.init(NTOK / 256, NZ / 256, GA, bx, nullptr);
              pg8::EpiZ E{(bf16*)(ws + WS_Z), NZ, (const float*)(sm + SM_RS1)};
              pg8::gemm_phase<pg8::EpiZ, false, true>(lds, g, S, E, tid); }
            { pg8::Gemm g{ws + WS_PB, ws + WS_WPP, PLE * 2, 0, nullptr, 0, 0}; pg8::Order S; S.init(NTOK / 256, DM / 256, GA, (bx + 128) % GA, nullptr);
              pg8::EpiPe E{(bf16*)(ws + WS_PE), (float*)(sm + SM_PESSQ)};
              pg8::gemm_phase<pg8::EpiPe, false, true>(lds, g, S, E, tid); }
        }
        { PHASE_IDS __syncthreads(); convert_pool(args, lds, tid, wave, lane); }
        }
        if (BOTH(1)) GRID_BAR();
    }
    if (IN(2)) {
        PHASE_IDS
        { GdnPre pre; pre.z[0] = pre.z[1] = pre.z[2] = (u32x4){0u, 0u, 0u, 0u}; pre.cw = (f32x4){0.f, 0.f, 0.f, 0.f};
          { const Args& a = args; if (bx < 2048) { GDN_ZLOAD(bx, 0, pre.z); GDN_CWLOAD(bx, pre.cw); } }
          for (int u = bx; u < 2048; u += G) gdn_prep_unit(args, u, (u + G < 2048) ? u + G : -1, pre, lds, tid, wave, lane); }
        { const Args& a = args; MlPre mp; const int u0 = bx + ((2048 - bx + G - 1) / G) * G;
          if (u0 < 3072) ML_PREP_LOAD(u0 - 2048, mp);
          for (int u = u0; u < 3072; u += G) ml_prep_unit(args, u - 2048, (u + G < 3072) ? u + G - 2048 : -1, mp, lds, tid, wave, lane); }
        if (BOTH(2)) GRID_BAR();
    }
    if (IN(3)) {
        PHASE_IDS
        for (int it = bx; it < 256; it += G) { const int itx = (G == 256) ? ((((it & 7) * 4 + (it >> 6)) << 3) | ((it >> 3) & 7)) : it;
            gdn_scan_item(args, itx, lds, tid, wave, lane); ml_scan_item(args, it, tid); __syncthreads(); }
        if (BOTH(3)) GRID_BAR();
    }
    if (IN(4)) {
        PHASE_IDS
        { const Args& a = args;
          { LAS float* gns = (LAS float*)(lds + GN_LDS); const float* gsrc = argin(args, 7); const float* msrc = argin(args, 10); if (tid < 128) gns[tid] = gsrc[tid]; gns[128 + tid] = msrc[tid]; gns[640 + tid] = msrc[512 + tid]; __syncthreads(); }
          { GdnOutPre pre; if (bx < 2048) GDN_OUT_LOAD(bx, pre);
            if (args.aux != 2) for (int u = bx; u < 2048; u += G) gdn_out_unit(args, u, (u + G < 2048) ? u + G : -1, pre, lds, tid, wave, lane); }
          { MlOutPre pre; const int u0 = bx + ((2048 - bx + G - 1) / G) * G;
            if (u0 < 3072) ML_OUT_LOAD(u0 - 2048, pre);
            if (args.aux != 1) for (int u = u0; u < 3072; u += G) ml_out_unit(args, u - 2048, (u + G < 3072) ? u + G - 2048 : -1, pre, lds, tid, wave, lane); } }
        if (BOTH(4)) GRID_BAR();
    }
    if (IN(5)) {
        PHASE_IDS
        pg8::Gemm g{ws + WS_Y, ws + WS_WOUT, DM * 2, 0, nullptr, 0, 0}; pg8::Order S; S.init(NTOK / 256, DM / 256, G, bx, nullptr);
        pg8::EpiOut E{argin(args, 0), (float*)(ws + WS_H1), (float*)(sm + SM_SSQ1)};
        pg8::gemm_phase<pg8::EpiOut, false, true>(lds, g, S, E, tid);
        if (BOTH(5)) GRID_BAR();
    }
    if (IN(6)) {
        PHASE_IDS
        for (int u = bx; u < NCHT; u += G) router_unit(args, u, lds, tid, wave, lane);
        if (BOTH(6)) GRID_BAR();
    }
    if (IN(7)) {
        PHASE_IDS
        LAS int* ps = (LAS int*)lds; LAS int* up = ps + 32; LAS int* cn = ps + 64;
        const int* CNTE = (const int*)(ws + WS_CTL) + CW_CNTE; const int* UCNT = (const int*)(sm + SM_UCNT);
        int* ROWTOK = (int*)(sm + SM_ROWTOK); float* ROWGATE = (float*)(sm + SM_ROWGATE); float* ROWRS = (float*)(sm + SM_ROWRS);
        if (tid < 64) {
            const int cnt = tid < 32 ? CNTE[tid] : 0, pad = ((cnt + 255) >> 8) << 8; int inc = pad;
#pragma unroll
            for (int off = 1; off < 32; off <<= 1) { const int p = __shfl_up(inc, off); if (tid >= off) inc += p; }
            if (tid < 32) { ps[tid] = inc - pad; cn[tid] = cnt; } }
        __syncthreads();
        for (int u = bx; u < NCHT; u += G) {
            { LAS int* pp = ps + 128; int s0 = 0, s1 = 0, s2 = 0, s3 = 0; const int e = tid & 31, part = tid >> 5;
              for (int v = part; v < u; v += 64) { s0 += UCNT[v * 32 + e]; if (v + 16 < u) s1 += UCNT[(v + 16) * 32 + e]; if (v + 32 < u) s2 += UCNT[(v + 32) * 32 + e]; if (v + 48 < u) s3 += UCNT[(v + 48) * 32 + e]; }
              pp[part * 32 + e] = (s0 + s1) + (s2 + s3); }
            __syncthreads();
            if (tid < 32) { int s = 0; for (int q = 0; q < 16; ++q) s += ps[128 + q * 32 + tid]; up[tid] = s; }
            __syncthreads();
            if (tid < 256) { const int ai = u * 256 + tid, t = ai >> 2; const int e = ((const int*)(sm + SM_TOPI))[ai]; const int dest = ps[e] + up[e] + ((const int*)(sm + SM_LRANK))[ai];
                ROWTOK[dest] = t; ROWGATE[dest] = ((const float*)(sm + SM_TOPG))[ai]; ROWRS[dest] = ((const float*)(sm + SM_RS2))[t]; ((int*)(sm + SM_DEST))[ai] = dest; }
            __syncthreads();
        }
        for (int e = bx; e < 32; e += G) { const int c0 = cn[e], c1 = ((c0 + 255) >> 8) << 8; for (int p = c0 + tid; p < c1; p += 512) { ROWTOK[ps[e] + p] = 0; ROWGATE[ps[e] + p] = 0.f; ROWRS[ps[e] + p] = 0.f; } }
        if (BOTH(7)) GRID_BAR();
    }
    if (IN(8) || IN(9)) {
        PHASE_IDS
        LAS int* tile_e = (LAS int*)(lds + MISC_OFF + 1024); LAS int* meta = (LAS int*)(lds + MISC_OFF + 512);
        if (tid < 64) {
            const int* CNTE = (const int*)(ws + WS_CTL) + CW_CNTE; const int nt = tid < 32 ? (CNTE[tid] + 255) >> 8 : 0; int inc = nt;
#pragma unroll
            for (int off = 1; off < 32; off <<= 1) { const int p = __shfl_up(inc, off); if (tid >= off) inc += p; }
            for (int i = 0; i < nt; ++i) tile_e[inc - nt + i] = tid;
            if (tid == 31) meta[0] = inc; }
        __syncthreads();
        const int n_mt = meta[0];
        if (IN(8)) {
            pg8::Gemm g{ws + WS_H1B, ws + WS_WGU, DM, (size_t)4096 * DM, (const int*)(sm + SM_ROWTOK), ONE_E8M0, W8_E8M0}; pg8::Order S;
            S.init(n_mt, 16, G, bx, tile_e);
            pg8::EpiMoe1 E{ws + WS_ACT, argin(args, 16)};
            pg8::gemm_phase<pg8::EpiMoe1, true, true, true>(lds, g, S, E, tid);
            if (BOTH(8)) GRID_BAR();
        }
        if (IN(9)) {
            pg8::Gemm g{ws + WS_ACT, ws + WS_WDN, DM, (size_t)DM * DM, nullptr, ACT8_E8M0, W8_E8M0}; pg8::Order S;
            S.init(n_mt, 8, G, bx, tile_e);
            pg8::EpiMoe2 E{ws + WS_YB, argin(args, 18), (const float*)(sm + SM_ROWGATE)};
            pg8::gemm_phase<pg8::EpiMoe2, false, true, true>(lds, g, S, E, tid);
            if (BOTH(9)) GRID_BAR();
        }
    }
    if (IN(10)) {
        PHASE_IDS
        const float* H1 = (const float*)(ws + WS_H1); const unsigned char* YB = ws + WS_YB; bf16* H2 = (bf16*)(ws + WS_H2); unsigned char* H2Q = ws + WS_H2B;
        const int* DEST = (const int*)(sm + SM_DEST); const float* PESSQ = (const float*)(sm + SM_PESSQ);
        for (int t = gw; t < NTOK; t += NGW) { const i32x4 dd = *(const i32x4*)(DEST + t * 4); float ss = 0.f;
            f32x4 hvv[8]; unsigned yv[8][4];
#pragma unroll
            for (int j = 0; j < 8; ++j) { const int col = 4 * lane + 256 * j; hvv[j] = *(const f32x4*)(H1 + (size_t)t * DM + col);
                yv[j][0] = *(const unsigned*)(YB + (size_t)dd[0] * DM + col); yv[j][1] = *(const unsigned*)(YB + (size_t)dd[1] * DM + col); yv[j][2] = *(const unsigned*)(YB + (size_t)dd[2] * DM + col); yv[j][3] = *(const unsigned*)(YB + (size_t)dd[3] * DM + col); }
            asm volatile("" ::: "memory");
#pragma unroll
            for (int j = 0; j < 8; ++j) { const int col = 4 * lane + 256 * j; f32x4 hv = hvv[j]; const unsigned y0 = yv[j][0], y1 = yv[j][1], y2 = yv[j][2], y3 = yv[j][3];
                const f32x2 a0 = __builtin_amdgcn_cvt_pk_f32_fp8(y0, false) + __builtin_amdgcn_cvt_pk_f32_fp8(y1, false) + (__builtin_amdgcn_cvt_pk_f32_fp8(y2, false) + __builtin_amdgcn_cvt_pk_f32_fp8(y3, false));
                const f32x2 a1 = __builtin_amdgcn_cvt_pk_f32_fp8(y0, true) + __builtin_amdgcn_cvt_pk_f32_fp8(y1, true) + (__builtin_amdgcn_cvt_pk_f32_fp8(y2, true) + __builtin_amdgcn_cvt_pk_f32_fp8(y3, true));
                hv[0] += a0[0] * (1.f / YB8_SCALE); hv[1] += a0[1] * (1.f / YB8_SCALE); hv[2] += a1[0] * (1.f / YB8_SCALE); hv[3] += a1[1] * (1.f / YB8_SCALE);
                *(u32x2*)(H2 + (size_t)t * DM + col) = (u32x2){pk2(hv[0], hv[1]), pk2(hv[2], hv[3])}; *(unsigned*)(H2Q + (size_t)t * DM + col) = pk4_fp8(hv[0] * ACT8_SCALE, hv[1] * ACT8_SCALE, hv[2] * ACT8_SCALE, hv[3] * ACT8_SCALE);
                ss += (hv[0] * hv[0] + hv[1] * hv[1]) + (hv[2] * hv[2] + hv[3] * hv[3]); }
            ss = wave_sum(ss); const float ps = wave_sum(lane < 32 ? PESSQ[(size_t)t * 32 + lane] : 0.f);
            if (lane == 0) { ((float*)(sm + SM_RS3))[t] = rsqrtf(ss * (1.f / DM) + EPS); ((float*)(sm + SM_RSPE))[t] = rsqrtf(ps * (1.f / DM) + EPS); } }
        if (BOTH(10)) GRID_BAR();
    }
    if (IN(11)) {
        PHASE_IDS
        pg8::Gemm g{ws + WS_H2B, ws + WS_WPG, DM, 0, nullptr, ACT8_E8M0, W8_E8M0}; pg8::Order S; S.init(NTOK / 256, DM / 256, G, bx, nullptr);
        pg8::EpiPg E{(const bf16*)(ws + WS_H2), (const bf16*)(ws + WS_PE), (const float*)(sm + SM_RS3), (const float*)(sm + SM_RSPE), argin(args, 22), (bf16*)(ws + WS_H3), (float*)(sm + SM_SSQ3)};
        pg8::gemm_phase<pg8::EpiPg, false, true, true>(lds, g, S, E, tid);
        if (BOTH(11)) GRID_BAR();
    }
#ifdef DBG_OUT
    if (IN(12)) {
        PHASE_IDS
        for (int t = gw; t < NTOK; t += NGW) {
#pragma unroll
            for (int j = 0; j < 8; ++j) { const int col = 4 * lane + 256 * j; f32x4 v;
#if DBG_OUT == 1
                { const u32x2 w = *(const u32x2*)((const bf16*)(ws + WS_Z) + (size_t)t * NZ + col); v = (f32x4){bflo(w.x), bfhi(w.x), bflo(w.y), bfhi(w.y)}; }
#elif DBG_OUT == 3
                v = *(const f32x4*)((const float*)(ws + WS_OSC) + (size_t)t * DM + col);
#elif DBG_OUT == 2
                { const size_t idx = (size_t)t * 1024 + (col & 1023);
                  if (col < 1024) v = *(const f32x4*)((const float*)(ws + WS_GU) + idx);
                  else { for (int q = 0; q < 4; ++q) { const size_t ix = idx + q; float a = bf2f(((const bf16*)(ws + WS_MVT))[ix]) + bf2f(((const bf16*)(ws + WS_MKWT))[ix & 8388607]) + bf2f(((const bf16*)(ws + WS_MWT))[ix & 4194303])
                      + bf2f(((const bf16*)(ws + WS_GW))[ix]) + bf2f(((const bf16*)(ws + WS_GKDT))[ix]) + bf2f(((const bf16*)(ws + WS_GQD))[ix]) + bf2f(((const bf16*)(ws + WS_GAT))[ix & 8388607])
                      + ((const float*)(sm + SM_MSI))[ix & 65535] + ((const float*)(sm + SM_MEN))[ix & 65535] + ((const float*)(sm + SM_MWS))[ix & 65535] + ((const float*)(sm + SM_GLAST))[ix & 2047] + ((const float*)(sm + SM_MDEC))[ix & 1023];
                      v[q] = a; } } }
#elif DBG_OUT == 31
                v = col < 1024 ? *(const f32x4*)((const float*)(ws + WS_OSC) + (size_t)t * DM + col) : (f32x4){0.f, 0.f, 0.f, 0.f};
#elif DBG_OUT == 32
                v = col >= 1024 ? *(const f32x4*)((const float*)(ws + WS_OSC) + (size_t)t * DM + col) : (f32x4){0.f, 0.f, 0.f, 0.f};
#elif DBG_OUT == 5
                v = *(const f32x4*)((const float*)(ws + WS_H1) + (size_t)t * DM + col);
#elif DBG_OUT == 10
                v = *(const f32x4*)((const float*)(ws + WS_H2) + (size_t)t * DM + col);
#endif
                *(f32x4*)(args.out + (size_t)t * DM + col) = v; } }
    }
#else
    if (IN(12)) {
        PHASE_IDS
        const bf16* H3 = (const bf16*)(ws + WS_H3); const float* SSQ3 = (const float*)(sm + SM_SSQ3); const float* gf = argin(args, 23);
        for (int t = gw; t < NTOK; t += NGW) { u32x2 hw[8]; f32x4 gv[8];
#pragma unroll
            for (int j = 0; j < 8; ++j) { const int col = 4 * lane + 256 * j; hw[j] = *(const u32x2*)(H3 + (size_t)t * DM + col); gv[j] = *(const f32x4*)(gf + col); }
            const float r = rsqrtf(wave_sum(lane < 32 ? SSQ3[(size_t)t * 32 + lane] : 0.f) * (1.f / DM) + EPS);
#pragma unroll
            for (int j = 0; j < 8; ++j) { const int col = 4 * lane + 256 * j; const f32x4 hv = (f32x4){bflo(hw[j].x), bfhi(hw[j].x), bflo(hw[j].y), bfhi(hw[j].y)};
                *(f32x4*)(args.out + (size_t)t * DM + col) = hv * gv[j] * r; } }
    }
#endif
#ifdef DBG_DET
    if (lo == 13) { PHASE_IDS
        unsigned long long s1 = 0ull, s2 = 0ull;
        auto acc_region = [&](const unsigned* p, size_t nwords) { for (size_t i = (size_t)bx * 512 + tid; i < nwords; i += (size_t)G * 512) { const unsigned w = p[i]; s1 += w; s2 += (unsigned long long)w * ((unsigned)i | 1u); } };
#if DBG_DET == 0
        acc_region((const unsigned*)(ws + WS_WIN), (size_t)(WS_Z - WS_WIN) / 4);
        acc_region((const unsigned*)(sm + SM_RS1), (size_t)(SM_GLAST - SM_RS1) / 4);
#elif DBG_DET == 1
        acc_region((const unsigned*)(ws + WS_Z), (size_t)(WS_GW - WS_Z) / 4);
        acc_region((const unsigned*)(sm + SM_PESSQ), (size_t)(2 << 20) / 4);
#elif DBG_DET == 2
        acc_region((const unsigned*)(ws + WS_GW), (size_t)(WS_OSC - WS_GW) / 4);
        acc_region((const unsigned*)(sm + SM_GLAST), (size_t)(SM_DEN - SM_GLAST) / 4);
#elif DBG_DET == 3
        acc_region((const unsigned*)(ws + WS_OSC), (size_t)(WS_Y - WS_OSC) / 4);
        acc_region((const unsigned*)(sm + SM_DEN), (size_t)(256 << 10) / 4);
#endif
        for (int o = 1; o < 64; o <<= 1) { s1 += __shfl_xor(s1, o); s2 += __shfl_xor(s2, o); }
        if (lane == 0) { unsigned long long* slot = (unsigned long long*)(ws + WS_CTL) + 8192 + 2 * args.aux; atomicAdd(slot, s1); atomicAdd(slot + 1, s2); }
    }
    if (lo == 14) { PHASE_IDS
        const unsigned long long* slot = (const unsigned long long*)(ws + WS_CTL) + 8192;
        const float v = (slot[0] == slot[2] && slot[1] == slot[3]) ? 0.f : 3.f;
        for (size_t i = (size_t)bx * 512 + tid; i < (size_t)NTOK * DM; i += (size_t)G * 512) args.out[i] = v;
    }
#endif
#undef IN
#undef BOTH
}

extern "C" void kernel_launch(void* const* d_in, const int* in_sizes, int n_in, void* d_out, int out_size, void* d_ws, size_t ws_size, hipStream_t stream) {
    static int grid = 0;
    if (grid == 0) {
        if (n_in != 24 || out_size != NTOK * DM || ws_size < WS_END) { fprintf(stderr, "kernel_launch: unexpected problem (n_in %d, out %d, ws %zu)\n", n_in, out_size, ws_size); grid = -1; return; }
        int dev = 0, cus = 0, per_cu = 0;
        if (hipGetDevice(&dev) != hipSuccess || hipDeviceGetAttribute(&cus, hipDeviceAttributeMultiprocessorCount, dev) != hipSuccess) { grid = -1; return; }
        if (hipFuncSetAttribute((const void*)mk_fwd, hipFuncAttributeMaxDynamicSharedMemorySize, LDS_BYTES) != hipSuccess) { fprintf(stderr, "kernel_launch: hipFuncSetAttribute failed\n"); grid = -1; return; }
        if (hipOccupancyMaxActiveBlocksPerMultiprocessor(&per_cu, (const void*)mk_fwd, NWAVES * 64, LDS_BYTES) != hipSuccess || per_cu < 1) fprintf(stderr, "kernel_launch: occupancy query reports %d\n", per_cu);
        (void)hipGetLastError();
        grid = cus;
    }
    if (grid < 0) return;
    (void)hipMemsetAsync((char*)d_ws + WS_CTL, 0, CTL_ZERO_BYTES, stream);
    Args a{};
    for (int i = 0; i < 24; ++i) a.in[i] = (const float*)d_in[i];
    a.out = (float*)d_out; a.ws = (unsigned char*)d_ws;
#ifdef DBG_DET
    for (int rep = 0; rep < 2; ++rep) {
        for (int ph = 0; ph <= DBG_DET; ++ph) { a.ph_lo = ph; a.ph_hi = ph + 1; hipLaunchKernelGGL(mk_fwd, dim3(grid), dim3(NWAVES * 64), LDS_BYTES, stream, a); }
        a.ph_lo = 13; a.ph_hi = 13; a.aux = rep; hipLaunchKernelGGL(mk_fwd, dim3(grid), dim3(NWAVES * 64), LDS_BYTES, stream, a); a.aux = 0;
    }
    a.ph_lo = 14; a.ph_hi = 14; hipLaunchKernelGGL(mk_fwd, dim3(grid), dim3(NWAVES * 64), LDS_BYTES, stream, a);
    return;
#endif
#if MK_SPLIT
#ifndef DUP_MASK
#define DUP_MASK 0u
#endif
    for (int ph = 0; ph < NPHASE; ++ph) { a.ph_lo = ph; a.ph_hi = ph + 1; const int reps = ((DUP_MASK >> ph) & 1u) ? 2 : 1;
        for (int r = 0; r < reps; ++r) { a.aux = (r == 1) ? DUP_AUX : 0; hipLaunchKernelGGL(mk_fwd, dim3(grid), dim3(NWAVES * 64), LDS_BYTES, stream, a); a.aux = 0; } }
#else
    a.ph_lo = 0; a.ph_hi = NPHASE; hipLaunchKernelGGL(mk_fwd, dim3(grid), dim3(NWAVES * 64), LDS_BYTES, stream, a);
#endif
}
```

```cpp
#include <hip/hip_runtime.h>
#include <cstdio>
#include <cstdint>


#ifndef DUP_AUX
#define DUP_AUX 0
#endif
#ifndef P3_DUP
#define P3_DUP 0
#endif
#ifndef P2_DUP
#define P2_DUP 0
#endif
#ifndef MK_SPLIT
#define DUP_MASK 0x0u
#define MK_SPLIT 0
#endif

#define LAS __attribute__((address_space(3)))
typedef unsigned short bf16;
typedef short bf16x8 __attribute__((ext_vector_type(8)));
typedef float f32x4 __attribute__((ext_vector_type(4)));
typedef float f32x2 __attribute__((ext_vector_type(2)));
typedef unsigned u32x4 __attribute__((ext_vector_type(4)));
typedef unsigned u32x2 __attribute__((ext_vector_type(2)));
typedef int i32x8 __attribute__((ext_vector_type(8)));
typedef int i32x4 __attribute__((ext_vector_type(4)));

constexpr int NTOK = 16384, DM = 2048, SEQL = 4096, NCHT = 256  ;
constexpr int DIN = 7192, NZ = 7168, PLE = 256, NEXP = 32;
constexpr int ZQ = 0, ZK = 1024, ZV = 2048, ZG = 3072, ZMQ = 4096, ZMK = 4608, ZMV = 5120, ZMO = 6144;
constexpr int MAXROWS = 73728;
constexpr float EPS = 1e-6f;

constexpr size_t MiB = 1ull << 20;
constexpr size_t WS_CTL = 0, CTL_ZERO_BYTES = 1 * MiB;
constexpr size_t WS_WIN = 1 * MiB, WS_WOUT = 29 * MiB, WS_WPG = 37 * MiB, WS_WPP = 45 * MiB, WS_WGU = 46 * MiB, WS_WDN = 558 * MiB;
constexpr size_t WS_XB = 814 * MiB, WS_PB = 878 * MiB, WS_Z = 886 * MiB, WS_PE = 1110 * MiB;
constexpr size_t WS_GW = 1174 * MiB, WS_GQD = 1206 * MiB, WS_GKDT = 1238 * MiB, WS_GAT = 1270 * MiB, WS_GU = 1286 * MiB;
constexpr size_t WS_MWT = 1350 * MiB, WS_MKWT = 1358 * MiB, WS_MVT = 1374 * MiB;
constexpr size_t WS_OSC = 1406 * MiB, WS_Y = 1534 * MiB, WS_H1 = 1598 * MiB, WS_H1B = 1726 * MiB;
constexpr size_t WS_ACT = 1790 * MiB, WS_YB = 2078 * MiB, WS_H2 = 2366 * MiB, WS_H2B = 2494 * MiB, WS_H3 = 2558 * MiB;
constexpr size_t WS_SMALL = 2686 * MiB;
constexpr size_t WS_WSK = 3038 * MiB;
constexpr size_t WS_GAP = 2718 * MiB, WS_GBB = 2782 * MiB, WS_GSS = 2846 * MiB, WS_MBM = 2910 * MiB, WS_MCS = 2974 * MiB, WS_END = 3039 * MiB;
constexpr size_t SM_RS1 = 0, SM_GC = 64 << 10, SM_BETA = SM_GC + (512 << 10), SM_FC = SM_BETA + (512 << 10), SM_IC = SM_FC + (256 << 10);
constexpr size_t SM_FLAST = SM_IC + (256 << 10), SM_AMAX = SM_FLAST + 4096, SM_GLAST = SM_AMAX + 4096;
constexpr size_t SM_MSI = SM_GLAST + 8192, SM_MEN = SM_MSI + (256 << 10), SM_MWS = SM_MEN + (256 << 10), SM_MDEC = SM_MWS + (256 << 10);
constexpr size_t SM_DEN = SM_MDEC + 4096, SM_PESSQ = SM_DEN + (256 << 10), SM_SSQ1 = SM_PESSQ + (2 << 20), SM_SSQ3 = SM_SSQ1 + (2 << 20);
constexpr size_t SM_RS2 = SM_SSQ3 + (2 << 20), SM_RS3 = SM_RS2 + (64 << 10), SM_RSPE = SM_RS3 + (64 << 10);
constexpr size_t SM_TOPI = SM_RSPE + (64 << 10), SM_TOPG = SM_TOPI + (256 << 10), SM_LRANK = SM_TOPG + (256 << 10), SM_DEST = SM_LRANK + (256 << 10);
constexpr size_t SM_UCNT = SM_DEST + (256 << 10), SM_ROWTOK = SM_UCNT + (32 << 10), SM_ROWGATE = SM_ROWTOK + (288 << 10), SM_ROWRS = SM_ROWGATE + (288 << 10);
constexpr size_t SM_MKS = SM_ROWRS + (288 << 10), SM_MNS = SM_MKS + (512 << 10);
constexpr size_t SM_END = SM_MNS + (512 << 10);
static_assert(SM_END <= 32 * MiB, "small arrays");
constexpr int CW_BAR = 4096, CW_CNTE = 8192, CW_POOL = 8320;

constexpr int RING_BYTES = 131072, MISC_OFF = 139264, LDS_BYTES = 155648;
constexpr int NWAVES = 8;
constexpr int GN_LDS = 134144;

typedef __bf16 bf16v2_t __attribute__((ext_vector_type(2)));
__device__ __forceinline__ unsigned pk2(float lo, float hi) { const f32x2 v = {lo, hi}; return __builtin_bit_cast(unsigned, __builtin_convertvector(v, bf16v2_t)); }
__device__ __forceinline__ bf16 f2bf(float f) { return __builtin_bit_cast(unsigned short, (__bf16)f); }
__device__ __forceinline__ unsigned pk4_fp8(float a, float b, float c, float d) { unsigned w = 0u; w = __builtin_amdgcn_cvt_pk_fp8_f32(a, b, w, false); w = __builtin_amdgcn_cvt_pk_fp8_f32(c, d, w, true); return w; }
constexpr float W8_SCALE = 32.f; constexpr int W8_E8M0 = 0x7a7a7a7a;
constexpr float ACT8_SCALE = 4.f; constexpr int ACT8_E8M0 = 0x7d7d7d7d;
constexpr int ONE_E8M0 = 0x7f7f7f7f;
constexpr float YB8_SCALE = 16.f;
constexpr float Y8_SCALE = 16.f; constexpr int Y8_E8M0 = 0x7b7b7b7b;
__device__ __forceinline__ float bf2f(bf16 b) { return __uint_as_float(((unsigned)b) << 16); }
__device__ __forceinline__ float bflo(unsigned w) { return __uint_as_float(w << 16); }
__device__ __forceinline__ float bfhi(unsigned w) { return __uint_as_float(w & 0xffff0000u); }
__device__ __forceinline__ float wave_sum(float v) {
#pragma unroll
    for (int o = 1; o < 64; o <<= 1) v += __shfl_xor(v, o);
    return v;
}
__device__ __forceinline__ float sigm(float x) { return __builtin_amdgcn_rcpf(1.f + __expf(-x)); }
__device__ __forceinline__ float softplusf(float x) { return fmaxf(x, 0.f) + log1pf(expf(-fabsf(x))); }
#define LDS_WAIT() asm volatile("s_waitcnt lgkmcnt(0)" ::: "memory")

#define XB_TMO      128
#define XB_XCNT(j)  (256  + 64 * (j))
#define XB_XSUB(j)  (1280 + 64 * (j))
#define XB_XGEN(j)  (2304 + 64 * (j))
#define XB_TOP      3328
#define XB_TOPGEN   3392
#define XCD_BAR_WORDS 3456
#define XB_SPIN_CAP (1u << 18)
__device__ __forceinline__ unsigned xb_ld(unsigned* p)              { return __hip_atomic_load(p, __ATOMIC_RELAXED, __HIP_MEMORY_SCOPE_AGENT); }
__device__ __forceinline__ unsigned xb_add(unsigned* p, unsigned v) { return __hip_atomic_fetch_add(p, v, __ATOMIC_RELAXED, __HIP_MEMORY_SCOPE_AGENT); }
__device__ __forceinline__ unsigned xb_xcc_id() { return (unsigned)__builtin_amdgcn_s_getreg((3 << 11) | 20) & 0xFu; }
#define XB_SPIN(cond, bar) do { unsigned _sp = 0; while (cond) { __builtin_amdgcn_s_sleep(1); \
    if ((++_sp & 255u) == 0u) { if (xb_ld(&(bar)[XB_TMO])) break; if (_sp > XB_SPIN_CAP) { atomicAdd(&(bar)[XB_TMO], 1u); break; } } } } while (0)
struct XcdBarrier { unsigned* bar; unsigned x; volatile LAS unsigned* st; };
__device__ __forceinline__ XcdBarrier xcd_barrier_post(unsigned* bar, volatile LAS unsigned* st, bool tid0) {
    XcdBarrier b; b.bar = bar; b.x = xb_xcc_id(); b.st = st;
    if (tid0) (void)xb_add(&bar[XB_XCNT(b.x)], 1u);
    return b;
}
__device__ __forceinline__ void xcd_barrier_complete(unsigned* bar, unsigned x, unsigned& nloc, unsigned& nx) {
    const unsigned G = gridDim.x * gridDim.y * gridDim.z;
    unsigned sum, cnt, mine, sp = 0u;
    for (;;) {
        sum = 0u; cnt = 0u; mine = 0u;
#pragma unroll
        for (unsigned j = 0; j < 16; ++j) { const unsigned c = xb_ld(&bar[XB_XCNT(j)]); sum += c; cnt += (c > 0u) ? 1u : 0u; mine = (j == x) ? c : mine; }
        if (sum == G) break;
        __builtin_amdgcn_s_sleep(1);
        if ((++sp & 255u) == 0u) { if (xb_ld(&bar[XB_TMO])) break; if (sp > XB_SPIN_CAP) { atomicAdd(&bar[XB_TMO], 1u); break; } }
    }
    nloc = mine > 0u ? mine : 1u; nx = cnt > 0u ? cnt : 1u;
}
__device__ __forceinline__ void xcd_barrier(const XcdBarrier& b, bool tid0) {
    asm volatile("s_waitcnt vmcnt(0)" ::: "memory");
    __syncthreads();
    if (tid0) {
        unsigned* bar = b.bar;
        __builtin_amdgcn_s_waitcnt(0);
        unsigned nloc = b.st[0], nx = b.st[1];
        if (nloc == 0u) { xcd_barrier_complete(bar, b.x, nloc, nx); b.st[0] = nloc; b.st[1] = nx; }
        const unsigned old = xb_add(&bar[XB_XSUB(b.x)], 1u);
        const unsigned gen = old / nloc;
        if (old + 1u == (gen + 1u) * nloc) {
            __builtin_amdgcn_fence(__ATOMIC_RELEASE, "agent");
            asm volatile("s_waitcnt vmcnt(0)" ::: "memory");
            const unsigned og = xb_add(&bar[XB_TOP], 1u);
            const unsigned tg = og / nx;
            if (og + 1u == (tg + 1u) * nx) xb_add(&bar[XB_TOPGEN], 1u);
            else XB_SPIN(xb_ld(&bar[XB_TOPGEN]) == tg, bar);
            __builtin_amdgcn_fence(__ATOMIC_ACQUIRE, "agent");
            xb_add(&bar[XB_XGEN(b.x)], 1u);
            asm volatile("s_waitcnt vmcnt(0)" ::: "memory");
        } else {
            XB_SPIN(xb_ld(&bar[XB_XGEN(b.x)]) == gen, bar);
            __builtin_amdgcn_fence(__ATOMIC_ACQUIRE, "agent");
            asm volatile("s_waitcnt vmcnt(0)" ::: "memory");
        }
    }
    __syncthreads();
}

namespace pg8 {
constexpr int BM = 256, BK = 64, HALF = 128, HTB = HALF * BK * 2, STAGE_BYTES = 8 * HTB, NXCD = 8, WGM = 8;
__host__ __device__ __forceinline__ int lds_byte(int r, int c) { const int st = (r >> 4) * 2 + (c >> 5), rr = r & 15, cc = c & 31, ob = rr * 64 + cc * 2; return st * 1024 + (ob ^ (((ob >> 9) & 1) << 5)); }
__host__ __device__ __forceinline__ void stage_rc(int b, int& R, int& C) { const int st = b / 1024, sb = b % 1024, swz = sb ^ (((sb >> 9) & 1) << 5); R = (st >> 1) * 16 + swz / 64; C = (st & 1) * 32 + (swz % 64) / 2; }
__host__ __device__ __forceinline__ int perm32(int rho) { const int n = rho >> 4, i = rho & 15; return 8 * (i >> 2) + 4 * n + (i & 3); }
struct Unit { int pm, pn, e; };
struct Gemm { const void* A; const void* Bt; int K; size_t bstride; const int* rowtab; int sclA, sclB; };
struct Order {
    int nM, nN, nwg, G, c; const LAS int* tile_e;
    __device__ __forceinline__ void init(int nM_, int nN_, int G_, int c_, const LAS int* te) { nM = nM_; nN = nN_; nwg = nM * nN; G = G_; c = c_; tile_e = te; }
    __device__ __forceinline__ bool next(int i, Unit& u) const {
        const long L = (long)i * G + c; if (L >= nwg) return false;
        int wgid = (int)L; { const int q = nwg / NXCD, r = nwg % NXCD, xcd = wgid % NXCD, off = wgid / NXCD; wgid = (xcd < r ? xcd * (q + 1) : r * (q + 1) + (xcd - r) * q) + off; }
        const int nig = WGM * nN, gid = wgid / nig, fm = gid * WGM, gsz = (nM - fm) < WGM ? (nM - fm) : WGM;
        u.pm = fm + ((wgid % nig) % gsz); u.pn = (wgid % nig) / gsz; u.e = tile_e ? tile_e[u.pm] : 0; return true;
    }
};

template <class Epi, bool GATHER, bool ALIGN_EPI, bool FP8 = false>
__device__ __forceinline__ void gemm_phase(LAS unsigned char* lds, const Gemm g, const Order& S, const Epi& E, const int tid) {
    const int wid = __builtin_amdgcn_readfirstlane(tid >> 6), lane = tid & 63, wr = wid >> 2, wc = wid & 3, fr = lane & 15, fq = lane >> 4;
    const int K = g.K, nt = K / 128;
    unsigned voffA[2], voffB[2]; int Rg[2], Cg[2];
#pragma unroll
    for (int i = 0; i < 2; ++i) { int R, C; stage_rc(tid * 16 + i * 8192, R, C); const int Rb = Epi::PERM ? ((R & ~31) + perm32(R & 31)) : R;
        voffA[i] = (unsigned)(R * K + C * 2); voffB[i] = (unsigned)(Rb * K + C * 2); Rg[i] = R; Cg[i] = C; }
    unsigned vAc[2][2], vAn[2][2];
    const size_t kstep = (size_t)128;
    const size_t hstep = (size_t)HALF * K;
    const size_t tstep = 2 * hstep;
    const unsigned ldsw = (unsigned)wid * 1024u;
    const int aoff = lds_byte(wr * 64 + fr, fq * 8), boff = lds_byte(wc * 32 + fr, fq * 8);
    const int lc1 = 2 * (fq & 1);
    const int aoff8a = lds_byte(wr * 64 + fr, (fq >> 1) * 32 + lc1 * 8), aoff8b = lds_byte(wr * 64 + fr, (fq >> 1) * 32 + (lc1 ^ 1) * 8);
    const int boff8a = lds_byte(wc * 32 + fr, (fq >> 1) * 32 + lc1 * 8), boff8b = lds_byte(wc * 32 + fr, (fq >> 1) * 32 + (lc1 ^ 1) * 8);
#define PG8_SA(b, h) (((b) * 2 + (h)) * HTB)
#define PG8_SB(b, h) ((4 + (b) * 2 + (h)) * HTB)
#define PG8_STAGE(bufoff, gbase, voff) do { _Pragma("unroll") for (int _i = 0; _i < 2; ++_i) \
        __builtin_amdgcn_global_load_lds((const unsigned*)((const char*)(gbase) + (voff)[_i]), (LAS unsigned*)(lds + (bufoff) + ldsw + _i * 8192), 16, 0, 0); } while (0)
#define PG8_STAGE_A(bufoff, kp, h, nx) do { if constexpr (GATHER) { _Pragma("unroll") for (int _i = 0; _i < 2; ++_i) { const unsigned _vo = (nx) ? vAn[h][_i] : vAc[h][_i]; \
        __builtin_amdgcn_global_load_lds((const unsigned*)((const char*)(kp) + _vo), (LAS unsigned*)(lds + (bufoff) + ldsw + _i * 8192), 16, 0, 0); } } \
        else { PG8_STAGE(bufoff, (kp) + (h) * hstep, voffA); } } while (0)
#define PG8_LD8(base, o1, o2) __builtin_shufflevector(*(const LAS i32x4*)(lds + (base) + (o1)), *(const LAS i32x4*)(lds + (base) + (o2)), 0, 1, 2, 3, 4, 5, 6, 7)
#define PG8_LDA(dst, b, h) do { if constexpr (FP8) { _Pragma("unroll") for (int m = 0; m < 4; ++m) dst##8[m] = PG8_LD8(PG8_SA(b, h) + m * 2048, aoff8a, aoff8b); } \
        else { _Pragma("unroll") for (int m = 0; m < 4; ++m) _Pragma("unroll") for (int k = 0; k < 2; ++k) dst[m][k] = *(const LAS bf16x8*)(lds + PG8_SA(b, h) + aoff + m * 2048 + k * 1024); } } while (0)
#define PG8_LDB(dst, b, h) do { if constexpr (FP8) { _Pragma("unroll") for (int n = 0; n < 2; ++n) dst##8[n] = PG8_LD8(PG8_SB(b, h) + n * 2048, boff8a, boff8b); } \
        else { _Pragma("unroll") for (int n = 0; n < 2; ++n) _Pragma("unroll") for (int k = 0; k < 2; ++k) dst[n][k] = *(const LAS bf16x8*)(lds + PG8_SB(b, h) + boff + n * 2048 + k * 1024); } } while (0)
#define PG8_MMA(ai, bj, At, Bt) do { __builtin_amdgcn_s_setprio(1); if constexpr (FP8) { _Pragma("unroll") for (int m = 0; m < 4; ++m) _Pragma("unroll") for (int n = 0; n < 2; ++n) \
        asm volatile("v_mfma_scale_f32_16x16x128_f8f6f4 %0, %1, %2, %0, %3, %4 op_sel_hi:[0,0,0]" : "+v"(acc[ai][bj][m][n]) : "v"(Bt##8[n]), "v"(At##8[m]), "v"(sclBv), "v"(sclAv)); } \
        else { _Pragma("unroll") for (int m = 0; m < 4; ++m) _Pragma("unroll") for (int n = 0; n < 2; ++n) _Pragma("unroll") for (int k = 0; k < 2; ++k) \
        acc[ai][bj][m][n] = __builtin_amdgcn_mfma_f32_16x16x32_bf16(Bt[n][k], At[m][k], acc[ai][bj][m][n], 0, 0, 0); } __builtin_amdgcn_s_setprio(0); } while (0)
#define PG8_WAIT_V(n) asm volatile("s_waitcnt vmcnt(" #n ")" ::: "memory")
#define PG8_WAIT_L(n) asm volatile("s_waitcnt lgkmcnt(" #n ")" ::: "memory")
#define PG8_BAR __builtin_amdgcn_s_barrier()
#define PG8_SCHED __builtin_amdgcn_sched_barrier(0)
#define PG8_GOFF(dst, u) do { if constexpr (GATHER) { _Pragma("unroll") for (int _h = 0; _h < 2; ++_h) _Pragma("unroll") for (int _i = 0; _i < 2; ++_i) \
        dst[_h][_i] = (unsigned)g.rowtab[(u).pm * BM + _h * HALF + Rg[_i]] * (unsigned)K + (unsigned)(Cg[_i] * 2); } } while (0)
    Unit cur, nxt; int ui = 0;
    if (!S.next(0, cur)) return;
    f32x4 acc[2][2][4][2];
#pragma unroll
    for (int a = 0; a < 2; ++a)
#pragma unroll
        for (int b = 0; b < 2; ++b)
#pragma unroll
            for (int m = 0; m < 4; ++m)
#pragma unroll
                for (int n = 0; n < 2; ++n) acc[a][b][m][n] = (f32x4){0.f, 0.f, 0.f, 0.f};
    bf16x8 At[4][2], B0[2][2], B1[2][2]; i32x8 At8[4], B08[2], B18[2];
    const int sclAv = g.sclA, sclBv = g.sclB;
    PG8_GOFF(vAc, cur);
#pragma unroll
    for (int _h = 0; _h < 2; ++_h)
#pragma unroll
        for (int _i = 0; _i < 2; ++_i) vAn[_h][_i] = vAc[_h][_i];
    const char* cA = GATHER ? (const char*)g.A : (const char*)g.A + (size_t)cur.pm * tstep;
    const char* cB = (const char*)g.Bt + (size_t)cur.e * g.bstride + (size_t)cur.pn * tstep;
    PG8_STAGE(PG8_SB(0, 0), cB, voffB); PG8_STAGE(PG8_SB(0, 1), cB + hstep, voffB); PG8_STAGE_A(PG8_SA(0, 0), cA, 0, false); PG8_STAGE_A(PG8_SA(0, 1), cA, 1, false);
    if (wr == 1) PG8_BAR;
    PG8_WAIT_V(2); PG8_BAR;
    PG8_STAGE(PG8_SB(1, 0), cB + kstep, voffB); PG8_STAGE_A(PG8_SA(1, 0), cA + kstep, 0, false); PG8_STAGE(PG8_SB(1, 1), cB + hstep + kstep, voffB);
    PG8_WAIT_V(6); PG8_BAR;
    for (;;) {
        const bool has_next = S.next(ui + 1, nxt);
        if (has_next) { PG8_GOFF(vAn, nxt); }
        const char* nA = GATHER ? (const char*)g.A : (has_next ? (const char*)g.A + (size_t)nxt.pm * tstep : cA);
        const char* nB = has_next ? (const char*)g.Bt + (size_t)nxt.e * g.bstride + (size_t)nxt.pn * tstep : cB;
        for (int t = 0; t < nt; t += 2) {
            const bool last = (t == nt - 2);
            const char* a1 = cA + (size_t)(t + 1) * kstep;
            const char* a2 = last ? nA : cA + (size_t)(t + 2) * kstep; const char* b2 = last ? nB : cB + (size_t)(t + 2) * kstep;
            const char* a3 = a2 + kstep; const char* b3 = b2 + kstep;
            PG8_LDB(B0, 0, 0); PG8_LDB(B1, 0, 1); PG8_SCHED; PG8_LDA(At, 0, 0); PG8_STAGE_A(PG8_SA(1, 1), a1, 1, false);
            PG8_WAIT_V(8); PG8_WAIT_L(0); PG8_BAR; PG8_MMA(0, 0, At, B0); PG8_MMA(0, 1, At, B1); PG8_BAR; PG8_SCHED;
            PG8_LDA(At, 0, 1); PG8_STAGE(PG8_SB(0, 0), b2, voffB); PG8_STAGE(PG8_SB(0, 1), b2 + hstep, voffB); PG8_STAGE_A(PG8_SA(0, 0), a2, 0, last);
            PG8_WAIT_V(8); PG8_WAIT_L(0); PG8_BAR; PG8_MMA(1, 0, At, B0); PG8_MMA(1, 1, At, B1); PG8_BAR; PG8_SCHED;
            PG8_LDB(B0, 1, 0); PG8_LDB(B1, 1, 1); PG8_SCHED; PG8_LDA(At, 1, 0); PG8_STAGE_A(PG8_SA(0, 1), a2, 1, last);
            PG8_WAIT_V(8); PG8_WAIT_L(0); PG8_BAR; PG8_MMA(0, 0, At, B0); PG8_MMA(0, 1, At, B1); PG8_BAR; PG8_SCHED;
            PG8_LDA(At, 1, 1); PG8_STAGE(PG8_SB(1, 0), b3, voffB); PG8_STAGE(PG8_SB(1, 1), b3 + hstep, voffB); PG8_STAGE_A(PG8_SA(1, 0), a3, 0, last);
            PG8_WAIT_V(8); PG8_WAIT_L(0); PG8_BAR; PG8_MMA(1, 0, At, B0); PG8_MMA(1, 1, At, B1); PG8_BAR; PG8_SCHED;
        }
        if constexpr (ALIGN_EPI) { if (wr == 0) PG8_BAR; }
        E(acc, cur, wr, wc, fr, fq);
        if (!has_next) break;
#pragma unroll
        for (int a = 0; a < 2; ++a)
#pragma unroll
            for (int b = 0; b < 2; ++b)
#pragma unroll
                for (int m = 0; m < 4; ++m)
#pragma unroll
                    for (int n = 0; n < 2; ++n) acc[a][b][m][n] = (f32x4){0.f, 0.f, 0.f, 0.f};
        cur = nxt; cA = nA; cB = nB; ++ui;
#pragma unroll
        for (int _h = 0; _h < 2; ++_h)
#pragma unroll
            for (int _i = 0; _i < 2; ++_i) vAc[_h][_i] = vAn[_h][_i];
        if constexpr (ALIGN_EPI) { if (wr == 1) PG8_BAR; }
    }
    PG8_WAIT_V(0);
    if constexpr (!ALIGN_EPI) { if (wr == 0) PG8_BAR; }
    PG8_BAR;
#undef PG8_SA
#undef PG8_SB
#undef PG8_STAGE
#undef PG8_STAGE_A
#undef PG8_LDA
#undef PG8_LDB
#undef PG8_MMA
#undef PG8_LD8
#undef PG8_WAIT_V
#undef PG8_WAIT_L
#undef PG8_BAR
#undef PG8_SCHED
#undef PG8_GOFF
}

typedef const f32x4 (&AccRef)[2][2][4][2];

struct EpiZ {
    static constexpr bool PERM = true;
    bf16* Z; int ldc; const float* rs;
    __device__ __forceinline__ void operator()(AccRef acc, const Unit& u, int wr, int wc, int fr, int fq) const {
        const int row0 = u.pm * BM + wr * 64 + fr, col0 = u.pn * BM + wc * 32 + 8 * fq;
#pragma unroll
        for (int ai = 0; ai < 2; ++ai)
#pragma unroll
            for (int m = 0; m < 4; ++m) { const int r = row0 + ai * HALF + m * 16; const float s = rs[r]; bf16* rowp = Z + (size_t)r * ldc + col0;
#pragma unroll
                for (int bj = 0; bj < 2; ++bj) { const f32x4 v0 = acc[ai][bj][m][0] * s, v1 = acc[ai][bj][m][1] * s;
                    u32x4 w; w.x = pk2(v0[0], v0[1]); w.y = pk2(v0[2], v0[3]); w.z = pk2(v1[0], v1[1]); w.w = pk2(v1[2], v1[3]);
                    *(u32x4*)(rowp + bj * HALF) = w; } }
    }
};
struct EpiPe {
    static constexpr bool PERM = true;
    bf16* O; float* ssq;
    __device__ __forceinline__ void operator()(AccRef acc, const Unit& u, int wr, int wc, int fr, int fq) const {
        const int row0 = u.pm * BM + wr * 64 + fr, col0 = u.pn * BM + wc * 32 + 8 * fq;
#pragma unroll
        for (int ai = 0; ai < 2; ++ai)
#pragma unroll
            for (int m = 0; m < 4; ++m) { const int r = row0 + ai * HALF + m * 16; bf16* rowp = O + (size_t)r * DM + col0; float ss = 0.f;
#pragma unroll
                for (int bj = 0; bj < 2; ++bj) { const f32x4 v0 = acc[ai][bj][m][0], v1 = acc[ai][bj][m][1];
                    ss += (v0[0] * v0[0] + v0[1] * v0[1]) + (v0[2] * v0[2] + v0[3] * v0[3]) + (v1[0] * v1[0] + v1[1] * v1[1]) + (v1[2] * v1[2] + v1[3] * v1[3]);
                    u32x4 w; w.x = pk2(v0[0], v0[1]); w.y = pk2(v0[2], v0[3]); w.z = pk2(v1[0], v1[1]); w.w = pk2(v1[2], v1[3]);
                    *(u32x4*)(rowp + bj * HALF) = w; }
                ss += __shfl_xor(ss, 16); ss += __shfl_xor(ss, 32);
                if (fq == 0) ssq[(size_t)r * 32 + u.pn * 4 + wc] = ss; }
    }
};
struct EpiOut {
    static constexpr bool PERM = false;
    const float* X; float* H; float* ssq;
    __device__ __forceinline__ void operator()(AccRef acc, const Unit& u, int wr, int wc, int fr, int fq) const {
        const int row0 = u.pm * BM + wr * 64 + fr, col0 = u.pn * BM + wc * 32 + 4 * fq;
#pragma unroll
        for (int ai = 0; ai < 2; ++ai)
#pragma unroll
            for (int m2 = 0; m2 < 2; ++m2) { f32x4 xv[2][2][2];
#pragma unroll
                for (int mm = 0; mm < 2; ++mm) { const size_t off = (size_t)(row0 + ai * HALF + (2 * m2 + mm) * 16) * DM + col0;
#pragma unroll
                    for (int bj = 0; bj < 2; ++bj)
#pragma unroll
                        for (int n = 0; n < 2; ++n) xv[mm][bj][n] = *(const f32x4*)(X + off + bj * HALF + n * 16); }
                asm volatile("" ::: "memory");
#pragma unroll
                for (int mm = 0; mm < 2; ++mm) { const int m = 2 * m2 + mm, r = row0 + ai * HALF + m * 16; const size_t off = (size_t)r * DM + col0; float ss = 0.f;
#pragma unroll
                    for (int bj = 0; bj < 2; ++bj)
#pragma unroll
                        for (int n = 0; n < 2; ++n) { const f32x4 h = xv[mm][bj][n] + acc[ai][bj][m][n]; *(f32x4*)(H + off + bj * HALF + n * 16) = h; ss += (h[0] * h[0] + h[1] * h[1]) + (h[2] * h[2] + h[3] * h[3]); }
                    ss += __shfl_xor(ss, 16); ss += __shfl_xor(ss, 32);
                    if (fq == 0) ssq[(size_t)r * 32 + u.pn * 4 + wc] = ss; } }
    }
};
struct EpiMoe1 {
    static constexpr bool PERM = true;
    unsigned char* ACT; const float* bgu;
    __device__ __forceinline__ void operator()(AccRef acc, const Unit& u, int wr, int wc, int fr, int fq) const {
        const int row0 = u.pm * BM + wr * 64 + fr, j0 = u.pn * HALF + wc * 32 + 8 * fq;
        const float* bp = bgu + (size_t)u.e * 4096 + 2 * j0;
        const f32x4 b0 = *(const f32x4*)(bp), b1 = *(const f32x4*)(bp + 4), b2 = *(const f32x4*)(bp + 8), b3 = *(const f32x4*)(bp + 12);
        const float bg[8] = {b0[0], b0[2], b1[0], b1[2], b2[0], b2[2], b3[0], b3[2]}, bu[8] = {b0[1], b0[3], b1[1], b1[3], b2[1], b2[3], b3[1], b3[3]};
#pragma unroll
        for (int ai = 0; ai < 2; ++ai)
#pragma unroll
            for (int m = 0; m < 4; ++m) { const int r = row0 + ai * HALF + m * 16; float o[8];
#pragma unroll
                for (int n = 0; n < 2; ++n)
#pragma unroll
                    for (int q = 0; q < 4; ++q) { float gt = acc[ai][0][m][n][q] + bg[4 * n + q], up = acc[ai][1][m][n][q] + bu[4 * n + q];
                        gt = fminf(gt, 7.f); up = fminf(fmaxf(up, -7.f), 7.f); o[4 * n + q] = gt * sigm(1.702f * gt) * (up + 1.f) * ACT8_SCALE; }
                u32x2 w; w.x = pk4_fp8(o[0], o[1], o[2], o[3]); w.y = pk4_fp8(o[4], o[5], o[6], o[7]);
                *(u32x2*)(ACT + (size_t)r * DM + j0) = w; }
    }
};
struct EpiMoe2 {
    static constexpr bool PERM = true;
    unsigned char* YB; const float* bdn; const float* rowgate;
    __device__ __forceinline__ void operator()(AccRef acc, const Unit& u, int wr, int wc, int fr, int fq) const {
        const int row0 = u.pm * BM + wr * 64 + fr, col0 = u.pn * BM + wc * 32 + 8 * fq;
        const float* bp = bdn + (size_t)u.e * DM + col0;
        f32x4 bv[2][2];
#pragma unroll
        for (int bj = 0; bj < 2; ++bj)
#pragma unroll
            for (int n = 0; n < 2; ++n) bv[bj][n] = *(const f32x4*)(bp + bj * HALF + 4 * n);
#pragma unroll
        for (int ai = 0; ai < 2; ++ai)
#pragma unroll
            for (int m = 0; m < 4; ++m) { const int r = row0 + ai * HALF + m * 16; const float gt = rowgate[r] * YB8_SCALE; unsigned char* rowp = YB + (size_t)r * DM + col0;
#pragma unroll
                for (int bj = 0; bj < 2; ++bj) { const f32x4 v0 = (acc[ai][bj][m][0] + bv[bj][0]) * gt, v1 = (acc[ai][bj][m][1] + bv[bj][1]) * gt;
                    *(u32x2*)(rowp + bj * HALF) = (u32x2){pk4_fp8(v0[0], v0[1], v0[2], v0[3]), pk4_fp8(v1[0], v1[1], v1[2], v1[3])}; } }
    }
};
struct EpiPg {
    static constexpr bool PERM = true;
    const bf16* H2; const bf16* PE; const float* rs3; const float* rspe; const float* gpost; bf16* H3; float* ssq;
    __device__ __forceinline__ void operator()(AccRef acc, const Unit& u, int wr, int wc, int fr, int fq) const {
        const int row0 = u.pm * BM + wr * 64 + fr, col0 = u.pn * BM + wc * 32 + 8 * fq;
#pragma unroll
        for (int ai = 0; ai < 2; ++ai)
#pragma unroll
            for (int m = 0; m < 4; ++m) { const int r = row0 + ai * HALF + m * 16; const size_t off = (size_t)r * DM + col0; const float s3 = rs3[r], sp = rspe[r]; float ss = 0.f;
#pragma unroll
                for (int bj = 0; bj < 2; ++bj) { const size_t o = off + bj * HALF; const f32x4 gp0 = *(const f32x4*)(gpost + col0 + bj * HALF), gp1 = *(const f32x4*)(gpost + col0 + bj * HALF + 4);
                    const u32x4 pw = *(const u32x4*)(PE + o), hw = *(const u32x4*)(H2 + o); const f32x4 a0 = acc[ai][bj][m][0] * s3, a1 = acc[ai][bj][m][1] * s3;
                    float h[8];
                    h[0] = bflo(hw.x) + sigm(a0[0]) * (bflo(pw.x) * sp * gp0[0]); h[1] = bfhi(hw.x) + sigm(a0[1]) * (bfhi(pw.x) * sp * gp0[1]);
                    h[2] = bflo(hw.y) + sigm(a0[2]) * (bflo(pw.y) * sp * gp0[2]); h[3] = bfhi(hw.y) + sigm(a0[3]) * (bfhi(pw.y) * sp * gp0[3]);
                    h[4] = bflo(hw.z) + sigm(a1[0]) * (bflo(pw.z) * sp * gp1[0]); h[5] = bfhi(hw.z) + sigm(a1[1]) * (bfhi(pw.z) * sp * gp1[1]);
                    h[6] = bflo(hw.w) + sigm(a1[2]) * (bflo(pw.w) * sp * gp1[2]); h[7] = bfhi(hw.w) + sigm(a1[3]) * (bfhi(pw.w) * sp * gp1[3]);
                    *(u32x4*)(H3 + o) = (u32x4){pk2(h[0], h[1]), pk2(h[2], h[3]), pk2(h[4], h[5]), pk2(h[6], h[7])};
                    ss += ((h[0] * h[0] + h[1] * h[1]) + (h[2] * h[2] + h[3] * h[3])) + ((h[4] * h[4] + h[5] * h[5]) + (h[6] * h[6] + h[7] * h[7])); }
                ss += __shfl_xor(ss, 16); ss += __shfl_xor(ss, 32);
                if (fq == 0) ssq[(size_t)r * 32 + u.pn * 4 + wc] = ss; }
    }
};
}

__device__ __forceinline__ bf16x8 frag(const LAS bf16* base, int row0, int ld, int k0, int lane) {
    return *(const LAS bf16x8*)(base + (row0 + (lane & 15)) * ld + k0 + 8 * (lane >> 4));
}
#define MMA16(a, b, c) __builtin_amdgcn_mfma_f32_16x16x32_bf16(a, b, c, 0, 0, 0)

struct Args { const float* in[24]; float* out; unsigned char* ws; int ph_lo, ph_hi, aux, pad; };
__device__ __forceinline__ const float* argin(const Args& a, int k) { asm volatile("" : "+s"(k)); return a.in[k]; }

__device__ __forceinline__ void tr_tile(const float* W, int ldn, int c0, int k0, const float* g, bf16* WT, int K, int d0, int mode, int lane) {
    const int kk = lane >> 4, n4 = lane & 15;
    const float* src = W + (size_t)(k0 + 16 * kk) * ldn + c0 + 4 * n4;
    f32x4 v[16];
#pragma unroll
    for (int i = 0; i < 16; ++i) v[i] = __builtin_nontemporal_load((const f32x4*)(src + (size_t)i * ldn));
    if (g) { const f32x4* gp = (const f32x4*)(g + k0 + 16 * kk);
#pragma unroll
        for (int i4 = 0; i4 < 4; ++i4) { const f32x4 gv = gp[i4];
#pragma unroll
            for (int e = 0; e < 4; ++e) v[4 * i4 + e] = v[4 * i4 + e] * gv[e]; } }
#pragma unroll
    for (int q = 0; q < 4; ++q) { const int j = 4 * n4 + q; int dr; if (mode == 0) dr = d0 + j; else { const int jj = (c0 + j) >> 1; dr = 256 * (jj >> 7) + (jj & 127) + 128 * (j & 1); }
        u32x4 o0, o1;
        o0.x = pk2(v[0][q], v[1][q]); o0.y = pk2(v[2][q], v[3][q]); o0.z = pk2(v[4][q], v[5][q]); o0.w = pk2(v[6][q], v[7][q]);
        o1.x = pk2(v[8][q], v[9][q]); o1.y = pk2(v[10][q], v[11][q]); o1.z = pk2(v[12][q], v[13][q]); o1.w = pk2(v[14][q], v[15][q]);
        bf16* dst = WT + (size_t)dr * K + k0 + 16 * kk; *(u32x4*)dst = o0; *(u32x4*)(dst + 8) = o1; }
}
__device__ __forceinline__ int win_src_col(int n) { return n < 3072 ? n : (n < 6144 ? n + 16 : n + 24); }

__device__ __forceinline__ void p0_weights(const Args& a, int gw, int NGW, int lane) {
    unsigned char* ws = a.ws;
    constexpr int I_WIN = 112 * 32, I_WPP = 32 * 4, I_WOUT = 32 * 32;
    for (int it = gw; it < I_WIN + I_WPP + I_WOUT; it += NGW) {
        int r = it;
        if (r >= I_WIN + I_WPP) { r -= I_WIN + I_WPP; const int kb = r >> 5, nb = r & 31; tr_tile(argin(a, 11), DM, 64 * nb, 64 * kb, nullptr, (bf16*)(ws + WS_WOUT), DM, 64 * nb, 0, lane); continue; }
        if (r < I_WIN) { const int kb = r / 112, nb = r - kb * 112; tr_tile(argin(a, 3), DIN, win_src_col(64 * nb), 64 * kb, argin(a, 2), (bf16*)(ws + WS_WIN), DM, 64 * nb, 0, lane); continue; } r -= I_WIN;
        { const int kb = r >> 5, nb = r & 31; tr_tile(argin(a, 21), DM, 64 * nb, 64 * kb, nullptr, (bf16*)(ws + WS_WPP), PLE, 64 * nb, 0, lane); }
    }
}
constexpr int POOL_WGU = 32 * 16 * 16, POOL_WDN = 32 * 16 * 8, POOL_WPG = 16 * 8, NPOOL = POOL_WGU + POOL_WDN + POOL_WPG;
struct PoolTile { const float* W; const float* g; unsigned char* WT; int ldn, c0, k0, d0, mode; };
__device__ __forceinline__ void pool_tile_desc(const Args& a, int r, PoolTile& t) {
    unsigned char* ws = a.ws;
    if (r < POOL_WGU) { const int e = r >> 8, kb = (r >> 4) & 15, nb = r & 15; t.W = argin(a, 15) + (size_t)e * DM * 4096; t.g = argin(a, 12); t.WT = ws + WS_WGU + (size_t)e * 4096 * DM; t.ldn = 4096; t.c0 = 256 * nb; t.k0 = 128 * kb; t.d0 = 0; t.mode = 1; return; } r -= POOL_WGU;
    if (r < POOL_WDN) { const int e = r >> 7, kb = (r >> 3) & 15, nb = r & 7; t.W = argin(a, 17) + (size_t)e * DM * DM; t.g = nullptr; t.WT = ws + WS_WDN + (size_t)e * DM * DM; t.ldn = DM; t.c0 = 256 * nb; t.k0 = 128 * kb; t.d0 = 256 * nb; t.mode = 0; return; } r -= POOL_WDN;
    { const int kb = r >> 3, nb = r & 7; t.W = argin(a, 20); t.g = argin(a, 19); t.WT = ws + WS_WPG; t.ldn = DM; t.c0 = 256 * nb; t.k0 = 128 * kb; t.d0 = 256 * nb; t.mode = 0; }
}
#define POOL_LOAD(t, v) do { const float* _src = (t).W + (size_t)((t).k0 + 16 * wid) * (t).ldn + (t).c0 + 4 * lane; _Pragma("unroll") for (int _i = 0; _i < 16; ++_i) (v)[_i] = __builtin_nontemporal_load((const f32x4*)(_src + (size_t)_i * (t).ldn)); } while (0)
__device__ __forceinline__ void convert_pool(const Args& a, LAS unsigned char* lds, int tid, int wid, int lane) {
    unsigned* ctr = (unsigned*)(a.ws + WS_CTL) + CW_POOL + (a.aux == 6 ? 64 : 0);
    LAS unsigned char* T = lds;
    LAS int* nxt = (LAS int*)(lds + 40960);
    f32x4 v[16]; PoolTile cur, nx; int have;
    if (tid == 0) nxt[0] = (int)__hip_atomic_fetch_add(ctr, 1u, __ATOMIC_RELAXED, __HIP_MEMORY_SCOPE_AGENT);
    __syncthreads();
    int r = __builtin_amdgcn_readfirstlane(nxt[0]); have = r < NPOOL;
    if (have) { pool_tile_desc(a, r, cur); POOL_LOAD(cur, v); }
    int slot = 1;
    while (have) {
        if (tid == 0) nxt[slot] = (int)__hip_atomic_fetch_add(ctr, 1u, __ATOMIC_RELAXED, __HIP_MEMORY_SCOPE_AGENT);
        { f32x4 gs[4];
#pragma unroll
          for (int i4 = 0; i4 < 4; ++i4) gs[i4] = cur.g ? *(const f32x4*)(cur.g + cur.k0 + 16 * wid + 4 * i4) * W8_SCALE : (f32x4){W8_SCALE, W8_SCALE, W8_SCALE, W8_SCALE};
#pragma unroll
          for (int i = 0; i < 16; ++i) v[i] = v[i] * gs[i >> 2][i & 3];
#pragma unroll
          for (int q = 0; q < 4; ++q) { u32x4 o;
              o.x = pk4_fp8(v[0][q], v[1][q], v[2][q], v[3][q]); o.y = pk4_fp8(v[4][q], v[5][q], v[6][q], v[7][q]); o.z = pk4_fp8(v[8][q], v[9][q], v[10][q], v[11][q]); o.w = pk4_fp8(v[12][q], v[13][q], v[14][q], v[15][q]);
              *(LAS u32x4*)(T + (4 * lane + q) * 128 + ((wid ^ (lane & 7)) << 4)) = o; } }
        __syncthreads();
        const int rn = __builtin_amdgcn_readfirstlane(nxt[slot]); const int have_n = rn < NPOOL;
        if (have_n) { pool_tile_desc(a, rn, nx); POOL_LOAD(nx, v); }
#pragma unroll
        for (int it = 0; it < 4; ++it) { const int row = 32 * wid + 8 * it + (lane >> 3), c = lane & 7;
            const u32x4 o = *(const LAS u32x4*)(T + row * 128 + ((c ^ ((row >> 2) & 7)) << 4));
            int dr; if (cur.mode == 0) dr = cur.d0 + row; else { const int jj = (cur.c0 + row) >> 1; dr = 256 * (jj >> 7) + (jj & 127) + 128 * (row & 1); }
            __builtin_nontemporal_store(o, (u32x4*)(cur.WT + (size_t)dr * DM + cur.k0 + 16 * c)); }
        __syncthreads();
        cur = nx; have = have_n; slot ^= 1;
    }
}
#undef POOL_LOAD

template <class Side>
__device__ __forceinline__ void skinny_mfma(const float* A, const bf16* Whi, const bf16* Wlo, LAS float* red, LAS float* Ls, int tid, int wid, int lane, const Side& side) {
    const int g4 = lane >> 4, c15 = lane & 15;
    f32x4 acc[4][2];
#pragma unroll
    for (int rt = 0; rt < 4; ++rt) { acc[rt][0] = (f32x4){0.f, 0.f, 0.f, 0.f}; acc[rt][1] = (f32x4){0.f, 0.f, 0.f, 0.f}; }
    const float* ap = A + (size_t)c15 * DM + 256 * wid + 8 * g4;
    const bf16* bh = Whi + (size_t)c15 * DM + 256 * wid + 8 * g4; const bf16* bl = Wlo + (size_t)c15 * DM + 256 * wid + 8 * g4;
    f32x4 av[2][4][2]; u32x4 bv[2][2][2];
#define SK_LOAD(buf, ks) do { _Pragma("unroll") for (int rt = 0; rt < 4; ++rt) { av[buf][rt][0] = *(const f32x4*)(ap + (size_t)(16 * rt) * DM + 32 * (ks)); av[buf][rt][1] = *(const f32x4*)(ap + (size_t)(16 * rt) * DM + 32 * (ks) + 4); } \
        _Pragma("unroll") for (int ct = 0; ct < 2; ++ct) { bv[buf][ct][0] = *(const u32x4*)(bh + (size_t)(16 * ct) * DM + 32 * (ks)); bv[buf][ct][1] = *(const u32x4*)(bl + (size_t)(16 * ct) * DM + 32 * (ks)); } } while (0)
    SK_LOAD(0, 0);
#pragma unroll
    for (int ks = 0; ks < 8; ++ks) { const int cb = ks & 1;
        if (ks < 7) SK_LOAD(cb ^ 1, ks + 1);
#pragma unroll
        for (int rt = 0; rt < 4; ++rt) { const f32x4 v0 = av[cb][rt][0], v1 = av[cb][rt][1];
            side(rt, 256 * wid + 32 * ks + 8 * g4, v0, v1);
            u32x4 hi, lo; hi.x = pk2(v0[0], v0[1]); hi.y = pk2(v0[2], v0[3]); hi.z = pk2(v1[0], v1[1]); hi.w = pk2(v1[2], v1[3]);
            lo.x = pk2(v0[0] - bflo(hi.x), v0[1] - bfhi(hi.x)); lo.y = pk2(v0[2] - bflo(hi.y), v0[3] - bfhi(hi.y)); lo.z = pk2(v1[0] - bflo(hi.z), v1[1] - bfhi(hi.z)); lo.w = pk2(v1[2] - bflo(hi.w), v1[3] - bfhi(hi.w));
            const bf16x8 ah = __builtin_bit_cast(bf16x8, hi), al = __builtin_bit_cast(bf16x8, lo);
#pragma unroll
            for (int ct = 0; ct < 2; ++ct) { const bf16x8 wh = __builtin_bit_cast(bf16x8, bv[cb][ct][0]), wl = __builtin_bit_cast(bf16x8, bv[cb][ct][1]);
                acc[rt][ct] = MMA16(ah, wh, acc[rt][ct]); acc[rt][ct] = MMA16(al, wh, acc[rt][ct]); acc[rt][ct] = MMA16(ah, wl, acc[rt][ct]); } } }
#undef SK_LOAD
#pragma unroll
    for (int rt = 0; rt < 4; ++rt)
#pragma unroll
        for (int ct = 0; ct < 2; ++ct)
#pragma unroll
            for (int rg = 0; rg < 4; ++rg) red[(wid * 64 + 16 * rt + 4 * g4 + rg) * 33 + 16 * ct + c15] = acc[rt][ct][rg];
    __syncthreads();
    { const int row = tid >> 3, n4 = (tid & 7) * 4;
#pragma unroll
      for (int q = 0; q < 4; ++q) { float s = 0.f;
#pragma unroll
          for (int w = 0; w < 8; ++w) s += red[(w * 64 + row) * 33 + n4 + q];
          Ls[row * 33 + n4 + q] = s; } }
    __syncthreads();
}

__device__ __forceinline__ void xgate_unit(const Args& a, int u, LAS unsigned char* lds, int tid, int wid, int lane) {
    asm volatile("" : "+v"(tid), "+v"(lane));
    unsigned char* sm = a.ws + WS_SMALL;
    LAS float* red = (LAS float*)lds; LAS float* Gs = (LAS float*)(lds + 67584); LAS float* gl = (LAS float*)(lds + 67584 + 8448); LAS float* il = gl + 64 * 12;
    const int t0 = u * 64;
    skinny_mfma(argin(a, 0) + (size_t)t0 * DM, (const bf16*)(a.ws + WS_WSK), (const bf16*)(a.ws + WS_WSK) + 32 * DM, red, Gs, tid, wid, lane, [](int, int, const f32x4&, const f32x4&) {});
    if (tid < 64) { const int l = tid, t = t0 + l; float* BETA = (float*)(sm + SM_BETA); float* IC = (float*)(sm + SM_IC); const float rs = ((const float*)(sm + SM_RS1))[t];
        const float* a_log = argin(a, 5); const float* dt_b = argin(a, 6); const float* b_i = argin(a, 8); const float* b_f = argin(a, 9);
        for (int h = 0; h < 8; ++h) { const float av = Gs[l * 33 + h] * rs; gl[l * 12 + h] = -expf(a_log[h]) * softplusf(av + dt_b[h]); BETA[t * 8 + h] = 1.f / (1.f + expf(-Gs[l * 33 + 8 + h] * rs)); }
        for (int h = 0; h < 4; ++h) { const float ip = 15.f * tanhf((Gs[l * 33 + 16 + h] * rs + b_i[h]) * (1.f / 15.f)); il[l * 4 + h] = ip; IC[t * 4 + h] = ip;
            const float fp = 15.f * tanhf((Gs[l * 33 + 20 + h] * rs + b_f[h]) * (1.f / 15.f)); gl[l * 12 + 8 + h] = -softplusf(-fp); } }
    __syncthreads();
    {
        float* GC = (float*)(sm + SM_GC); float* FC = (float*)(sm + SM_FC);
        for (int j = wid; j < 12; j += 8) { float v = gl[lane * 12 + j];
#pragma unroll
            for (int off = 1; off < 64; off <<= 1) { const float vp = __shfl_up(v, off); if (lane >= off) v += vp; }
            if (j < 8) GC[(t0 + lane) * 8 + j] = v; else { const int h = j - 8; FC[(t0 + lane) * 4 + h] = v; const float tot = __shfl(v, 63); float am = tot - v + il[lane * 4 + h];
#pragma unroll
                for (int off = 1; off < 64; off <<= 1) am = fmaxf(am, __shfl_xor(am, off));
                if (lane == 0) { ((float*)(sm + SM_FLAST))[u * 4 + h] = tot; ((float*)(sm + SM_AMAX))[u * 4 + h] = am; } } }
    }
    __syncthreads();
}

__device__ __forceinline__ int tsw(int row, int l, int sh) { return row * 72 + ((((l >> 3) ^ (row >> sh)) & 7) << 3) + (l & 7); }
__device__ __forceinline__ bf16x8 fragsw(const LAS bf16* base, int rt  , int ks, int lane, int sh) {
    return *(const LAS bf16x8*)(base + (16 * rt + (lane & 15)) * 72 + ((((4 * ks + (lane >> 4)) ^ ((16 * rt) >> sh)) & 7) << 3));
}
#define MMA4F(a, b, c) __builtin_amdgcn_mfma_f32_16x16x4f32(a, b, c, 0, 0, 0)

struct GdnPre { u32x4 z[3]; f32x4 cw; };
#define GDN_ZLOAD(ugx, tz, R) do { const int _b = (ugx) >> 9, _h = ((ugx) >> 6) & 7, _c = (ugx) & 63; const bf16* _zb = (const bf16*)(a.ws + WS_Z) + ((long)(_b * SEQL + _c * 64 - 3)) * NZ + (tz) * 1024 + _h * 128 + (tid & 15) * 8; \
        _Pragma("unroll") for (int _k = 0; _k < 3; ++_k) { const int _r = (tid >> 4) + 32 * _k; const bool _ok = (_k < 2 || tid < 48) && (_c * 64 - 3 + _r >= 0); \
            (R)[_k] = _ok ? *(const u32x4*)(_zb + (long)_r * NZ) : (u32x4){0u, 0u, 0u, 0u}; } } while (0)
#define GDN_ZPUT(R, ZSx) do { *(LAS u32x4*)((ZSx) + ((tid >> 4)) * 136 + (tid & 15) * 8) = (R)[0]; *(LAS u32x4*)((ZSx) + ((tid >> 4) + 32) * 136 + (tid & 15) * 8) = (R)[1]; \
        if (tid < 48) *(LAS u32x4*)((ZSx) + ((tid >> 4) + 64) * 136 + (tid & 15) * 8) = (R)[2]; } while (0)
#define GDN_CWLOAD(ugx, dst) do { if (tid < 384) { const int _h = ((ugx) >> 6) & 7, _tj = tid >> 5; (dst) = *(const f32x4*)(argin(a, 4) + (_tj & 3) * 3072 + (_tj >> 2) * 1024 + _h * 128 + (tid & 31) * 4); } } while (0)
#define GDN_CONV(tz, ZSx, out) do { _Pragma("unroll") for (int _i = 0; _i < 16; ++_i) (out)[_i] = 0.f; \
        _Pragma("unroll") for (int _j = 0; _j < 4; ++_j) { const LAS bf16* _zr = (ZSx) + (l + _j) * 136 + cg * 16; const u32x4 _w0 = *(const LAS u32x4*)_zr, _w1 = *(const LAS u32x4*)(_zr + 8); \
            const LAS float* _cw = CWs + ((tz) * 4 + _j) * 128 + cg * 16; const f32x4 _c0 = *(const LAS f32x4*)_cw, _c1 = *(const LAS f32x4*)(_cw + 4), _c2 = *(const LAS f32x4*)(_cw + 8), _c3 = *(const LAS f32x4*)(_cw + 12); \
            (out)[0] += _c0[0] * bflo(_w0.x); (out)[1] += _c0[1] * bfhi(_w0.x); (out)[2] += _c0[2] * bflo(_w0.y); (out)[3] += _c0[3] * bfhi(_w0.y); \
            (out)[4] += _c1[0] * bflo(_w0.z); (out)[5] += _c1[1] * bfhi(_w0.z); (out)[6] += _c1[2] * bflo(_w0.w); (out)[7] += _c1[3] * bfhi(_w0.w); \
            (out)[8] += _c2[0] * bflo(_w1.x); (out)[9] += _c2[1] * bfhi(_w1.x); (out)[10] += _c2[2] * bflo(_w1.y); (out)[11] += _c2[3] * bfhi(_w1.y); \
            (out)[12] += _c3[0] * bflo(_w1.z); (out)[13] += _c3[1] * bfhi(_w1.z); (out)[14] += _c3[2] * bflo(_w1.w); (out)[15] += _c3[3] * bfhi(_w1.w); } \
        _Pragma("unroll") for (int _i = 0; _i < 16; ++_i) { const float _v = (out)[_i]; (out)[_i] = _v * __builtin_amdgcn_rcpf(1.f + __expf(-_v)); } } while (0)

__device__ __forceinline__ void gdn_prep_unit(const Args& a, int ug, int ug_next, GdnPre& pre, LAS unsigned char* lds, int tid, int wid, int lane) {
    asm volatile("" : "+v"(tid), "+v"(lane));
    unsigned char* ws = a.ws; unsigned char* sm = ws + WS_SMALL;
    LAS bf16* KDt = (LAS bf16*)lds; LAS bf16* KBGt = (LAS bf16*)(lds + 18432); LAS bf16* VBt = (LAS bf16*)(lds + 36864); LAS bf16* Qs = (LAS bf16*)(lds + 55296); LAS bf16* Ks = (LAS bf16*)(lds + 72704);
    LAS bf16* GTt = (LAS bf16*)(lds + 55296); LAS bf16* Ti = (LAS bf16*)(lds + 73728); LAS bf16* TiT = (LAS bf16*)(lds + 82944);
    LAS float* Mm = (LAS float*)(lds + 92160); LAS float* TT = (LAS float*)(lds + 109568); LAS float* Td = (LAS float*)(lds + 126976); LAS float* gcs = (LAS float*)(lds + 134752); LAS float* bts = (LAS float*)(lds + 135008);
    LAS bf16* ZS0 = (LAS bf16*)(lds + 92160); LAS bf16* ZS1 = (LAS bf16*)(lds + 110384); LAS float* CWs = (LAS float*)(lds + 128608);
    const int b = ug >> 9, h = (ug >> 6) & 7, c = ug & 63, t0 = b * SEQL + c * 64;
    const int l = tid >> 3, cg = tid & 7, g4 = lane >> 4, c15 = lane & 15;
    const float gcl = ((const float*)(sm + SM_GC))[(t0 + l) * 8 + h], btl = ((const float*)(sm + SM_BETA))[(t0 + l) * 8 + h], gclast = ((const float*)(sm + SM_GC))[(t0 + 63) * 8 + h];
    {
        float qv[16], kv[16], vv[16]; u32x4 R[3];
        GDN_ZPUT(pre.z, ZS0); if (tid < 384) *(LAS f32x4*)(CWs + 4 * tid) = pre.cw;
        GDN_ZLOAD(ug, 1, R);
        __syncthreads();
        GDN_CONV(0, ZS0, qv);
        GDN_ZPUT(R, ZS1); GDN_ZLOAD(ug, 2, R);
        __syncthreads();
        GDN_CONV(1, ZS1, kv);
        GDN_ZPUT(R, ZS0);
        if (ug_next >= 0) { GDN_ZLOAD(ug_next, 0, pre.z); GDN_CWLOAD(ug_next, pre.cw); }
        __syncthreads();
        GDN_CONV(2, ZS0, vv);
        float sq = 0.f, sk = 0.f;
#pragma unroll
        for (int i = 0; i < 16; ++i) { sq += qv[i] * qv[i]; sk += kv[i] * kv[i]; }
#pragma unroll
        for (int o = 1; o < 8; o <<= 1) { sq += __shfl_xor(sq, o); sk += __shfl_xor(sk, o); }
        const float rq = rsqrtf(sq + EPS) * 0.08838834764831845f, rk = rsqrtf(sk + EPS);
        const float eg = expf(gcl), ekd = expf(gclast - gcl);
        unsigned qw[8], kw[8], qdw[8];
#pragma unroll
        for (int i = 0; i < 8; ++i) { const float q0 = qv[2 * i] * rq, q1 = qv[2 * i + 1] * rq, k0 = kv[2 * i] * rk, k1 = kv[2 * i + 1] * rk;
            qw[i] = pk2(q0, q1); kw[i] = pk2(k0, k1); qdw[i] = pk2(q0 * eg, q1 * eg);
            const int d = cg * 16 + 2 * i;
            KBGt[tsw(d, l, 4)] = f2bf(k0 * btl * eg); KBGt[tsw(d + 1, l, 4)] = f2bf(k1 * btl * eg);
            KDt[tsw(d, l, 4)] = f2bf(k0 * ekd); KDt[tsw(d + 1, l, 4)] = f2bf(k1 * ekd);
            VBt[tsw(d, l, 4)] = f2bf(vv[2 * i] * btl); VBt[tsw(d + 1, l, 4)] = f2bf(vv[2 * i + 1] * btl); }
        *(LAS u32x4*)(Qs + l * 136 + cg * 16) = (u32x4){qw[0], qw[1], qw[2], qw[3]}; *(LAS u32x4*)(Qs + l * 136 + cg * 16 + 8) = (u32x4){qw[4], qw[5], qw[6], qw[7]};
        *(LAS u32x4*)(Ks + l * 136 + cg * 16) = (u32x4){kw[0], kw[1], kw[2], kw[3]}; *(LAS u32x4*)(Ks + l * 136 + cg * 16 + 8) = (u32x4){kw[4], kw[5], kw[6], kw[7]};
        bf16* qd = (bf16*)(ws + WS_GQD) + (size_t)ug * 8192 + l * 128 + cg * 16;
        *(u32x4*)qd = (u32x4){qdw[0], qdw[1], qdw[2], qdw[3]}; *(u32x4*)(qd + 8) = (u32x4){qdw[4], qdw[5], qdw[6], qdw[7]};
        if (cg == 0) { gcs[l] = gcl; bts[l] = btl; }
    }
    __syncthreads();
    {
        const int wv = wid & 3; const bool isQ = wid >= 4; const LAS bf16* Ab = isQ ? Qs : Ks;
        f32x4 acc[4];
#pragma unroll
        for (int n = 0; n < 4; ++n) acc[n] = (f32x4){0.f, 0.f, 0.f, 0.f};
#pragma unroll
        for (int ks = 0; ks < 4; ++ks) { const bf16x8 af = frag(Ab, 16 * wv, 136, 32 * ks, lane);
#pragma unroll
            for (int n = 0; n < 4; ++n) acc[n] = MMA16(af, frag(Ks, 16 * n, 136, 32 * ks, lane), acc[n]); }
        bf16* AT = (bf16*)(ws + WS_GAT) + (size_t)ug * 4096;
#pragma unroll
        for (int n = 0; n < 4; ++n)
#pragma unroll
            for (int rg = 0; rg < 4; ++rg) { const int i = 16 * wv + 4 * g4 + rg, j = 16 * n + c15;
                const float dec = (j <= i) ? __expf(gcs[i] - gcs[j]) : 0.f;
                if (!isQ) Mm[i * 68 + j] = (j < i) ? bts[i] * acc[n][rg] * dec : 0.f;
                else AT[i * 64 + j] = f2bf(acc[n][rg] * dec); }
    }
    __syncthreads();
    if (wid == 0) {
        const int blk = g4;
        unsigned mb = (unsigned)(size_t)(Mm + (16 * blk) * 68 + 16 * blk), ml = mb + 4u * (unsigned)c15;
        asm volatile("" : "+v"(mb), "+v"(ml));
        float X[16];
#pragma unroll
        for (int i = 0; i < 16; ++i) { float s = -*(const LAS float*)(size_t)(ml + (unsigned)(i * 68 * 4));
#pragma unroll
            for (int j4 = 0; j4 < (i + 3) / 4; ++j4) { const f32x4 mv = *(const LAS f32x4*)(size_t)(mb + (unsigned)((i * 68 + 4 * j4) * 4));
#pragma unroll
                for (int q = 0; q < 4; ++q) if (4 * j4 + q < i) s -= mv[q] * X[4 * j4 + q]; }
            X[i] = s; }
        const float cf = (float)c15;
#pragma unroll
        for (int i = 0; i < 16; ++i) { X[i] += fmaxf(0.f, 1.f - fabsf(cf - (float)i)); Td[(blk * 16 + i) * 20 + c15] = X[i]; Ti[(16 * blk + i) * 72 + 16 * blk + c15] = f2bf(X[i]); }
        LAS float* ttp = TT + (16 * blk + c15) * 68 + 16 * blk; LAS bf16* tip = TiT + (16 * blk + c15) * 72 + 16 * blk;
#pragma unroll
        for (int i4 = 0; i4 < 4; ++i4) *(LAS f32x4*)(ttp + 4 * i4) = (f32x4){X[4 * i4], X[4 * i4 + 1], X[4 * i4 + 2], X[4 * i4 + 3]};
        *(LAS u32x4*)tip = (u32x4){pk2(X[0], X[1]), pk2(X[2], X[3]), pk2(X[4], X[5]), pk2(X[6], X[7])}; *(LAS u32x4*)(tip + 8) = (u32x4){pk2(X[8], X[9]), pk2(X[10], X[11]), pk2(X[12], X[13]), pk2(X[14], X[15])};
    } else if (wid >= 4) {
        for (int p = tid - 256; p < 384; p += 256) { const int arr = p / 192, q = p - arr * 192, bi6 = q >> 5, r = (q & 31) >> 1, hf = q & 1;
            const int bi = bi6 < 3 ? 0 : (bi6 < 5 ? 1 : 2), bj = bi6 < 3 ? bi6 + 1 : (bi6 < 5 ? bi6 - 1 : 3);
            if (arr) *(LAS u32x4*)(TiT + (16 * bj + r) * 72 + 16 * bi + 8 * hf) = (u32x4){0u, 0u, 0u, 0u};
            else *(LAS u32x4*)(Ti + (16 * bi + r) * 72 + 16 * bj + 8 * hf) = (u32x4){0u, 0u, 0u, 0u}; }
    }
    __syncthreads();
#pragma unroll
    for (int dg = 1; dg < 4; ++dg) {
        if (wid < 4 - dg) { const int bi = wid + dg, bj = wid;
            f32x4 P = (f32x4){0.f, 0.f, 0.f, 0.f};
            for (int k = bj; k < bi; ++k) { const f32x4 a4 = *(const LAS f32x4*)(Mm + (16 * bi + c15) * 68 + 16 * k + 4 * g4), b4 = *(const LAS f32x4*)(TT + (16 * bj + c15) * 68 + 16 * k + 4 * g4);
#pragma unroll
                for (int s = 0; s < 4; ++s) P = MMA4F(a4[s], b4[s], P); }
            const f32x4 t4 = *(const LAS f32x4*)(Td + (bi * 16 + c15) * 20 + 4 * g4);
            f32x4 Q = (f32x4){0.f, 0.f, 0.f, 0.f};
#pragma unroll
            for (int s = 0; s < 4; ++s) Q = MMA4F(t4[s], P[s], Q);
            Q = -Q;
            *(LAS f32x4*)(TT + (16 * bj + c15) * 68 + 16 * bi + 4 * g4) = Q;
            *(LAS u32x2*)(TiT + (16 * bj + c15) * 72 + 16 * bi + 4 * g4) = (u32x2){pk2(Q[0], Q[1]), pk2(Q[2], Q[3])};
#pragma unroll
            for (int rg = 0; rg < 4; ++rg) Ti[(16 * bi + 4 * g4 + rg) * 72 + 16 * bj + c15] = f2bf(Q[rg]);
        }
        __syncthreads();
    }
    {
        const int wv = wid & 3; const LAS bf16* Bb = wid < 4 ? VBt : KBGt; bf16* OUT = (bf16*)(ws + (wid < 4 ? WS_GU : WS_GW)) + (size_t)ug * 8192;
#pragma unroll
        for (int e2 = 0; e2 < 2; ++e2) { const int en = 2 * wv + e2; f32x4 acc[4];
#pragma unroll
            for (int it = 0; it < 4; ++it) acc[it] = (f32x4){0.f, 0.f, 0.f, 0.f};
#pragma unroll
            for (int ks = 0; ks < 2; ++ks) { const bf16x8 af = fragsw(Bb, en, ks, lane, 4);
#pragma unroll
                for (int it = 0; it < 4; ++it) acc[it] = MMA16(af, frag(Ti, 16 * it, 72, 32 * ks, lane), acc[it]); }
#pragma unroll
            for (int it = 0; it < 4; ++it) { const u32x2 pv = (u32x2){pk2(acc[it][0], acc[it][1]), pk2(acc[it][2], acc[it][3])};
                *(u32x2*)(OUT + (((en * 4 + it) * 64) + lane) * 4) = pv; } }
    }
    {
        const int mt = wid & 3;
#pragma unroll
        for (int d4 = 0; d4 < 4; ++d4) { const int dn = (wid >> 2) * 4 + d4; f32x4 acc = (f32x4){0.f, 0.f, 0.f, 0.f};
#pragma unroll
            for (int ks = 0; ks < 2; ++ks) acc = MMA16(frag(TiT, 16 * mt, 72, 32 * ks, lane), fragsw(KDt, dn, ks, lane, 4), acc);
            *(LAS u32x2*)(GTt + (16 * dn + c15) * 72 + 16 * mt + 4 * g4) = (u32x2){pk2(acc[0], acc[1]), pk2(acc[2], acc[3])}; }
        if (tid == 0) ((float*)(sm + SM_GLAST))[ug] = expf(gcs[63]);
    }
    __syncthreads();
    {
        bf16* AP = (bf16*)(ws + WS_GAP) + (size_t)ug * 16384; bf16* BB = (bf16*)(ws + WS_GBB) + (size_t)ug * 16384;
        bf16x8 kf[2], gf[2];
#pragma unroll
        for (int ks = 0; ks < 2; ++ks) { kf[ks] = fragsw(KBGt, wid, ks, lane, 4); gf[ks] = frag(GTt, 16 * wid, 72, 32 * ks, lane); }
#pragma unroll
        for (int n = 0; n < 8; ++n) { f32x4 a1 = (f32x4){0.f, 0.f, 0.f, 0.f}, b1 = (f32x4){0.f, 0.f, 0.f, 0.f};
#pragma unroll
            for (int ks = 0; ks < 2; ++ks) { a1 = MMA16(kf[ks], frag(GTt, 16 * n, 72, 32 * ks, lane), a1); b1 = MMA16(gf[ks], fragsw(VBt, n, ks, lane, 4), b1); }
            *(u32x2*)(AP + (((n * 4 + (wid >> 1)) * 64) + ((2 * wid + (g4 >> 1)) & 3) * 16 + c15) * 8 + 4 * (g4 & 1)) = (u32x2){pk2(-a1[0], -a1[1]), pk2(-a1[2], -a1[3])};
            *(u32x2*)(BB + (((((n >> 1) * 8 + wid) * 2 + (n & 1)) * 64) + lane) * 4) = (u32x2){pk2(b1[0], b1[1]), pk2(b1[2], b1[3])}; }
    }
    __syncthreads();
}

struct MlPre { u32x4 q0, q1, k0, k1, v[4]; float fl, am, fc, ic; };
#define ML_PREP_LOAD(umx, P) do { const int _b = (umx) >> 8, _h = ((umx) >> 6) & 3, _c = (umx) & 63, _t0 = _b * SEQL + _c * 64; const bf16* _zr = (const bf16*)(a.ws + WS_Z) + (size_t)(_t0 + (tid >> 3)) * NZ; const int _cg = tid & 7; \
        (P).q0 = *(const u32x4*)(_zr + ZMQ + _h * 128 + _cg * 16); (P).q1 = *(const u32x4*)(_zr + ZMQ + _h * 128 + _cg * 16 + 8); (P).k0 = *(const u32x4*)(_zr + ZMK + _h * 128 + _cg * 16); (P).k1 = *(const u32x4*)(_zr + ZMK + _h * 128 + _cg * 16 + 8); \
        _Pragma("unroll") for (int _s = 0; _s < 4; ++_s) (P).v[_s] = *(const u32x4*)(_zr + ZMV + _h * 256 + _cg * 32 + _s * 8); \
        if (tid < 64) { const unsigned char* _sm = a.ws + WS_SMALL; (P).fl = ((const float*)(_sm + SM_FLAST))[(_b * 64 + tid) * 4 + _h]; (P).am = ((const float*)(_sm + SM_AMAX))[(_b * 64 + tid) * 4 + _h]; \
            (P).fc = ((const float*)(_sm + SM_FC))[(_t0 + tid) * 4 + _h]; (P).ic = ((const float*)(_sm + SM_IC))[(_t0 + tid) * 4 + _h]; } } while (0)
__device__ __forceinline__ void ml_prep_unit(const Args& a, int um, int um_next, MlPre& pre, LAS unsigned char* lds, int tid, int wid, int lane) {
    asm volatile("" : "+v"(tid), "+v"(lane));
    unsigned char* ws = a.ws; unsigned char* sm = ws + WS_SMALL;
    LAS bf16* Qs = (LAS bf16*)lds; LAS bf16* Ks = (LAS bf16*)(lds + 17408); LAS bf16* VTs = (LAS bf16*)(lds + 34816); LAS bf16* KWTs = (LAS bf16*)(lds + 71680);
    LAS float* FL = (LAS float*)(lds + 90112); LAS float* AM = FL + 64; LAS float* fcs = FL + 128; LAS float* ics = FL + 192; LAS float* mis = FL + 256; LAS float* wks = FL + 320;
    const int c = um & 63;
    const int l = tid >> 3, cg = tid & 7, g4 = lane >> 4, c15 = lane & 15;
    {
        const u32x4 q0 = pre.q0, q1 = pre.q1, k0 = pre.k0, k1 = pre.k1;
        *(LAS u32x4*)(Qs + l * 136 + cg * 16) = q0; *(LAS u32x4*)(Qs + l * 136 + cg * 16 + 8) = q1;
        const float sc = 0.08838834764831845f;
        u32x4 ko0, ko1;
        ko0.x = pk2(bflo(k0.x) * sc, bfhi(k0.x) * sc); ko0.y = pk2(bflo(k0.y) * sc, bfhi(k0.y) * sc); ko0.z = pk2(bflo(k0.z) * sc, bfhi(k0.z) * sc); ko0.w = pk2(bflo(k0.w) * sc, bfhi(k0.w) * sc);
        ko1.x = pk2(bflo(k1.x) * sc, bfhi(k1.x) * sc); ko1.y = pk2(bflo(k1.y) * sc, bfhi(k1.y) * sc); ko1.z = pk2(bflo(k1.z) * sc, bfhi(k1.z) * sc); ko1.w = pk2(bflo(k1.w) * sc, bfhi(k1.w) * sc);
        *(LAS u32x4*)(Ks + l * 136 + cg * 16) = ko0; *(LAS u32x4*)(Ks + l * 136 + cg * 16 + 8) = ko1;
#pragma unroll
        for (int s4 = 0; s4 < 4; ++s4) { const u32x4 v = pre.v[s4]; const int e0 = cg * 32 + s4 * 8;
            VTs[tsw(e0 + 0, l, 5)] = (bf16)(v.x & 0xffffu); VTs[tsw(e0 + 1, l, 5)] = (bf16)(v.x >> 16); VTs[tsw(e0 + 2, l, 5)] = (bf16)(v.y & 0xffffu); VTs[tsw(e0 + 3, l, 5)] = (bf16)(v.y >> 16);
            VTs[tsw(e0 + 4, l, 5)] = (bf16)(v.z & 0xffffu); VTs[tsw(e0 + 5, l, 5)] = (bf16)(v.z >> 16); VTs[tsw(e0 + 6, l, 5)] = (bf16)(v.w & 0xffffu); VTs[tsw(e0 + 7, l, 5)] = (bf16)(v.w >> 16); }
        if (tid < 64) { FL[tid] = pre.fl; AM[tid] = pre.am; fcs[tid] = pre.fc; ics[tid] = pre.ic; }
        if (um_next >= 0) ML_PREP_LOAD(um_next, pre);
    }
    __syncthreads();
    if (tid < 64) {
        float A = FL[tid], B = AM[tid], v = ics[tid] - fcs[tid];
#pragma unroll
        for (int off = 1; off < 64; off <<= 1) { const float Ap = __shfl_up(A, off), Bp = __shfl_up(B, off), vp = __shfl_up(v, off);
            if (tid >= off) { B = fmaxf(Bp + A, B); A = Ap + A; v = fmaxf(v, vp); } }
        const float mm = fmaxf(A, B);
        float mprev = __shfl_up(mm, 1); if (tid == 0) mprev = 0.f;
        const float mst = __shfl(mprev, c), mn = __shfl(mm, c), flc = FL[c];
        if (tid == 0) ((float*)(sm + SM_MDEC))[um] = expf(flc + mst - mn);
        const float inter = fcs[tid] + mst, mi = fmaxf(fcs[tid] + v, inter); mis[tid] = mi;
        ((float*)(sm + SM_MSI))[um * 64 + tid] = expf(inter - mi); ((float*)(sm + SM_MEN))[um * 64 + tid] = expf(-mi); wks[tid] = expf(flc - fcs[tid] + ics[tid] - mn); }
    __syncthreads();
    if (wid < 4) {
        f32x4 acc[4];
#pragma unroll
        for (int n = 0; n < 4; ++n) acc[n] = (f32x4){0.f, 0.f, 0.f, 0.f};
#pragma unroll
        for (int ks = 0; ks < 4; ++ks) { const bf16x8 af = frag(Qs, 16 * wid, 136, 32 * ks, lane);
#pragma unroll
            for (int n = 0; n < 4; ++n) acc[n] = MMA16(af, frag(Ks, 16 * n, 136, 32 * ks, lane), acc[n]); }
        bf16* WT = (bf16*)(ws + WS_MWT) + (size_t)um * 4096; float rsum[4] = {0.f, 0.f, 0.f, 0.f};
#pragma unroll
        for (int n = 0; n < 4; ++n)
#pragma unroll
            for (int rg = 0; rg < 4; ++rg) { const int i = 16 * wid + 4 * g4 + rg, j = 16 * n + c15;
                const float wv = (j <= i) ? __expf(fcs[i] - fcs[j] + ics[j] - mis[i]) * acc[n][rg] : 0.f; rsum[rg] += wv; WT[i * 64 + j] = f2bf(wv); }
#pragma unroll
        for (int rg = 0; rg < 4; ++rg) { float s = rsum[rg];
#pragma unroll
            for (int o = 1; o < 16; o <<= 1) s += __shfl_xor(s, o);
            if (c15 == 0) ((float*)(sm + SM_MWS))[um * 64 + 16 * wid + 4 * g4 + rg] = s; }
    } else {
        const int t2 = tid - 256, l2 = t2 >> 2, part = t2 & 3; const float wk = wks[l2];
#pragma unroll 8
        for (int i = 0; i < 32; ++i) { const int d = part * 32 + i; KWTs[tsw(d, l2, 5)] = f2bf(wk * bf2f(Ks[l2 * 136 + d])); }
    }
    __syncthreads();
    {
        bf16* BM = (bf16*)(ws + WS_MBM) + (size_t)um * 32768;
        bf16x8 kf[2];
#pragma unroll
        for (int ks = 0; ks < 2; ++ks) kf[ks] = fragsw(KWTs, wid, ks, lane, 5);
#pragma unroll
        for (int n = 0; n < 16; ++n) { f32x4 b1 = (f32x4){0.f, 0.f, 0.f, 0.f};
#pragma unroll
            for (int ks = 0; ks < 2; ++ks) b1 = MMA16(kf[ks], fragsw(VTs, n, ks, lane, 5), b1);
            *(u32x2*)(BM + (((n * 8 + wid) * 64) + lane) * 4) = (u32x2){pk2(b1[0], b1[1]), pk2(b1[2], b1[3])}; }
        if (tid < 128) { float s = 0.f;
#pragma unroll
            for (int c8 = 0; c8 < 8; ++c8) { const u32x4 kv = *(const LAS u32x4*)(KWTs + tid * 72 + c8 * 8); s += (bflo(kv.x) + bfhi(kv.x)) + (bflo(kv.y) + bfhi(kv.y)) + (bflo(kv.z) + bfhi(kv.z)) + (bflo(kv.w) + bfhi(kv.w)); }
            ((float*)(sm + SM_MKS))[um * 128 + tid] = s; }
        bf16* VT = (bf16*)(ws + WS_MVT) + (size_t)um * 16384;
        for (int p = tid; p < 2048; p += 512) { const int row = p >> 3, seg = p & 7; *(u32x4*)(VT + row * 64 + seg * 8) = *(const LAS u32x4*)(VTs + row * 72 + ((seg ^ (row >> 5)) & 7) * 8); }
    }
    __syncthreads();
}

__device__ __forceinline__ void gdn_scan_item(const Args& a, int item, LAS unsigned char* lds, int tid, int wid, int lane) {
    asm volatile("" : "+v"(tid), "+v"(lane));
    unsigned char* ws = a.ws; unsigned char* sm = ws + WS_SMALL;
    LAS bf16* STs = (LAS bf16*)lds;
    LAS float* gls = (LAS float*)(lds + 8704);
    const int bh = item >> 3, n = item & 7, g4 = lane >> 4, c15 = lane & 15;
    const int ug0 = bh * 64;
    const size_t toff = (size_t)ug0 * 16384 + (size_t)(((((n >> 1) * 8 + wid) * 2 + (n & 1)) * 64) + lane) * 4;
    const bf16* APl = (const bf16*)(ws + WS_GAP) + (size_t)ug0 * 16384 + wid * 2048 + lane * 8;
    const bf16* BBl = (const bf16*)(ws + WS_GBB) + toff; bf16* SSl = (bf16*)(ws + WS_GSS) + toff;
    f32x4 S = (f32x4){0.f, 0.f, 0.f, 0.f};
    for (int i = tid; i < 16 * 136; i += 512) STs[i] = 0;
    if (tid < 64) gls[tid] = ((const float*)(sm + SM_GLAST))[ug0 + tid];
    u32x4 ap[8][4]; u32x2 bb[8];
#define GS_FILL(st, c) do { const bf16* _pa = APl + (size_t)(c) * 16384; const bf16* _pb = BBl + (size_t)(c) * 16384; \
        asm volatile("global_load_dwordx4 %0, %5, off\n\tglobal_load_dwordx4 %1, %5, off offset:1024\n\tglobal_load_dwordx4 %2, %5, off offset:2048\n\tglobal_load_dwordx4 %3, %5, off offset:3072\n\t" \
                     "global_load_dwordx2 %4, %6, off" \
                     : "=&v"(ap[st][0]), "=&v"(ap[st][1]), "=&v"(ap[st][2]), "=&v"(ap[st][3]), "=&v"(bb[st]) : "v"(_pa), "v"(_pb) : "memory"); } while (0)
#pragma unroll
    for (int st = 0; st < 8; ++st) GS_FILL(st, st);
    int cur = 0;
    __syncthreads();
    for (int c0 = 0; c0 < 64; c0 += 8) {
#pragma unroll
        for (int st = 0; st < 8; ++st) { const int c = c0 + st;
            asm volatile("s_waitcnt vmcnt(30)" : "+v"(ap[st][0]), "+v"(ap[st][1]), "+v"(ap[st][2]), "+v"(ap[st][3]), "+v"(bb[st]) :: "memory");
            const LAS bf16* STc = STs + cur * (16 * 136); LAS bf16* STn = STs + (cur ^ 1) * (16 * 136);
            const float gl = gls[c];
            *(u32x2*)(SSl + (size_t)c * 16384) = (u32x2){pk2(S[0], S[1]), pk2(S[2], S[3])};
            f32x4 acc; acc[0] = gl * S[0] + bflo(bb[st].x); acc[1] = gl * S[1] + bfhi(bb[st].x); acc[2] = gl * S[2] + bflo(bb[st].y); acc[3] = gl * S[3] + bfhi(bb[st].y);
#pragma unroll
            for (int ks = 0; ks < 4; ++ks) acc = MMA16(__builtin_bit_cast(bf16x8, ap[st][ks]), frag(STc, 0, 136, 32 * ks, lane), acc);
            S = acc; *(LAS u32x2*)(STn + c15 * 136 + 16 * wid + 4 * g4) = (u32x2){pk2(acc[0], acc[1]), pk2(acc[2], acc[3])};
            { const int cn = c + 8 < 64 ? c + 8 : 63; GS_FILL(st, cn); }
            __syncthreads();
            cur ^= 1;
        }
    }
    asm volatile("s_waitcnt vmcnt(0)" ::: "memory");
#undef GS_FILL
}
__device__ __forceinline__ void ml_scan_item(const Args& a, int item, int tid) {
    unsigned char* ws = a.ws; unsigned char* sm = ws + WS_SMALL;
    const int bh = item >> 4, part = item & 15, um0 = bh * 64; const size_t el = (size_t)part * 2048 + (size_t)tid * 4;
    const bf16* BM = (const bf16*)(ws + WS_MBM) + (size_t)um0 * 32768 + el; bf16* CS = (bf16*)(ws + WS_MCS) + (size_t)um0 * 32768 + el;
    const float* DEC = (const float*)(sm + SM_MDEC) + um0; const float* KS = (const float*)(sm + SM_MKS) + um0 * 128; float* NS = (float*)(sm + SM_MNS) + um0 * 128;
    float C[4] = {0.f, 0.f, 0.f, 0.f}; float n = 0.f; const bool don = (part == 0 && tid < 128);
    for (int c0 = 0; c0 < 64; c0 += 16) {
        u32x2 bv[16]; float dc[16], kv[16];
#pragma unroll
        for (int j = 0; j < 16; ++j) { bv[j] = *(const u32x2*)(BM + (size_t)(c0 + j) * 32768); dc[j] = DEC[c0 + j]; kv[j] = don ? KS[(c0 + j) * 128 + tid] : 0.f; }
#pragma unroll
        for (int j = 0; j < 16; ++j) {
            *(u32x2*)(CS + (size_t)(c0 + j) * 32768) = (u32x2){pk2(C[0], C[1]), pk2(C[2], C[3])};
            if (don) { NS[(c0 + j) * 128 + tid] = n; n = dc[j] * n + kv[j]; }
            C[0] = dc[j] * C[0] + bflo(bv[j].x); C[1] = dc[j] * C[1] + bfhi(bv[j].x); C[2] = dc[j] * C[2] + bflo(bv[j].y); C[3] = dc[j] * C[3] + bfhi(bv[j].y); }
    }
}

struct GdnOutPre { u32x4 s4[4], w2[2], q2[2], a1, z0, z1; u32x2 u4[4]; };
#define GDN_OUT_LOAD(ugx, P) do { const bf16* _S = (const bf16*)(a.ws + WS_GSS) + (size_t)(ugx) * 16384; const bf16* _W = (const bf16*)(a.ws + WS_GW) + (size_t)(ugx) * 8192; const bf16* _Q = (const bf16*)(a.ws + WS_GQD) + (size_t)(ugx) * 8192; \
        const bf16* _A = (const bf16*)(a.ws + WS_GAT) + (size_t)(ugx) * 4096; const bf16* _U = (const bf16*)(a.ws + WS_GU) + (size_t)(ugx) * 8192; \
        _Pragma("unroll") for (int _i = 0; _i < 4; ++_i) (P).s4[_i] = *(const u32x4*)(_S + (tid + 512 * _i) * 8); \
        _Pragma("unroll") for (int _i = 0; _i < 2; ++_i) { const int _p = tid + 512 * _i; (P).w2[_i] = *(const u32x4*)(_W + _p * 8); (P).q2[_i] = *(const u32x4*)(_Q + (_p >> 4) * 128 + (_p & 15) * 8); } \
        (P).a1 = *(const u32x4*)(_A + (tid >> 3) * 64 + (tid & 7) * 8); \
        _Pragma("unroll") for (int _lt = 0; _lt < 4; ++_lt) (P).u4[_lt] = *(const u32x2*)(_U + ((((tid >> 6) * 4 + _lt) * 64) + (tid & 63)) * 4); \
        { const int _b = (ugx) >> 9, _h = ((ugx) >> 6) & 7, _c = (ugx) & 63; const bf16* _zr = (const bf16*)(a.ws + WS_Z) + (size_t)(_b * SEQL + _c * 64 + (tid >> 3)) * NZ + ZG + _h * 128 + (tid & 7) * 16; \
          (P).z0 = *(const u32x4*)_zr; (P).z1 = *(const u32x4*)(_zr + 8); } } while (0)
__device__ __forceinline__ void gdn_out_unit(const Args& a, int ug, int ug_next, GdnOutPre& pre, LAS unsigned char* lds, int tid, int wid, int lane) {
    asm volatile("" : "+v"(tid), "+v"(lane));
    unsigned char* ws = a.ws;
    LAS bf16* Ss = (LAS bf16*)lds; LAS bf16* Ws = (LAS bf16*)(lds + 34816); LAS bf16* QDs = (LAS bf16*)(lds + 52224); LAS bf16* ATs = (LAS bf16*)(lds + 69632); LAS bf16* VNt = (LAS bf16*)(lds + 78848);
    LAS float* Os = (LAS float*)lds;
    const int b = ug >> 9, h = (ug >> 6) & 7, c = ug & 63, t0 = b * SEQL + c * 64, g4 = lane >> 4, c15 = lane & 15;
    u32x2 u4r[4]; u32x4 z0, z1;
    {
#pragma unroll
        for (int i = 0; i < 4; ++i) { const int p = tid + 512 * i;
#pragma unroll
            for (int hq = 0; hq < 2; ++hq) { const int q = 2 * p + hq, lr = q & 63, et = (q >> 6) & 1, w = (q >> 7) & 7, es = q >> 10;
                *(LAS u32x2*)(Ss + (es * 32 + 16 * et + (lr & 15)) * 136 + 16 * w + 4 * (lr >> 4)) = hq ? (u32x2){pre.s4[i].z, pre.s4[i].w} : (u32x2){pre.s4[i].x, pre.s4[i].y}; } }
#pragma unroll
        for (int i = 0; i < 2; ++i) { const int p = tid + 512 * i; *(LAS u32x4*)(QDs + (p >> 4) * 136 + (p & 15) * 8) = pre.q2[i];
#pragma unroll
            for (int hq = 0; hq < 2; ++hq) { const int q = 2 * p + hq, lr = q & 63, it = (q >> 6) & 3, en = q >> 8;
                *(LAS u32x2*)(Ws + (16 * it + (lr & 15)) * 136 + 16 * en + 4 * (lr >> 4)) = hq ? (u32x2){pre.w2[i].z, pre.w2[i].w} : (u32x2){pre.w2[i].x, pre.w2[i].y}; } }
        *(LAS u32x4*)(ATs + (tid >> 3) * 72 + (tid & 7) * 8) = pre.a1;
#pragma unroll
        for (int lt = 0; lt < 4; ++lt) u4r[lt] = pre.u4[lt];
        z0 = pre.z0; z1 = pre.z1;
        if (ug_next >= 0) GDN_OUT_LOAD(ug_next, pre);
    }
    __syncthreads();
    f32x4 O[4];
    {
        bf16x8 sf[4];
#pragma unroll
        for (int ks = 0; ks < 4; ++ks) sf[ks] = frag(Ss, 16 * wid, 136, 32 * ks, lane);
#pragma unroll
        for (int lt = 0; lt < 4; ++lt) { f32x4 P = (f32x4){0.f, 0.f, 0.f, 0.f}; const u32x2 u4 = u4r[lt];
#pragma unroll
            for (int ks = 0; ks < 4; ++ks) P = MMA16(sf[ks], frag(Ws, 16 * lt, 136, 32 * ks, lane), P);
            const float v0 = bflo(u4.x) - P[0], v1 = bfhi(u4.x) - P[1], v2 = bflo(u4.y) - P[2], v3 = bfhi(u4.y) - P[3];
            LAS bf16* vp = VNt + (16 * wid + 4 * g4) * 72 + 16 * lt + c15; vp[0] = f2bf(v0); vp[72] = f2bf(v1); vp[144] = f2bf(v2); vp[216] = f2bf(v3); }
        LDS_WAIT();
#pragma unroll
        for (int lt = 0; lt < 4; ++lt) { f32x4 o = (f32x4){0.f, 0.f, 0.f, 0.f};
#pragma unroll
            for (int ks = 0; ks < 4; ++ks) o = MMA16(frag(QDs, 16 * lt, 136, 32 * ks, lane), sf[ks], o);
#pragma unroll
            for (int ks = 0; ks < 2; ++ks) o = MMA16(frag(ATs, 16 * lt, 72, 32 * ks, lane), frag(VNt, 16 * wid, 72, 32 * ks, lane), o);
            O[lt] = o; }
    }
    __syncthreads();
#pragma unroll
    for (int lt = 0; lt < 4; ++lt)
#pragma unroll
        for (int rg = 0; rg < 4; ++rg) Os[(16 * lt + 4 * g4 + rg) * 132 + 16 * wid + c15] = O[lt][rg];
    __syncthreads();
    {
        const int l = tid >> 3, cg = tid & 7; const LAS f32x4* op = (const LAS f32x4*)(Os + l * 132 + cg * 16);
        const f32x4 o0 = op[0], o1 = op[1], o2 = op[2], o3 = op[3];
        float ss = ((o0[0] * o0[0] + o0[1] * o0[1]) + (o0[2] * o0[2] + o0[3] * o0[3])) + ((o1[0] * o1[0] + o1[1] * o1[1]) + (o1[2] * o1[2] + o1[3] * o1[3]))
                 + ((o2[0] * o2[0] + o2[1] * o2[1]) + (o2[2] * o2[2] + o2[3] * o2[3])) + ((o3[0] * o3[0] + o3[1] * o3[1]) + (o3[2] * o3[2] + o3[3] * o3[3]));
#pragma unroll
        for (int o = 1; o < 8; o <<= 1) ss += __shfl_xor(ss, o);
        const float r = rsqrtf(ss * (1.f / 128.f) + EPS);
        const LAS float* gn = (const LAS float*)(lds + GN_LDS) + cg * 16; const f32x4 g0 = *(const LAS f32x4*)gn, g1 = *(const LAS f32x4*)(gn + 4), g2 = *(const LAS f32x4*)(gn + 8), g3 = *(const LAS f32x4*)(gn + 12);
#define GY(ov, gv, zw, k) pk2(ov[2 * (k)] * r * gv[2 * (k)] * (bflo(zw) * sigm(bflo(zw))), ov[2 * (k) + 1] * r * gv[2 * (k) + 1] * (bfhi(zw) * sigm(bfhi(zw))))
        bf16* yp = (bf16*)(ws + WS_Y) + (size_t)(t0 + l) * DM + h * 128 + cg * 16;
        *(u32x4*)yp = (u32x4){GY(o0, g0, z0.x, 0), GY(o0, g0, z0.y, 1), GY(o1, g1, z0.z, 0), GY(o1, g1, z0.w, 1)};
        *(u32x4*)(yp + 8) = (u32x4){GY(o2, g2, z1.x, 0), GY(o2, g2, z1.y, 1), GY(o3, g3, z1.z, 0), GY(o3, g3, z1.w, 1)};
#undef GY
    }
    __syncthreads();
}
struct MlOutPre { u32x4 c4[8], q2[2], v4[4], w1; float nsv, siv; };
#define ML_OUT_LOAD(umx, P) do { const int _b = (umx) >> 8, _h = ((umx) >> 6) & 3, _c = (umx) & 63, _t0 = _b * SEQL + _c * 64; \
        const bf16* _C = (const bf16*)(a.ws + WS_MCS) + (size_t)(umx) * 32768; const bf16* _Z = (const bf16*)(a.ws + WS_Z); const bf16* _WT = (const bf16*)(a.ws + WS_MWT) + (size_t)(umx) * 4096; const bf16* _VT = (const bf16*)(a.ws + WS_MVT) + (size_t)(umx) * 16384; \
        _Pragma("unroll") for (int _i = 0; _i < 8; ++_i) { const int _p = tid + 512 * _i; (P).c4[_i] = *(const u32x4*)(_C + _p * 8); } \
        _Pragma("unroll") for (int _i = 0; _i < 2; ++_i) { const int _p = tid + 512 * _i; (P).q2[_i] = *(const u32x4*)(_Z + (size_t)(_t0 + (_p >> 4)) * NZ + ZMQ + _h * 128 + (_p & 15) * 8); } \
        _Pragma("unroll") for (int _i = 0; _i < 4; ++_i) { const int _p = tid + 512 * _i; (P).v4[_i] = *(const u32x4*)(_VT + (_p >> 3) * 64 + (_p & 7) * 8); } \
        (P).w1 = *(const u32x4*)(_WT + (tid >> 3) * 64 + (tid & 7) * 8); \
        (P).nsv = tid < 128 ? ((const float*)(a.ws + WS_SMALL + SM_MNS))[(umx) * 128 + tid] : 0.f; (P).siv = tid < 64 ? ((const float*)(a.ws + WS_SMALL + SM_MSI))[(umx) * 64 + tid] : 0.f; } while (0)
__device__ __forceinline__ void ml_out_unit(const Args& a, int um, int um_next, MlOutPre& pre, LAS unsigned char* lds, int tid, int wid, int lane) {
    asm volatile("" : "+v"(tid), "+v"(lane));
    unsigned char* ws = a.ws; unsigned char* sm = ws + WS_SMALL;
    LAS bf16* Cs = (LAS bf16*)lds; LAS bf16* Qs = (LAS bf16*)(lds + 69632); LAS bf16* WTs = (LAS bf16*)(lds + 87040); LAS bf16* VTs = (LAS bf16*)(lds + 96256);
    LAS float* ns = (LAS float*)(lds + 133120); LAS float* sis = ns + 128; LAS float* dns = ns + 192;
    LAS float* Hs = (LAS float*)lds;
    const int b = um >> 8, h = (um >> 6) & 3, c = um & 63, t0 = b * SEQL + c * 64, g4 = lane >> 4, c15 = lane & 15;
    u32x4 zo[4];
    { const bf16* zr0 = (const bf16*)(ws + WS_Z) + (size_t)(t0 + (tid >> 3)) * NZ + ZMO + h * 256 + (tid & 7) * 32;
#pragma unroll
      for (int i = 0; i < 4; ++i) zo[i] = *(const u32x4*)(zr0 + 8 * i); }
    {
#pragma unroll
        for (int i = 0; i < 8; ++i) { const int p = tid + 512 * i;
#pragma unroll
            for (int hq = 0; hq < 2; ++hq) { const int q = 2 * p + hq, lr = q & 63, w = (q >> 6) & 7, n = q >> 9;
                *(LAS u32x2*)(Cs + (16 * n + (lr & 15)) * 136 + 16 * w + 4 * (lr >> 4)) = hq ? (u32x2){pre.c4[i].z, pre.c4[i].w} : (u32x2){pre.c4[i].x, pre.c4[i].y}; } }
#pragma unroll
        for (int i = 0; i < 2; ++i) { const int p = tid + 512 * i; *(LAS u32x4*)(Qs + (p >> 4) * 136 + (p & 15) * 8) = pre.q2[i]; }
#pragma unroll
        for (int i = 0; i < 4; ++i) { const int p = tid + 512 * i; *(LAS u32x4*)(VTs + (p >> 3) * 72 + (p & 7) * 8) = pre.v4[i]; }
        *(LAS u32x4*)(WTs + (tid >> 3) * 72 + (tid & 7) * 8) = pre.w1;
        if (tid < 128) ns[tid] = pre.nsv;
        if (tid < 64) sis[tid] = pre.siv;
        if (um_next >= 0) ML_OUT_LOAD(um_next, pre);
    }
    __syncthreads();
    {
        const int l = tid >> 3, part = tid & 7; float s = 0.f;
#pragma unroll
        for (int hq = 0; hq < 2; ++hq) { const u32x4 qv = *(const LAS u32x4*)(Qs + l * 136 + part * 16 + 8 * hq); const f32x4 n0 = *(const LAS f32x4*)(ns + part * 16 + 8 * hq), n1 = *(const LAS f32x4*)(ns + part * 16 + 8 * hq + 4);
            s += (bflo(qv.x) * n0[0] + bfhi(qv.x) * n0[1]) + (bflo(qv.y) * n0[2] + bfhi(qv.y) * n0[3]) + (bflo(qv.z) * n1[0] + bfhi(qv.z) * n1[1]) + (bflo(qv.w) * n1[2] + bfhi(qv.w) * n1[3]); }
#pragma unroll
        for (int o = 1; o < 8; o <<= 1) s += __shfl_xor(s, o);
        if (part == 0) dns[l] = 1.f / fmaxf(fabsf(sis[l] * s + ((const float*)(sm + SM_MWS))[um * 64 + l]), ((const float*)(sm + SM_MEN))[um * 64 + l]);
    }
    f32x4 N[2][4];
#pragma unroll
    for (int e2 = 0; e2 < 2; ++e2) { const int et = 2 * wid + e2; bf16x8 cf[4];
#pragma unroll
        for (int ks = 0; ks < 4; ++ks) cf[ks] = frag(Cs, 16 * et, 136, 32 * ks, lane);
#pragma unroll
        for (int lt = 0; lt < 4; ++lt) { f32x4 n4 = (f32x4){0.f, 0.f, 0.f, 0.f};
#pragma unroll
            for (int ks = 0; ks < 4; ++ks) n4 = MMA16(frag(Qs, 16 * lt, 136, 32 * ks, lane), cf[ks], n4);
#pragma unroll
            for (int rg = 0; rg < 4; ++rg) n4[rg] *= sis[16 * lt + 4 * g4 + rg];
#pragma unroll
            for (int ks = 0; ks < 2; ++ks) n4 = MMA16(frag(WTs, 16 * lt, 72, 32 * ks, lane), frag(VTs, 16 * et, 72, 32 * ks, lane), n4);
            N[e2][lt] = n4; } }
    __syncthreads();
#pragma unroll
    for (int e2 = 0; e2 < 2; ++e2)
#pragma unroll
        for (int lt = 0; lt < 4; ++lt)
#pragma unroll
            for (int rg = 0; rg < 4; ++rg) { const int l = 16 * lt + 4 * g4 + rg; Hs[l * 260 + 16 * (2 * wid + e2) + c15] = N[e2][lt][rg] * dns[l]; }
    __syncthreads();
    {
        const int l = tid >> 3, cg = tid & 7; const LAS f32x4* hp = (const LAS f32x4*)(Hs + l * 260 + cg * 32);
        f32x4 hv[8]; float ss = 0.f;
#pragma unroll
        for (int i = 0; i < 8; ++i) { hv[i] = hp[i]; ss += (hv[i][0] * hv[i][0] + hv[i][1] * hv[i][1]) + (hv[i][2] * hv[i][2] + hv[i][3] * hv[i][3]); }
#pragma unroll
        for (int o = 1; o < 8; o <<= 1) ss += __shfl_xor(ss, o);
        const float r = rsqrtf(ss * (1.f / 256.f) + EPS);
        const LAS float* mn = (const LAS float*)(lds + GN_LDS + 512) + h * 256 + cg * 32;
        bf16* yp = (bf16*)(ws + WS_Y) + (size_t)(t0 + l) * DM + 1024 + h * 256 + cg * 32;
#pragma unroll
        for (int i = 0; i < 4; ++i) { const u32x4 zw = zo[i]; const f32x4 m0 = *(const LAS f32x4*)(mn + 8 * i), m1 = *(const LAS f32x4*)(mn + 8 * i + 4); const f32x4 h0 = hv[2 * i], h1 = hv[2 * i + 1];
            u32x4 y; y.x = pk2(h0[0] * r * m0[0] * sigm(bflo(zw.x)), h0[1] * r * m0[1] * sigm(bfhi(zw.x))); y.y = pk2(h0[2] * r * m0[2] * sigm(bflo(zw.y)), h0[3] * r * m0[3] * sigm(bfhi(zw.y)));
            y.z = pk2(h1[0] * r * m1[0] * sigm(bflo(zw.z)), h1[1] * r * m1[1] * sigm(bfhi(zw.z))); y.w = pk2(h1[2] * r * m1[2] * sigm(bflo(zw.w)), h1[3] * r * m1[3] * sigm(bfhi(zw.w)));
            *(u32x4*)(yp + 8 * i) = y; }
    }
    __syncthreads();
}

__device__ __forceinline__ void router_unit(const Args& a, int u, LAS unsigned char* lds, int tid, int wid, int lane) {
    asm volatile("" : "+v"(tid), "+v"(lane));
    unsigned char* ws = a.ws; unsigned char* sm = ws + WS_SMALL;
    const float* H1 = (const float*)(ws + WS_H1);
    LAS float* red = (LAS float*)lds; LAS float* Ls = (LAS float*)(lds + 67584); LAS int* sel = (LAS int*)(lds + 67584 + 8448); LAS int* rks = sel + 256; LAS float* rsl = (LAS float*)(rks + 256);
    const int t0 = u * 64, g4 = lane >> 4, c15 = lane & 15;
    if (tid < 64) { const float* SSQ = (const float*)(sm + SM_SSQ1) + (size_t)(t0 + tid) * 32; float s = 0.f;
#pragma unroll
        for (int q = 0; q < 8; ++q) { const f32x4 v = *(const f32x4*)(SSQ + 4 * q); s += (v[0] + v[1]) + (v[2] + v[3]); }
        const float r = rsqrtf(s * (1.f / DM) + EPS); rsl[tid] = r; ((float*)(sm + SM_RS2))[t0 + tid] = r; }
    __syncthreads();
    float rr[4];
#pragma unroll
    for (int rt = 0; rt < 4; ++rt) rr[rt] = rsl[16 * rt + c15];
    unsigned char* qb = ws + WS_H1B + (size_t)(t0 + c15) * DM;
    skinny_mfma(H1 + (size_t)t0 * DM, (const bf16*)(ws + WS_WSK) + 64 * DM, (const bf16*)(ws + WS_WSK) + 96 * DM, red, Ls, tid, wid, lane,
        [&](int rt, int k, const f32x4& v0, const f32x4& v1) { const float r = rr[rt];
            *(u32x2*)(qb + (size_t)(16 * rt) * DM + k) = (u32x2){pk4_fp8(v0[0] * r, v0[1] * r, v0[2] * r, v0[3] * r), pk4_fp8(v1[0] * r, v1[1] * r, v1[2] * r, v1[3] * r)}; });
    if (tid < 64) { const int l = tid, t = t0 + l; float tv[4]; int ti[4]; const float r = rsl[l]; const float* b_r = argin(a, 14);
        float lg[32];
#pragma unroll
        for (int c4 = 0; c4 < 8; ++c4) { const f32x4 bq = *(const f32x4*)(b_r + 4 * c4);
#pragma unroll
            for (int e = 0; e < 4; ++e) lg[4 * c4 + e] = Ls[l * 33 + 4 * c4 + e] * r + bq[e]; }
        unsigned taken = 0u;
#pragma unroll
        for (int k = 0; k < 4; ++k) { float best = -INFINITY; int bi = 0;
#pragma unroll
            for (int c = 0; c < 32; ++c) { const bool ok = !((taken >> c) & 1u) && lg[c] > best; best = ok ? lg[c] : best; bi = ok ? c : bi; }
            tv[k] = best; ti[k] = bi; taken |= 1u << bi; }
        const float e1 = expf(tv[1] - tv[0]), e2 = expf(tv[2] - tv[0]), e3 = expf(tv[3] - tv[0]); const float inv = 1.f / (1.f + e1 + e2 + e3);
        int* TOPI = (int*)(sm + SM_TOPI); float* TOPG = (float*)(sm + SM_TOPG);
        *(i32x4*)(TOPI + t * 4) = (i32x4){ti[0], ti[1], ti[2], ti[3]};
        *(f32x4*)(TOPG + t * 4) = (f32x4){inv, e1 * inv, e2 * inv, e3 * inv};
        sel[l * 4 + 0] = ti[0]; sel[l * 4 + 1] = ti[1]; sel[l * 4 + 2] = ti[2]; sel[l * 4 + 3] = ti[3]; }
    __syncthreads();
    int my_e = 0, my_lr = 0;
    if (tid < 256) {
        my_e = sel[tid];
#pragma unroll 4
        for (int e = 0; e < 32; ++e) { const unsigned long long m = __ballot(my_e == e); if (my_e == e) my_lr = __popcll(m & ((1ull << lane) - 1ull)); if (lane == 0) rks[wid * 32 + e] = __popcll(m); }
    }
    __syncthreads();
    if (tid < 256) { int rk = my_lr; for (int w = 0; w < wid; ++w) rk += rks[w * 32 + my_e]; ((int*)(sm + SM_LRANK))[t0 * 4 + tid] = rk; }
    if (tid < 32) { const int cnt = (rks[tid] + rks[32 + tid]) + (rks[64 + tid] + rks[96 + tid]);
        ((int*)(sm + SM_UCNT))[u * 32 + tid] = cnt; atomicAdd((int*)(ws + WS_CTL) + CW_CNTE + tid, cnt); }
    __syncthreads();
}

constexpr int NPHASE = 13;
__global__ void __launch_bounds__(NWAVES * 64, 2) mk_fwd(Args args) {
    extern __shared__ __attribute__((aligned(16))) unsigned char lds_raw[];
    LAS unsigned char* lds = (LAS unsigned char*)lds_raw;
    volatile LAS unsigned* MISC = (volatile LAS unsigned*)(lds + MISC_OFF);
    const int wave = __builtin_amdgcn_readfirstlane((int)threadIdx.x >> 6);
#define PHASE_IDS int lane_; asm volatile("v_mbcnt_lo_u32_b32 %0, -1, 0\n\tv_mbcnt_hi_u32_b32 %0, -1, %0" : "=v"(lane_)); const int tid = wave * 64 + lane_; const int lane = lane_; (void)lane;
    const int G = gridDim.x, bx = blockIdx.x;
    unsigned char* ws = args.ws; unsigned char* sm = ws + WS_SMALL;
    const int gw = bx * NWAVES + wave, NGW = G * NWAVES;
    { PHASE_IDS for (int u = tid; u < 64; u += NWAVES * 64) MISC[u] = 0u; }
    __syncthreads();
#if MK_SPLIT
#define GRID_BAR() do { } while (0)
#else
    XcdBarrier bar; { PHASE_IDS bar = xcd_barrier_post((unsigned*)(ws + WS_CTL) + CW_BAR, MISC + 8, tid == 0); }
#define GRID_BAR() xcd_barrier(bar, tid == 0)
#endif
#if MK_SPLIT
    const int lo = args.ph_lo, hi = args.ph_hi;
#else
    constexpr int lo = 0, hi = NPHASE;
#endif
#ifndef PH_MASK
#define PH_MASK 0xffffffffu
#endif
#define IN(k) ((((PH_MASK) >> (k)) & 1u) && lo <= (k) && (k) < hi)
#define BOTH(k) (IN(k) && IN((k) + 1))

    if (IN(0)) {
        PHASE_IDS
        {
            const float* x = argin(args, 0); bf16* xb = (bf16*)(ws + WS_XB);
            for (int t = gw; t < NTOK; t += NGW) { float ss = 0.f;
#pragma unroll
                for (int j = 0; j < 8; ++j) { const int col = 4 * lane + 256 * j; const f32x4 v = *(const f32x4*)(x + (size_t)t * DM + col); ss += (v[0] * v[0] + v[1] * v[1]) + (v[2] * v[2] + v[3] * v[3]);
                    *(u32x2*)(xb + (size_t)t * DM + col) = (u32x2){pk2(v[0], v[1]), pk2(v[2], v[3])}; }
                ss = wave_sum(ss); if (lane == 0) ((float*)(sm + SM_RS1))[t] = rsqrtf(ss * (1.f / DM) + EPS); } }
        {
            const float* w_in = argin(args, 3); const float* g_mix = argin(args, 2); const float* w_r = argin(args, 13); const float* g_ffn = argin(args, 12); bf16* wsk = (bf16*)(ws + WS_WSK);
            for (int i = bx * 512 + tid; i < 2 * 32 * DM; i += G * 512) { const int which = i >> 16, n = (i >> 11) & 31, k = i & 2047; float v;
                if (which == 0) { const int col = n < 16 ? 3072 + n : 6160 + (n - 16); v = n < 24 ? w_in[(size_t)k * DIN + col] * g_mix[k] : 0.f; } else v = w_r[(size_t)k * 32 + n] * g_ffn[k];
                const bf16 hi = f2bf(v); wsk[(size_t)(which * 64 + n) * DM + k] = hi; wsk[(size_t)(which * 64 + 32 + n) * DM + k] = f2bf(v - bf2f(hi)); } }
        p0_weights(args, gw, NGW, lane);
        { const float* p = argin(args, 1); bf16* pb = (bf16*)(ws + WS_PB);
          for (size_t i = (size_t)bx * 512 + tid; i < (size_t)NTOK * PLE / 4; i += (size_t)G * 512) { const f32x4 v = *(const f32x4*)(p + 4 * i); u32x2 w; w.x = pk2(v[0], v[1]); w.y = pk2(v[2], v[3]); *(u32x2*)(pb + 4 * i) = w; } }
        if (BOTH(0)) GRID_BAR();
    }
    if (IN(1)) {
        PHASE_IDS
        const int GA = (G == 256) ? 160 : G;
        if (args.aux == 6) { if (bx >= GA) { PHASE_IDS __syncthreads(); convert_pool(args, lds, tid, wave, lane); } }
        else {
        if (GA == G || bx >= GA) { const int u0 = (GA == G) ? bx : bx - GA, us = (GA == G) ? G : G - GA; for (int u = u0; u < NCHT; u += us) xgate_unit(args, u, lds, tid, wave, lane); }
        if (bx < GA) {
            { pg8::Gemm g{ws + WS_XB, ws + WS_WIN, DM * 2, 0, nullptr, 0, 0}; pg8::Order S; S.init(NTOK / 256, NZ / 256, GA, bx, nullptr);
              pg8::EpiZ E{(bf16*)(ws + WS_Z), NZ, (const float*)(sm + SM_RS1)};
              pg8::gemm_phase<pg8::EpiZ, false, true>(lds, g, S, E, tid); }
            { pg8::Gemm g{ws + WS_PB, ws + WS_WPP, PLE * 2, 0, nullptr, 0, 0}; pg8::Order S; S.init(NTOK / 256, DM / 256, GA, (bx + 128) % GA, nullptr);
              pg8::EpiPe E{(bf16*)(ws + WS_PE), (float*)(sm + SM_PESSQ)};
              pg8::gemm_phase<pg8::EpiPe, false, true>(lds, g, S, E, tid); }
        }
        { PHASE_IDS __syncthreads(); convert_pool(args, lds, tid, wave, lane); }
        }
        if (BOTH(1)) GRID_BAR();
    }
    if (IN(2)) {
        PHASE_IDS
        { GdnPre pre; pre.z[0] = pre.z[1] = pre.z[2] = (u32x4){0u, 0u, 0u, 0u}; pre.cw = (f32x4){0.f, 0.f, 0.f, 0.f};
          { const Args& a = args; if (bx < 2048) { GDN_ZLOAD(bx, 0, pre.z); GDN_CWLOAD(bx, pre.cw); } }
          for (int u = bx; u < 2048; u += G) gdn_prep_unit(args, u, (u + G < 2048) ? u + G : -1, pre, lds, tid, wave, lane); }
        { const Args& a = args; MlPre mp; const int u0 = bx + ((2048 - bx + G - 1) / G) * G;
          if (u0 < 3072) ML_PREP_LOAD(u0 - 2048, mp);
          for (int u = u0; u < 3072; u += G) ml_prep_unit(args, u - 2048, (u + G < 3072) ? u + G - 2048 : -1, mp, lds, tid, wave, lane); }
        if (BOTH(2)) GRID_BAR();
    }
    if (IN(3)) {
        PHASE_IDS
        for (int it = bx; it < 256; it += G) { const int itx = (G == 256) ? ((((it & 7) * 4 + (it >> 6)) << 3) | ((it >> 3) & 7)) : it;
            gdn_scan_item(args, itx, lds, tid, wave, lane); ml_scan_item(args, it, tid); __syncthreads(); }
        if (BOTH(3)) GRID_BAR();
    }
    if (IN(4)) {
        PHASE_IDS
        { const Args& a = args;
          { LAS float* gns = (LAS float*)(lds + GN_LDS); const float* gsrc = argin(args, 7); const float* msrc = argin(args, 10); if (tid < 128) gns[tid] = gsrc[tid]; gns[128 + tid] = msrc[tid]; gns[640 + tid] = msrc[512 + tid]; __syncthreads(); }
          { GdnOutPre pre; if (bx < 2048) GDN_OUT_LOAD(bx, pre);
            if (args.aux != 2) for (int u = bx; u < 2048; u += G) gdn_out_unit(args, u, (u + G < 2048) ? u + G : -1, pre, lds, tid, wave, lane); }
          { MlOutPre pre; const int u0 = bx + ((2048 - bx + G - 1) / G) * G;
            if (u0 < 3072) ML_OUT_LOAD(u0 - 2048, pre);
            if (args.aux != 1) for (int u = u0; u < 3072; u += G) ml_out_unit(args, u - 2048, (u + G < 3072) ? u + G - 2048 : -1, pre, lds, tid, wave, lane); } }
        if (BOTH(4)) GRID_BAR();
    }
    if (IN(5)) {
        PHASE_IDS
        pg8::Gemm g{ws + WS_Y, ws + WS_WOUT, DM * 2, 0, nullptr, 0, 0}; pg8::Order S; S.init(NTOK / 256, DM / 256, G, bx, nullptr);
        pg8::EpiOut E{argin(args, 0), (float*)(ws + WS_H1), (float*)(sm + SM_SSQ1)};
        pg8::gemm_phase<pg8::EpiOut, false, true>(lds, g, S, E, tid);
        if (BOTH(5)) GRID_BAR();
    }
    if (IN(6)) {
        PHASE_IDS
        for (int u = bx; u < NCHT; u += G) router_unit(args, u, lds, tid, wave, lane);
        if (BOTH(6)) GRID_BAR();
    }
    if (IN(7)) {
        PHASE_IDS
        LAS int* ps = (LAS int*)lds; LAS int* up = ps + 32; LAS int* cn = ps + 64;
        const int* CNTE = (const int*)(ws + WS_CTL) + CW_CNTE; const int* UCNT = (const int*)(sm + SM_UCNT);
        int* ROWTOK = (int*)(sm + SM_ROWTOK); float* ROWGATE = (float*)(sm + SM_ROWGATE); float* ROWRS = (float*)(sm + SM_ROWRS);
        if (tid < 64) {
            const int cnt = tid < 32 ? CNTE[tid] : 0, pad = ((cnt + 255) >> 8) << 8; int inc = pad;
#pragma unroll
            for (int off = 1; off < 32; off <<= 1) { const int p = __shfl_up(inc, off); if (tid >= off) inc += p; }
            if (tid < 32) { ps[tid] = inc - pad; cn[tid] = cnt; } }
        __syncthreads();
        for (int u = bx; u < NCHT; u += G) {
            { LAS int* pp = ps + 128; int s0 = 0, s1 = 0, s2 = 0, s3 = 0; const int e = tid & 31, part = tid >> 5;
              for (int v = part; v < u; v += 64) { s0 += UCNT[v * 32 + e]; if (v + 16 < u) s1 += UCNT[(v + 16) * 32 + e]; if (v + 32 < u) s2 += UCNT[(v + 32) * 32 + e]; if (v + 48 < u) s3 += UCNT[(v + 48) * 32 + e]; }
              pp[part * 32 + e] = (s0 + s1) + (s2 + s3); }
            __syncthreads();
            if (tid < 32) { int s = 0; for (int q = 0; q < 16; ++q) s += ps[128 + q * 32 + tid]; up[tid] = s; }
            __syncthreads();
            if (tid < 256) { const int ai = u * 256 + tid, t = ai >> 2; const int e = ((const int*)(sm + SM_TOPI))[ai]; const int dest = ps[e] + up[e] + ((const int*)(sm + SM_LRANK))[ai];
                ROWTOK[dest] = t; ROWGATE[dest] = ((const float*)(sm + SM_TOPG))[ai]; ROWRS[dest] = ((const float*)(sm + SM_RS2))[t]; ((int*)(sm + SM_DEST))[ai] = dest; }
            __syncthreads();
        }
        for (int e = bx; e < 32; e += G) { const int c0 = cn[e], c1 = ((c0 + 255) >> 8) << 8; for (int p = c0 + tid; p < c1; p += 512) { ROWTOK[ps[e] + p] = 0; ROWGATE[ps[e] + p] = 0.f; ROWRS[ps[e] + p] = 0.f; } }
        if (BOTH(7)) GRID_BAR();
    }
    if (IN(8) || IN(9)) {
        PHASE_IDS
        LAS int* tile_e = (LAS int*)(lds + MISC_OFF + 1024); LAS int* meta = (LAS int*)(lds + MISC_OFF + 512);
        if (tid < 64) {
            const int* CNTE = (const int*)(ws + WS_CTL) + CW_CNTE; const int nt = tid < 32 ? (CNTE[tid] + 255) >> 8 : 0; int inc = nt;
#pragma unroll
            for (int off = 1; off < 32; off <<= 1) { const int p = __shfl_up(inc, off); if (tid >= off) inc += p; }
            for (int i = 0; i < nt; ++i) tile_e[inc - nt + i] = tid;
            if (tid == 31) meta[0] = inc; }
        __syncthreads();
        const int n_mt = meta[0];
        if (IN(8)) {
            pg8::Gemm g{ws + WS_H1B, ws + WS_WGU, DM, (size_t)4096 * DM, (const int*)(sm + SM_ROWTOK), ONE_E8M0, W8_E8M0}; pg8::Order S;
            S.init(n_mt, 16, G, bx, tile_e);
            pg8::EpiMoe1 E{ws + WS_ACT, argin(args, 16)};
            pg8::gemm_phase<pg8::EpiMoe1, true, true, true>(lds, g, S, E, tid);
            if (BOTH(8)) GRID_BAR();
        }
        if (IN(9)) {
            pg8::Gemm g{ws + WS_ACT, ws + WS_WDN, DM, (size_t)DM * DM, nullptr, ACT8_E8M0, W8_E8M0}; pg8::Order S;
            S.init(n_mt, 8, G, bx, tile_e);
            pg8::EpiMoe2 E{ws + WS_YB, argin(args, 18), (const float*)(sm + SM_ROWGATE)};
            pg8::gemm_phase<pg8::EpiMoe2, false, true, true>(lds, g, S, E, tid);
            if (BOTH(9)) GRID_BAR();
        }
    }
    if (IN(10)) {
        PHASE_IDS
        const float* H1 = (const float*)(ws + WS_H1); const unsigned char* YB = ws + WS_YB; bf16* H2 = (bf16*)(ws + WS_H2); unsigned char* H2Q = ws + WS_H2B;
        const int* DEST = (const int*)(sm + SM_DEST); const float* PESSQ = (const float*)(sm + SM_PESSQ);
        for (int t = gw; t < NTOK; t += NGW) { const i32x4 dd = *(const i32x4*)(DEST + t * 4); float ss = 0.f;
            f32x4 hvv[8]; unsigned yv[8][4];
#pragma unroll
            for (int j = 0; j < 8; ++j) { const int col = 4 * lane + 256 * j; hvv[j] = *(const f32x4*)(H1 + (size_t)t * DM + col);
                yv[j][0] = *(const unsigned*)(YB + (size_t)dd[0] * DM + col); yv[j][1] = *(const unsigned*)(YB + (size_t)dd[1] * DM + col); yv[j][2] = *(const unsigned*)(YB + (size_t)dd[2] * DM + col); yv[j][3] = *(const unsigned*)(YB + (size_t)dd[3] * DM + col); }
            asm volatile("" ::: "memory");
#pragma unroll
            for (int j = 0; j < 8; ++j) { const int col = 4 * lane + 256 * j; f32x4 hv = hvv[j]; const unsigned y0 = yv[j][0], y1 = yv[j][1], y2 = yv[j][2], y3 = yv[j][3];
                const f32x2 a0 = __builtin_amdgcn_cvt_pk_f32_fp8(y0, false) + __builtin_amdgcn_cvt_pk_f32_fp8(y1, false) + (__builtin_amdgcn_cvt_pk_f32_fp8(y2, false) + __builtin_amdgcn_cvt_pk_f32_fp8(y3, false));
                const f32x2 a1 = __builtin_amdgcn_cvt_pk_f32_fp8(y0, true) + __builtin_amdgcn_cvt_pk_f32_fp8(y1, true) + (__builtin_amdgcn_cvt_pk_f32_fp8(y2, true) + __builtin_amdgcn_cvt_pk_f32_fp8(y3, true));
                hv[0] += a0[0] * (1.f / YB8_SCALE); hv[1] += a0[1] * (1.f / YB8_SCALE); hv[2] += a1[0] * (1.f / YB8_SCALE); hv[3] += a1[1] * (1.f / YB8_SCALE);
                *(u32x2*)(H2 + (size_t)t * DM + col) = (u32x2){pk2(hv[0], hv[1]), pk2(hv[2], hv[3])}; *(unsigned*)(H2Q + (size_t)t * DM + col) = pk4_fp8(hv[0] * ACT8_SCALE, hv[1] * ACT8_SCALE, hv[2] * ACT8_SCALE, hv[3] * ACT8_SCALE);
                ss += (hv[0] * hv[0] + hv[1] * hv[1]) + (hv[2] * hv[2] + hv[3] * hv[3]); }
            ss = wave_sum(ss); const float ps = wave_sum(lane < 32 ? PESSQ[(size_t)t * 32 + lane] : 0.f);
            if (lane == 0) { ((float*)(sm + SM_RS3))[t] = rsqrtf(ss * (1.f / DM) + EPS); ((float*)(sm + SM_RSPE))[t] = rsqrtf(ps * (1.f / DM) + EPS); } }
        if (BOTH(10)) GRID_BAR();
    }
    if (IN(11)) {
        PHASE_IDS
        pg8::Gemm g{ws + WS_H2B, ws + WS_WPG, DM, 0, nullptr, ACT8_E8M0, W8_E8M0}; pg8::Order S; S.init(NTOK / 256, DM / 256, G, bx, nullptr);
        pg8::EpiPg E{(const bf16*)(ws + WS_H2), (const bf16*)(ws + WS_PE), (const float*)(sm + SM_RS3), (const float*)(sm + SM_RSPE), argin(args, 22), (bf16*)(ws + WS_H3), (float*)(sm + SM_SSQ3)};
        pg8::gemm_phase<pg8::EpiPg, false, true, true>(lds, g, S, E, tid);
        if (BOTH(11)) GRID_BAR();
    }
#ifdef DBG_OUT
    if (IN(12)) {
        PHASE_IDS
        for (int t = gw; t < NTOK; t += NGW) {
#pragma unroll
            for (int j = 0; j < 8; ++j) { const int col = 4 * lane + 256 * j; f32x4 v;
#if DBG_OUT == 1
                { const u32x2 w = *(const u32x2*)((const bf16*)(ws + WS_Z) + (size_t)t * NZ + col); v = (f32x4){bflo(w.x), bfhi(w.x), bflo(w.y), bfhi(w.y)}; }
#elif DBG_OUT == 3
                v = *(const f32x4*)((const float*)(ws + WS_OSC) + (size_t)t * DM + col);
#elif DBG_OUT == 2
                { const size_t idx = (size_t)t * 1024 + (col & 1023);
                  if (col < 1024) v = *(const f32x4*)((const float*)(ws + WS_GU) + idx);
                  else { for (int q = 0; q < 4; ++q) { const size_t ix = idx + q; float a = bf2f(((const bf16*)(ws + WS_MVT))[ix]) + bf2f(((const bf16*)(ws + WS_MKWT))[ix & 8388607]) + bf2f(((const bf16*)(ws + WS_MWT))[ix & 4194303])
                      + bf2f(((const bf16*)(ws + WS_GW))[ix]) + bf2f(((const bf16*)(ws + WS_GKDT))[ix]) + bf2f(((const bf16*)(ws + WS_GQD))[ix]) + bf2f(((const bf16*)(ws + WS_GAT))[ix & 8388607])
                      + ((const float*)(sm + SM_MSI))[ix & 65535] + ((const float*)(sm + SM_MEN))[ix & 65535] + ((const float*)(sm + SM_MWS))[ix & 65535] + ((const float*)(sm + SM_GLAST))[ix & 2047] + ((const float*)(sm + SM_MDEC))[ix & 1023];
                      v[q] = a; } } }
#elif DBG_OUT == 31
                v = col < 1024 ? *(const f32x4*)((const float*)(ws + WS_OSC) + (size_t)t * DM + col) : (f32x4){0.f, 0.f, 0.f, 0.f};
#elif DBG_OUT == 32
                v = col >= 1024 ? *(const f32x4*)((const float*)(ws + WS_OSC) + (size_t)t * DM + col) : (f32x4){0.f, 0.f, 0.f, 0.f};
#elif DBG_OUT == 5
                v = *(const f32x4*)((const float*)(ws + WS_H1) + (size_t)t * DM + col);
#elif DBG_OUT == 10
                v = *(const f32x4*)((const float*)(ws + WS_H2) + (size_t)t * DM + col);
#endif
                *(f32x4*)(args.out + (size_t)t * DM + col) = v; } }
    }
#else
    if (IN(12)) {
        PHASE_IDS
        const bf16* H3 = (const bf16*)(ws + WS_H3); const float* SSQ3 = (const float*)(sm + SM_SSQ3); const float* gf = argin(args, 23);
        for (int t = gw; t < NTOK; t += NGW) { u32x2 hw[8]; f32x4 gv[8];
#pragma unroll
            for (int j = 0; j < 8; ++j) { const int col = 4 * lane + 256 * j; hw[j] = *(const u32x2*)(H3 + (size_t)t * DM + col); gv[j] = *(const f32x4*)(gf + col); }
            const float r = rsqrtf(wave_sum(lane < 32 ? SSQ3[(size_t)t * 32 + lane] : 0.f) * (1.f / DM) + EPS);
#pragma unroll
            for (int j = 0; j < 8; ++j) { const int col = 4 * lane + 256 * j; const f32x4 hv = (f32x4){bflo(hw[j].x), bfhi(hw[j].x), bflo(hw[j].y), bfhi(hw[j].y)};
                *(f32x4*)(args.out + (size_t)t * DM + col) = hv * gv[j] * r; } }
    }
#endif
#ifdef DBG_DET
    if (lo == 13) { PHASE_IDS
        unsigned long long s1 = 0ull, s2 = 0ull;
        auto acc_region = [&](const unsigned* p, size_t nwords) { for (size_t i = (size_t)bx * 512 + tid; i < nwords; i += (size_t)G * 512) { const unsigned w = p[i]; s1 += w; s2 += (unsigned long long)w * ((unsigned)i | 1u); } };
#if DBG_DET == 0
        acc_region((const unsigned*)(ws + WS_WIN), (size_t)(WS_Z - WS_WIN) / 4);
        acc_region((const unsigned*)(sm + SM_RS1), (size_t)(SM_GLAST - SM_RS1) / 4);
#elif DBG_DET == 1
        acc_region((const unsigned*)(ws + WS_Z), (size_t)(WS_GW - WS_Z) / 4);
        acc_region((const unsigned*)(sm + SM_PESSQ), (size_t)(2 << 20) / 4);
#elif DBG_DET == 2
        acc_region((const unsigned*)(ws + WS_GW), (size_t)(WS_OSC - WS_GW) / 4);
        acc_region((const unsigned*)(sm + SM_GLAST), (size_t)(SM_DEN - SM_GLAST) / 4);
#elif DBG_DET == 3
        acc_region((const unsigned*)(ws + WS_OSC), (size_t)(WS_Y - WS_OSC) / 4);
        acc_region((const unsigned*)(sm + SM_DEN), (size_t)(256 << 10) / 4);
#endif
        for (int o = 1; o < 64; o <<= 1) { s1 += __shfl_xor(s1, o); s2 += __shfl_xor(s2, o); }
        if (lane == 0) { unsigned long long* slot = (unsigned long long*)(ws + WS_CTL) + 8192 + 2 * args.aux; atomicAdd(slot, s1); atomicAdd(slot + 1, s2); }
    }
    if (lo == 14) { PHASE_IDS
        const unsigned long long* slot = (const unsigned long long*)(ws + WS_CTL) + 8192;
        const float v = (slot[0] == slot[2] && slot[1] == slot[3]) ? 0.f : 3.f;
        for (size_t i = (size_t)bx * 512 + tid; i < (size_t)NTOK * DM; i += (size_t)G * 512) args.out[i] = v;
    }
#endif
#undef IN
#undef BOTH
}

extern "C" void kernel_launch(void* const* d_in, const int* in_sizes, int n_in, void* d_out, int out_size, void* d_ws, size_t ws_size, hipStream_t stream) {
    static int grid = 0;
    if (grid == 0) {
        if (n_in != 24 || out_size != NTOK * DM || ws_size < WS_END) { fprintf(stderr, "kernel_launch: unexpected problem (n_in %d, out %d, ws %zu)\n", n_in, out_size, ws_size); grid = -1; return; }
        int dev = 0, cus = 0, per_cu = 0;
        if (hipGetDevice(&dev) != hipSuccess || hipDeviceGetAttribute(&cus, hipDeviceAttributeMultiprocessorCount, dev) != hipSuccess) { grid = -1; return; }
        if (hipFuncSetAttribute((const void*)mk_fwd, hipFuncAttributeMaxDynamicSharedMemorySize, LDS_BYTES) != hipSuccess) { fprintf(stderr, "kernel_launch: hipFuncSetAttribute failed\n"); grid = -1; return; }
        if (hipOccupancyMaxActiveBlocksPerMultiprocessor(&per_cu, (const void*)mk_fwd, NWAVES * 64, LDS_BYTES) != hipSuccess || per_cu < 1) fprintf(stderr, "kernel_launch: occupancy query reports %d\n", per_cu);
        (void)hipGetLastError();
        grid = cus;
    }
    if (grid < 0) return;
    (void)hipMemsetAsync((char*)d_ws + WS_CTL, 0, CTL_ZERO_BYTES, stream);
    Args a{};
    for (int i = 0; i < 24; ++i) a.in[i] = (const float*)d_in[i];
    a.out = (float*)d_out; a.ws = (unsigned char*)d_ws;
#ifdef DBG_DET
    for (int rep = 0; rep < 2; ++rep) {
        for (int ph = 0; ph <= DBG_DET; ++ph) { a.ph_lo = ph; a.ph_hi = ph + 1; hipLaunchKernelGGL(mk_fwd, dim3(grid), dim3(NWAVES * 64), LDS_BYTES, stream, a); }
        a.ph_lo = 13; a.ph_hi = 13; a.aux = rep; hipLaunchKernelGGL(mk_fwd, dim3(grid), dim3(NWAVES * 64), LDS_BYTES, stream, a); a.aux = 0;
    }
    a.ph_lo = 14; a.ph_hi = 14; hipLaunchKernelGGL(mk_fwd, dim3(grid), dim3(NWAVES * 64), LDS_BYTES, stream, a);
    return;
#endif
#if MK_SPLIT
#ifndef DUP_MASK
#define DUP_MASK 0u
#endif
    for (int ph = 0; ph < NPHASE; ++ph) { a.ph_lo = ph; a.ph_hi = ph + 1; const int reps = ((DUP_MASK >> ph) & 1u) ? 2 : 1;
        for (int r = 0; r < reps; ++r) { a.aux = (r == 1) ? DUP_AUX : 0; hipLaunchKernelGGL(mk_fwd, dim3(grid), dim3(NWAVES * 64), LDS_BYTES, stream, a); a.aux = 0; } }
#else
    a.ph_lo = 0; a.ph_hi = NPHASE; hipLaunchKernelGGL(mk_fwd, dim3(grid), dim3(NWAVES * 64), LDS_BYTES, stream, a);
#endif
}
```

```cpp
#include <hip/hip_runtime.h>
#include <cstdio>
#include <cstdint>


#ifndef DUP_AUX
#define DUP_AUX 0
#endif
#ifndef P3_DUP
#define P3_DUP 0
#endif
#ifndef P2_DUP
#define P2_DUP 0
#endif
#ifndef MK_SPLIT
#define DUP_MASK 0x0u
#define MK_SPLIT 0
#endif

#define LAS __attribute__((address_space(3)))
typedef unsigned short bf16;
typedef short bf16x8 __attribute__((ext_vector_type(8)));
typedef float f32x4 __attribute__((ext_vector_type(4)));
typedef float f32x2 __attribute__((ext_vector_type(2)));
typedef unsigned u32x4 __attribute__((ext_vector_type(4)));
typedef unsigned u32x2 __attribute__((ext_vector_type(2)));
typedef int i32x8 __attribute__((ext_vector_type(8)));
typedef int i32x4 __attribute__((ext_vector_type(4)));

constexpr int NTOK = 16384, DM = 2048, SEQL = 4096, NCHT = 256  ;
constexpr int DIN = 7192, NZ = 7168, PLE = 256, NEXP = 32;
constexpr int ZQ = 0, ZK = 1024, ZV = 2048, ZG = 3072, ZMQ = 4096, ZMK = 4608, ZMV = 5120, ZMO = 6144;
constexpr int MAXROWS = 73728;
constexpr float EPS = 1e-6f;

constexpr size_t MiB = 1ull << 20;
constexpr size_t WS_CTL = 0, CTL_ZERO_BYTES = 1 * MiB;
constexpr size_t WS_WIN = 1 * MiB, WS_WOUT = 29 * MiB, WS_WPG = 37 * MiB, WS_WPP = 45 * MiB, WS_WGU = 46 * MiB, WS_WDN = 558 * MiB;
constexpr size_t WS_XB = 814 * MiB, WS_PB = 878 * MiB, WS_Z = 886 * MiB, WS_PE = 1110 * MiB;
constexpr size_t WS_GW = 1174 * MiB, WS_GQD = 1206 * MiB, WS_GKDT = 1238 * MiB, WS_GAT = 1270 * MiB, WS_GU = 1286 * MiB;
constexpr size_t WS_MWT = 1350 * MiB, WS_MKWT = 1358 * MiB, WS_MVT = 1374 * MiB;
constexpr size_t WS_OSC = 1406 * MiB, WS_Y = 1534 * MiB, WS_H1 = 1598 * MiB, WS_H1B = 1726 * MiB;
constexpr size_t WS_ACT = 1790 * MiB, WS_YB = 2078 * MiB, WS_H2 = 2366 * MiB, WS_H2B = 2494 * MiB, WS_H3 = 2558 * MiB;
constexpr size_t WS_SMALL = 2686 * MiB;
constexpr size_t WS_WSK = 3038 * MiB;
constexpr size_t WS_GAP = 2718 * MiB, WS_GBB = 2782 * MiB, WS_GSS = 2846 * MiB, WS_MBM = 2910 * MiB, WS_MCS = 2974 * MiB, WS_END = 3039 * MiB;
constexpr size_t SM_RS1 = 0, SM_GC = 64 << 10, SM_BETA = SM_GC + (512 << 10), SM_FC = SM_BETA + (512 << 10), SM_IC = SM_FC + (256 << 10);
constexpr size_t SM_FLAST = SM_IC + (256 << 10), SM_AMAX = SM_FLAST + 4096, SM_GLAST = SM_AMAX + 4096;
constexpr size_t SM_MSI = SM_GLAST + 8192, SM_MEN = SM_MSI + (256 << 10), SM_MWS = SM_MEN + (256 << 10), SM_MDEC = SM_MWS + (256 << 10);
constexpr size_t SM_DEN = SM_MDEC + 4096, SM_PESSQ = SM_DEN + (256 << 10), SM_SSQ1 = SM_PESSQ + (2 << 20), SM_SSQ3 = SM_SSQ1 + (2 << 20);
constexpr size_t SM_RS2 = SM_SSQ3 + (2 << 20), SM_RS3 = SM_RS2 + (64 << 10), SM_RSPE = SM_RS3 + (64 << 10);
constexpr size_t SM_TOPI = SM_RSPE + (64 << 10), SM_TOPG = SM_TOPI + (256 << 10), SM_LRANK = SM_TOPG + (256 << 10), SM_DEST = SM_LRANK + (256 << 10);
constexpr size_t SM_UCNT = SM_DEST + (256 << 10), SM_ROWTOK = SM_UCNT + (32 << 10), SM_ROWGATE = SM_ROWTOK + (288 << 10), SM_ROWRS = SM_ROWGATE + (288 << 10);
constexpr size_t SM_MKS = SM_ROWRS + (288 << 10), SM_MNS = SM_MKS + (512 << 10);
constexpr size_t SM_END = SM_MNS + (512 << 10);
static_assert(SM_END <= 32 * MiB, "small arrays");
constexpr int CW_BAR = 4096, CW_CNTE = 8192, CW_POOL = 8320;

constexpr int RING_BYTES = 131072, MISC_OFF = 139264, LDS_BYTES = 155648;
constexpr int NWAVES = 8;
constexpr int GN_LDS = 134144;

typedef __bf16 bf16v2_t __attribute__((ext_vector_type(2)));
__device__ __forceinline__ unsigned pk2(float lo, float hi) { const f32x2 v = {lo, hi}; return __builtin_bit_cast(unsigned, __builtin_convertvector(v, bf16v2_t)); }
__device__ __forceinline__ bf16 f2bf(float f) { return __builtin_bit_cast(unsigned short, (__bf16)f); }
__device__ __forceinline__ unsigned pk4_fp8(float a, float b, float c, float d) { unsigned w = 0u; w = __builtin_amdgcn_cvt_pk_fp8_f32(a, b, w, false); w = __builtin_amdgcn_cvt_pk_fp8_f32(c, d, w, true); return w; }
constexpr float W8_SCALE = 32.f; constexpr int W8_E8M0 = 0x7a7a7a7a;
constexpr float ACT8_SCALE = 4.f; constexpr int ACT8_E8M0 = 0x7d7d7d7d;
constexpr int ONE_E8M0 = 0x7f7f7f7f;
constexpr float YB8_SCALE = 16.f;
constexpr float Y8_SCALE = 16.f; constexpr int Y8_E8M0 = 0x7b7b7b7b;
__device__ __forceinline__ float bf2f(bf16 b) { return __uint_as_float(((unsigned)b) << 16); }
__device__ __forceinline__ float bflo(unsigned w) { return __uint_as_float(w << 16); }
__device__ __forceinline__ float bfhi(unsigned w) { return __uint_as_float(w & 0xffff0000u); }
__device__ __forceinline__ float wave_sum(float v) {
#pragma unroll
    for (int o = 1; o < 64; o <<= 1) v += __shfl_xor(v, o);
    return v;
}
__device__ __forceinline__ float sigm(float x) { return __builtin_amdgcn_rcpf(1.f + __expf(-x)); }
__device__ __forceinline__ float softplusf(float x) { return fmaxf(x, 0.f) + log1pf(expf(-fabsf(x))); }
#define LDS_WAIT() asm volatile("s_waitcnt lgkmcnt(0)" ::: "memory")

#define XB_TMO      128
#define XB_XCNT(j)  (256  + 64 * (j))
#define XB_XSUB(j)  (1280 + 64 * (j))
#define XB_XGEN(j)  (2304 + 64 * (j))
#define XB_TOP      3328
#define XB_TOPGEN   3392
#define XCD_BAR_WORDS 3456
#define XB_SPIN_CAP (1u << 18)
__device__ __forceinline__ unsigned xb_ld(unsigned* p)              { return __hip_atomic_load(p, __ATOMIC_RELAXED, __HIP_MEMORY_SCOPE_AGENT); }
__device__ __forceinline__ unsigned xb_add(unsigned* p, unsigned v) { return __hip_atomic_fetch_add(p, v, __ATOMIC_RELAXED, __HIP_MEMORY_SCOPE_AGENT); }
__device__ __forceinline__ unsigned xb_xcc_id() { return (unsigned)__builtin_amdgcn_s_getreg((3 << 11) | 20) & 0xFu; }
#define XB_SPIN(cond, bar) do { unsigned _sp = 0; while (cond) { __builtin_amdgcn_s_sleep(1); \
    if ((++_sp & 255u) == 0u) { if (xb_ld(&(bar)[XB_TMO])) break; if (_sp > XB_SPIN_CAP) { atomicAdd(&(bar)[XB_TMO], 1u); break; } } } } while (0)
struct XcdBarrier { unsigned* bar; unsigned x; volatile LAS unsigned* st; };
__device__ __forceinline__ XcdBarrier xcd_barrier_post(unsigned* bar, volatile LAS unsigned* st, bool tid0) {
    XcdBarrier b; b.bar = bar; b.x = xb_xcc_id(); b.st = st;
    if (tid0) (void)xb_add(&bar[XB_XCNT(b.x)], 1u);
    return b;
}
__device__ __forceinline__ void xcd_barrier_complete(unsigned* bar, unsigned x, unsigned& nloc, unsigned& nx) {
    const unsigned G = gridDim.x * gridDim.y * gridDim.z;
    unsigned sum, cnt, mine, sp = 0u;
    for (;;) {
        sum = 0u; cnt = 0u; mine = 0u;
#pragma unroll
        for (unsigned j = 0; j < 16; ++j) { const unsigned c = xb_ld(&bar[XB_XCNT(j)]); sum += c; cnt += (c > 0u) ? 1u : 0u; mine = (j == x) ? c : mine; }
        if (sum == G) break;
        __builtin_amdgcn_s_sleep(1);
        if ((++sp & 255u) == 0u) { if (xb_ld(&bar[XB_TMO])) break; if (sp > XB_SPIN_CAP) { atomicAdd(&bar[XB_TMO], 1u); break; } }
    }
    nloc = mine > 0u ? mine : 1u; nx = cnt > 0u ? cnt : 1u;
}
__device__ __forceinline__ void xcd_barrier(const XcdBarrier& b, bool tid0) {
    asm volatile("s_waitcnt vmcnt(0)" ::: "memory");
    __syncthreads();
    if (tid0) {
        unsigned* bar = b.bar;
        __builtin_amdgcn_s_waitcnt(0);
        unsigned nloc = b.st[0], nx = b.st[1];
        if (nloc == 0u) { xcd_barrier_complete(bar, b.x, nloc, nx); b.st[0] = nloc; b.st[1] = nx; }
        const unsigned old = xb_add(&bar[XB_XSUB(b.x)], 1u);
        const unsigned gen = old / nloc;
        if (old + 1u == (gen + 1u) * nloc) {
            __builtin_amdgcn_fence(__ATOMIC_RELEASE, "agent");
            asm volatile("s_waitcnt vmcnt(0)" ::: "memory");
            const unsigned og = xb_add(&bar[XB_TOP], 1u);
            const unsigned tg = og / nx;
            if (og + 1u == (tg + 1u) * nx) xb_add(&bar[XB_TOPGEN], 1u);
            else XB_SPIN(xb_ld(&bar[XB_TOPGEN]) == tg, bar);
            __builtin_amdgcn_fence(__ATOMIC_ACQUIRE, "agent");
            xb_add(&bar[XB_XGEN(b.x)], 1u);
            asm volatile("s_waitcnt vmcnt(0)" ::: "memory");
        } else {
            XB_SPIN(xb_ld(&bar[XB_XGEN(b.x)]) == gen, bar);
            __builtin_amdgcn_fence(__ATOMIC_ACQUIRE, "agent");
            asm volatile("s_waitcnt vmcnt(0)" ::: "memory");
        }
    }
    __syncthreads();
}

namespace pg8 {
constexpr int BM = 256, BK = 64, HALF = 128, HTB = HALF * BK * 2, STAGE_BYTES = 8 * HTB, NXCD = 8, WGM = 8;
__host__ __device__ __forceinline__ int lds_byte(int r, int c) { const int st = (r >> 4) * 2 + (c >> 5), rr = r & 15, cc = c & 31, ob = rr * 64 + cc * 2; return st * 1024 + (ob ^ (((ob >> 9) & 1) << 5)); }
__host__ __device__ __forceinline__ void stage_rc(int b, int& R, int& C) { const int st = b / 1024, sb = b % 1024, swz = sb ^ (((sb >> 9) & 1) << 5); R = (st >> 1) * 16 + swz / 64; C = (st & 1) * 32 + (swz % 64) / 2; }
__host__ __device__ __forceinline__ int perm32(int rho) { const int n = rho >> 4, i = rho & 15; return 8 * (i >> 2) + 4 * n + (i & 3); }
struct Unit { int pm, pn, e; };
struct Gemm { const void* A; const void* Bt; int K; size_t bstride; const int* rowtab; int sclA, sclB; };
struct Order {
    int nM, nN, nwg, G, c; const LAS int* tile_e;
    __device__ __forceinline__ void init(int nM_, int nN_, int G_, int c_, const LAS int* te) { nM = nM_; nN = nN_; nwg = nM * nN; G = G_; c = c_; tile_e = te; }
    __device__ __forceinline__ bool next(int i, Unit& u) const {
        const long L = (long)i * G + c; if (L >= nwg) return false;
        int wgid = (int)L; { const int q = nwg / NXCD, r = nwg % NXCD, xcd = wgid % NXCD, off = wgid / NXCD; wgid = (xcd < r ? xcd * (q + 1) : r * (q + 1) + (xcd - r) * q) + off; }
        const int nig = WGM * nN, gid = wgid / nig, fm = gid * WGM, gsz = (nM - fm) < WGM ? (nM - fm) : WGM;
        u.pm = fm + ((wgid % nig) % gsz); u.pn = (wgid % nig) / gsz; u.e = tile_e ? tile_e[u.pm] : 0; return true;
    }
};

template <class Epi, bool GATHER, bool ALIGN_EPI, bool FP8 = false>
__device__ __forceinline__ void gemm_phase(LAS unsigned char* lds, const Gemm g, const Order& S, const Epi& E, const int tid) {
    const int wid = __builtin_amdgcn_readfirstlane(tid >> 6), lane = tid & 63, wr = wid >> 2, wc = wid & 3, fr = lane & 15, fq = lane >> 4;
    const int K = g.K, nt = K / 128;
    unsigned voffA[2], voffB[2]; int Rg[2], Cg[2];
#pragma unroll
    for (int i = 0; i < 2; ++i) { int R, C; stage_rc(tid * 16 + i * 8192, R, C); const int Rb = Epi::PERM ? ((R & ~31) + perm32(R & 31)) : R;
        voffA[i] = (unsigned)(R * K + C * 2); voffB[i] = (unsigned)(Rb * K + C * 2); Rg[i] = R; Cg[i] = C; }
    unsigned vAc[2][2], vAn[2][2];
    const size_t kstep = (size_t)128;
    const size_t hstep = (size_t)HALF * K;
    const size_t tstep = 2 * hstep;
    const unsigned ldsw = (unsigned)wid * 1024u;
    const int aoff = lds_byte(wr * 64 + fr, fq * 8), boff = lds_byte(wc * 32 + fr, fq * 8);
    const int lc1 = 2 * (fq & 1);
    const int aoff8a = lds_byte(wr * 64 + fr, (fq >> 1) * 32 + lc1 * 8), aoff8b = lds_byte(wr * 64 + fr, (fq >> 1) * 32 + (lc1 ^ 1) * 8);
    const int boff8a = lds_byte(wc * 32 + fr, (fq >> 1) * 32 + lc1 * 8), boff8b = lds_byte(wc * 32 + fr, (fq >> 1) * 32 + (lc1 ^ 1) * 8);
#define PG8_SA(b, h) (((b) * 2 + (h)) * HTB)
#define PG8_SB(b, h) ((4 + (b) * 2 + (h)) * HTB)
#define PG8_STAGE(bufoff, gbase, voff) do { _Pragma("unroll") for (int _i = 0; _i < 2; ++_i) \
        __builtin_amdgcn_global_load_lds((const unsigned*)((const char*)(gbase) + (voff)[_i]), (LAS unsigned*)(lds + (bufoff) + ldsw + _i * 8192), 16, 0, 0); } while (0)
#define PG8_STAGE_A(bufoff, kp, h, nx) do { if constexpr (GATHER) { _Pragma("unroll") for (int _i = 0; _i < 2; ++_i) { const unsigned _vo = (nx) ? vAn[h][_i] : vAc[h][_i]; \
        __builtin_amdgcn_global_load_lds((const unsigned*)((const char*)(kp) + _vo), (LAS unsigned*)(lds + (bufoff) + ldsw + _i * 8192), 16, 0, 0); } } \
        else { PG8_STAGE(bufoff, (kp) + (h) * hstep, voffA); } } while (0)
#define PG8_LD8(base, o1, o2) __builtin_shufflevector(*(const LAS i32x4*)(lds + (base) + (o1)), *(const LAS i32x4*)(lds + (base) + (o2)), 0, 1, 2, 3, 4, 5, 6, 7)
#define PG8_LDA(dst, b, h) do { if constexpr (FP8) { _Pragma("unroll") for (int m = 0; m < 4; ++m) dst##8[m] = PG8_LD8(PG8_SA(b, h) + m * 2048, aoff8a, aoff8b); } \
        else { _Pragma("unroll") for (int m = 0; m < 4; ++m) _Pragma("unroll") for (int k = 0; k < 2; ++k) dst[m][k] = *(const LAS bf16x8*)(lds + PG8_SA(b, h) + aoff + m * 2048 + k * 1024); } } while (0)
#define PG8_LDB(dst, b, h) do { if constexpr (FP8) { _Pragma("unroll") for (int n = 0; n < 2; ++n) dst##8[n] = PG8_LD8(PG8_SB(b, h) + n * 2048, boff8a, boff8b); } \
        else { _Pragma("unroll") for (int n = 0; n < 2; ++n) _Pragma("unroll") for (int k = 0; k < 2; ++k) dst[n][k] = *(const LAS bf16x8*)(lds + PG8_SB(b, h) + boff + n * 2048 + k * 1024); } } while (0)
#define PG8_MMA(ai, bj, At, Bt) do { __builtin_amdgcn_s_setprio(1); if constexpr (FP8) { _Pragma("unroll") for (int m = 0; m < 4; ++m) _Pragma("unroll") for (int n = 0; n < 2; ++n) \
        asm volatile("v_mfma_scale_f32_16x16x128_f8f6f4 %0, %1, %2, %0, %3, %4 op_sel_hi:[0,0,0]" : "+v"(acc[ai][bj][m][n]) : "v"(Bt##8[n]), "v"(At##8[m]), "v"(sclBv), "v"(sclAv)); } \
        else { _Pragma("unroll") for (int m = 0; m < 4; ++m) _Pragma("unroll") for (int n = 0; n < 2; ++n) _Pragma("unroll") for (int k = 0; k < 2; ++k) \
        acc[ai][bj][m][n] = __builtin_amdgcn_mfma_f32_16x16x32_bf16(Bt[n][k], At[m][k], acc[ai][bj][m][n], 0, 0, 0); } __builtin_amdgcn_s_setprio(0); } while (0)
#define PG8_WAIT_V(n) asm volatile("s_waitcnt vmcnt(" #n ")" ::: "memory")
#define PG8_WAIT_L(n) asm volatile("s_waitcnt lgkmcnt(" #n ")" ::: "memory")
#define PG8_BAR __builtin_amdgcn_s_barrier()
#define PG8_SCHED __builtin_amdgcn_sched_barrier(0)
#define PG8_GOFF(dst, u) do { if constexpr (GATHER) { _Pragma("unroll") for (int _h = 0; _h < 2; ++_h) _Pragma("unroll") for (int _i = 0; _i < 2; ++_i) \
        dst[_h][_i] = (unsigned)g.rowtab[(u).pm * BM + _h * HALF + Rg[_i]] * (unsigned)K + (unsigned)(Cg[_i] * 2); } } while (0)
    Unit cur, nxt; int ui = 0;
    if (!S.next(0, cur)) return;
    f32x4 acc[2][2][4][2];
#pragma unroll
    for (int a = 0; a < 2; ++a)
#pragma unroll
        for (int b = 0; b < 2; ++b)
#pragma unroll
            for (int m = 0; m < 4; ++m)
#pragma unroll
                for (int n = 0; n < 2; ++n) acc[a][b][m][n] = (f32x4){0.f, 0.f, 0.f, 0.f};
    bf16x8 At[4][2], B0[2][2], B1[2][2]; i32x8 At8[4], B08[2], B18[2];
    const int sclAv = g.sclA, sclBv = g.sclB;
    PG8_GOFF(vAc, cur);
#pragma unroll
    for (int _h = 0; _h < 2; ++_h)
#pragma unroll
        for (int _i = 0; _i < 2; ++_i) vAn[_h][_i] = vAc[_h][_i];
    const char* cA = GATHER ? (const char*)g.A : (const char*)g.A + (size_t)cur.pm * tstep;
    const char* cB = (const char*)g.Bt + (size_t)cur.e * g.bstride + (size_t)cur.pn * tstep;
    PG8_STAGE(PG8_SB(0, 0), cB, voffB); PG8_STAGE(PG8_SB(0, 1), cB + hstep, voffB); PG8_STAGE_A(PG8_SA(0, 0), cA, 0, false); PG8_STAGE_A(PG8_SA(0, 1), cA, 1, false);
    if (wr == 1) PG8_BAR;
    PG8_WAIT_V(2); PG8_BAR;
    PG8_STAGE(PG8_SB(1, 0), cB + kstep, voffB); PG8_STAGE_A(PG8_SA(1, 0), cA + kstep, 0, false); PG8_STAGE(PG8_SB(1, 1), cB + hstep + kstep, voffB);
    PG8_WAIT_V(6); PG8_BAR;
    for (;;) {
        const bool has_next = S.next(ui + 1, nxt);
        if (has_next) { PG8_GOFF(vAn, nxt); }
        const char* nA = GATHER ? (const char*)g.A : (has_next ? (const char*)g.A + (size_t)nxt.pm * tstep : cA);
        const char* nB = has_next ? (const char*)g.Bt + (size_t)nxt.e * g.bstride + (size_t)nxt.pn * tstep : cB;
        for (int t = 0; t < nt; t += 2) {
            const bool last = (t == nt - 2);
            const char* a1 = cA + (size_t)(t + 1) * kstep;
            const char* a2 = last ? nA : cA + (size_t)(t + 2) * kstep; const char* b2 = last ? nB : cB + (size_t)(t + 2) * kstep;
            const char* a3 = a2 + kstep; const char* b3 = b2 + kstep;
            PG8_LDB(B0, 0, 0); PG8_LDB(B1, 0, 1); PG8_SCHED; PG8_LDA(At, 0, 0); PG8_STAGE_A(PG8_SA(1, 1), a1, 1, false);
            PG8_WAIT_V(8); PG8_WAIT_L(0); PG8_BAR; PG8_MMA(0, 0, At, B0); PG8_MMA(0, 1, At, B1); PG8_BAR; PG8_SCHED;
            PG8_LDA(At, 0, 1); PG8_STAGE(PG8_SB(0, 0), b2, voffB); PG8_STAGE(PG8_SB(0, 1), b2 + hstep, voffB); PG8_STAGE_A(PG8_SA(0, 0), a2, 0, last);
            PG8_WAIT_V(8); PG8_WAIT_L(0); PG8_BAR; PG8_MMA(1, 0, At, B0); PG8_MMA(1, 1, At, B1); PG8_BAR; PG8_SCHED;
            PG8_LDB(B0, 1, 0); PG8_LDB(B1, 1, 1); PG8_SCHED; PG8_LDA(At, 1, 0); PG8_STAGE_A(PG8_SA(0, 1), a2, 1, last);
            PG8_WAIT_V(8); PG8_WAIT_L(0); PG8_BAR; PG8_MMA(0, 0, At, B0); PG8_MMA(0, 1, At, B1); PG8_BAR; PG8_SCHED;
            PG8_LDA(At, 1, 1); PG8_STAGE(PG8_SB(1, 0), b3, voffB); PG8_STAGE(PG8_SB(1, 1), b3 + hstep, voffB); PG8_STAGE_A(PG8_SA(1, 0), a3, 0, last);
            PG8_WAIT_V(8); PG8_WAIT_L(0); PG8_BAR; PG8_MMA(1, 0, At, B0); PG8_MMA(1, 1, At, B1); PG8_BAR; PG8_SCHED;
        }
        if constexpr (ALIGN_EPI) { if (wr == 0) PG8_BAR; }
        E(acc, cur, wr, wc, fr, fq);
        if (!has_next) break;
#pragma unroll
        for (int a = 0; a < 2; ++a)
#pragma unroll
            for (int b = 0; b < 2; ++b)
#pragma unroll
                for (int m = 0; m < 4; ++m)
#pragma unroll
                    for (int n = 0; n < 2; ++n) acc[a][b][m][n] = (f32x4){0.f, 0.f, 0.f, 0.f};
        cur = nxt; cA = nA; cB = nB; ++ui;
#pragma unroll
        for (int _h = 0; _h < 2; ++_h)
#pragma unroll
            for (int _i = 0; _i < 2; ++_i) vAc[_h][_i] = vAn[_h][_i];
        if constexpr (ALIGN_EPI) { if (wr == 1) PG8_BAR; }
    }
    PG8_WAIT_V(0);
    if constexpr (!ALIGN_EPI) { if (wr == 0) PG8_BAR; }
    PG8_BAR;
#undef PG8_SA
#undef PG8_SB
#undef PG8_STAGE
#undef PG8_STAGE_A
#undef PG8_LDA
#undef PG8_LDB
#undef PG8_MMA
#undef PG8_LD8
#undef PG8_WAIT_V
#undef PG8_WAIT_L
#undef PG8_BAR
#undef PG8_SCHED
#undef PG8_GOFF
}

typedef const f32x4 (&AccRef)[2][2][4][2];

struct EpiZ {
    static constexpr bool PERM = true;
    bf16* Z; int ldc; const float* rs;
    __device__ __forceinline__ void operator()(AccRef acc, const Unit& u, int wr, int wc, int fr, int fq) const {
        const int row0 = u.pm * BM + wr * 64 + fr, col0 = u.pn * BM + wc * 32 + 8 * fq;
#pragma unroll
        for (int ai = 0; ai < 2; ++ai)
#pragma unroll
            for (int m = 0; m < 4; ++m) { const int r = row0 + ai * HALF + m * 16; const float s = rs[r]; bf16* rowp = Z + (size_t)r * ldc + col0;
#pragma unroll
                for (int bj = 0; bj < 2; ++bj) { const f32x4 v0 = acc[ai][bj][m][0] * s, v1 = acc[ai][bj][m][1] * s;
                    u32x4 w; w.x = pk2(v0[0], v0[1]); w.y = pk2(v0[2], v0[3]); w.z = pk2(v1[0], v1[1]); w.w = pk2(v1[2], v1[3]);
                    *(u32x4*)(rowp + bj * HALF) = w; } }
    }
};
struct EpiPe {
    static constexpr bool PERM = true;
    bf16* O; float* ssq;
    __device__ __forceinline__ void operator()(AccRef acc, const Unit& u, int wr, int wc, int fr, int fq) const {
        const int row0 = u.pm * BM + wr * 64 + fr, col0 = u.pn * BM + wc * 32 + 8 * fq;
#pragma unroll
        for (int ai = 0; ai < 2; ++ai)
#pragma unroll
            for (int m = 0; m < 4; ++m) { const int r = row0 + ai * HALF + m * 16; bf16* rowp = O + (size_t)r * DM + col0; float ss = 0.f;
#pragma unroll
                for (int bj = 0; bj < 2; ++bj) { const f32x4 v0 = acc[ai][bj][m][0], v1 = acc[ai][bj][m][1];
                    ss += (v0[0] * v0[0] + v0[1] * v0[1]) + (v0[2] * v0[2] + v0[3] * v0[3]) + (v1[0] * v1[0] + v1[1] * v1[1]) + (v1[2] * v1[2] + v1[3] * v1[3]);
                    u32x4 w; w.x = pk2(v0[0], v0[1]); w.y = pk2(v0[2], v0[3]); w.z = pk2(v1[0], v1[1]); w.w = pk2(v1[2], v1[3]);
                    *(u32x4*)(rowp + bj * HALF) = w; }
                ss += __shfl_xor(ss, 16); ss += __shfl_xor(ss, 32);
                if (fq == 0) ssq[(size_t)r * 32 + u.pn * 4 + wc] = ss; }
    }
};
struct EpiOut {
    static constexpr bool PERM = false;
    const float* X; float* H; float* ssq;
    __device__ __forceinline__ void operator()(AccRef acc, const Unit& u, int wr, int wc, int fr, int fq) const {
        const int row0 = u.pm * BM + wr * 64 + fr, col0 = u.pn * BM + wc * 32 + 4 * fq;
#pragma unroll
        for (int ai = 0; ai < 2; ++ai)
#pragma unroll
            for (int m2 = 0; m2 < 2; ++m2) { f32x4 xv[2][2][2];
#pragma unroll
                for (int mm = 0; mm < 2; ++mm) { const size_t off = (size_t)(row0 + ai * HALF + (2 * m2 + mm) * 16) * DM + col0;
#pragma unroll
                    for (int bj = 0; bj < 2; ++bj)
#pragma unroll
                        for (int n = 0; n < 2; ++n) xv[mm][bj][n] = *(const f32x4*)(X + off + bj * HALF + n * 16); }
                asm volatile("" ::: "memory");
#pragma unroll
                for (int mm = 0; mm < 2; ++mm) { const int m = 2 * m2 + mm, r = row0 + ai * HALF + m * 16; const size_t off = (size_t)r * DM + col0; float ss = 0.f;
#pragma unroll
                    for (int bj = 0; bj < 2; ++bj)
#pragma unroll
                        for (int n = 0; n < 2; ++n) { const f32x4 h = xv[mm][bj][n] + acc[ai][bj][m][n]; *(f32x4*)(H + off + bj * HALF + n * 16) = h; ss += (h[0] * h[0] + h[1] * h[1]) + (h[2] * h[2] + h[3] * h[3]); }
                    ss += __shfl_xor(ss, 16); ss += __shfl_xor(ss, 32);
                    if (fq == 0) ssq[(size_t)r * 32 + u.pn * 4 + wc] = ss; } }
    }
};
struct EpiMoe1 {
    static constexpr bool PERM = true;
    unsigned char* ACT; const float* bgu;
    __device__ __forceinline__ void operator()(AccRef acc, const Unit& u, int wr, int wc, int fr, int fq) const {
        const int row0 = u.pm * BM + wr * 64 + fr, j0 = u.pn * HALF + wc * 32 + 8 * fq;
        const float* bp = bgu + (size_t)u.e * 4096 + 2 * j0;
        const f32x4 b0 = *(const f32x4*)(bp), b1 = *(const f32x4*)(bp + 4), b2 = *(const f32x4*)(bp + 8), b3 = *(const f32x4*)(bp + 12);
        const float bg[8] = {b0[0], b0[2], b1[0], b1[2], b2[0], b2[2], b3[0], b3[2]}, bu[8] = {b0[1], b0[3], b1[1], b1[3], b2[1], b2[3], b3[1], b3[3]};
#pragma unroll
        for (int ai = 0; ai < 2; ++ai)
#pragma unroll
            for (int m = 0; m < 4; ++m) { const int r = row0 + ai * HALF + m * 16; float o[8];
#pragma unroll
                for (int n = 0; n < 2; ++n)
#pragma unroll
                    for (int q = 0; q < 4; ++q) { float gt = acc[ai][0][m][n][q] + bg[4 * n + q], up = acc[ai][1][m][n][q] + bu[4 * n + q];
                        gt = fminf(gt, 7.f); up = fminf(fmaxf(up, -7.f), 7.f); o[4 * n + q] = gt * sigm(1.702f * gt) * (up + 1.f) * ACT8_SCALE; }
                u32x2 w; w.x = pk4_fp8(o[0], o[1], o[2], o[3]); w.y = pk4_fp8(o[4], o[5], o[6], o[7]);
                *(u32x2*)(ACT + (size_t)r * DM + j0) = w; }
    }
};
struct EpiMoe2 {
    static constexpr bool PERM = true;
    unsigned char* YB; const float* bdn; const float* rowgate;
    __device__ __forceinline__ void operator()(AccRef acc, const Unit& u, int wr, int wc, int fr, int fq) const {
        const int row0 = u.pm * BM + wr * 64 + fr, col0 = u.pn * BM + wc * 32 + 8 * fq;
        const float* bp = bdn + (size_t)u.e * DM + col0;
        f32x4 bv[2][2];
#pragma unroll
        for (int bj = 0; bj < 2; ++bj)
#pragma unroll
            for (int n = 0; n < 2; ++n) bv[bj][n] = *(const f32x4*)(bp + bj * HALF + 4 * n);
#pragma unroll
        for (int ai = 0; ai < 2; ++ai)
#pragma unroll
            for (int m = 0; m < 4; ++m) { const int r = row0 + ai * HALF + m * 16; const float gt = rowgate[r] * YB8_SCALE; unsigned char* rowp = YB + (size_t)r * DM + col0;
#pragma unroll
                for (int bj = 0; bj < 2; ++bj) { const f32x4 v0 = (acc[ai][bj][m][0] + bv[bj][0]) * gt, v1 = (acc[ai][bj][m][1] + bv[bj][1]) * gt;
                    *(u32x2*)(rowp + bj * HALF) = (u32x2){pk4_fp8(v0[0], v0[1], v0[2], v0[3]), pk4_fp8(v1[0], v1[1], v1[2], v1[3])}; } }
    }
};
struct EpiPg {
    static constexpr bool PERM = true;
    const bf16* H2; const bf16* PE; const float* rs3; const float* rspe; const float* gpost; bf16* H3; float* ssq;
    __device__ __forceinline__ void operator()(AccRef acc, const Unit& u, int wr, int wc, int fr, int fq) const {
        const int row0 = u.pm * BM + wr * 64 + fr, col0 = u.pn * BM + wc * 32 + 8 * fq;
#pragma unroll
        for (int ai = 0; ai < 2; ++ai)
#pragma unroll
            for (int m = 0; m < 4; ++m) { const int r = row0 + ai * HALF + m * 16; const size_t off = (size_t)r * DM + col0; const float s3 = rs3[r], sp = rspe[r]; float ss = 0.f;
#pragma unroll
                for (int bj = 0; bj < 2; ++bj) { const size_t o = off + bj * HALF; const f32x4 gp0 = *(const f32x4*)(gpost + col0 + bj * HALF), gp1 = *(const f32x4*)(gpost + col0 + bj * HALF + 4);
                    const u32x4 pw = *(const u32x4*)(PE + o), hw = *(const u32x4*)(H2 + o); const f32x4 a0 = acc[ai][bj][m][0] * s3, a1 = acc[ai][bj][m][1] * s3;
                    float h[8];
                    h[0] = bflo(hw.x) + sigm(a0[0]) * (bflo(pw.x) * sp * gp0[0]); h[1] = bfhi(hw.x) + sigm(a0[1]) * (bfhi(pw.x) * sp * gp0[1]);
                    h[2] = bflo(hw.y) + sigm(a0[2]) * (bflo(pw.y) * sp * gp0[2]); h[3] = bfhi(hw.y) + sigm(a0[3]) * (bfhi(pw.y) * sp * gp0[3]);
                    h[4] = bflo(hw.z) + sigm(a1[0]) * (bflo(pw.z) * sp * gp1[0]); h[5] = bfhi(hw.z) + sigm(a1[1]) * (bfhi(pw.z) * sp * gp1[1]);
                    h[6] = bflo(hw.w) + sigm(a1[2]) * (bflo(pw.w) * sp * gp1[2]); h[7] = bfhi(hw.w) + sigm(a1[3]) * (bfhi(pw.w) * sp * gp1[3]);
                    *(u32x4*)(H3 + o) = (u32x4){pk2(h[0], h[1]), pk2(h[2], h[3]), pk2(h[4], h[5]), pk2(h[6], h[7])};
                    ss += ((h[0] * h[0] + h[1] * h[1]) + (h[2] * h[2] + h[3] * h[3])) + ((h[4] * h[4] + h[5] * h[5]) + (h[6] * h[6] + h[7] * h[7])); }
                ss += __shfl_xor(ss, 16); ss += __shfl_xor(ss, 32);
                if (fq == 0) ssq[(size_t)r * 32 + u.pn * 4 + wc] = ss; }
    }
};
}

__device__ __forceinline__ bf16x8 frag(const LAS bf16* base, int row0, int ld, int k0, int lane) {
    return *(const LAS bf16x8*)(base + (row0 + (lane & 15)) * ld + k0 + 8 * (lane >> 4));
}
#define MMA16(a, b, c) __builtin_amdgcn_mfma_f32_16x16x32_bf16(a, b, c, 0, 0, 0)

struct Args { const float* in[24]; float* out; unsigned char* ws; int ph_lo, ph_hi, aux, pad; };
__device__ __forceinline__ const float* argin(const Args& a, int k) { asm volatile("" : "+s"(k)); return a.in[k]; }

__device__ __forceinline__ void tr_tile(const float* W, int ldn, int c0, int k0, const float* g, bf16* WT, int K, int d0, int mode, int lane) {
    const int kk = lane >> 4, n4 = lane & 15;
    const float* src = W + (size_t)(k0 + 16 * kk) * ldn + c0 + 4 * n4;
    f32x4 v[16];
#pragma unroll
    for (int i = 0; i < 16; ++i) v[i] = __builtin_nontemporal_load((const f32x4*)(src + (size_t)i * ldn));
    if (g) { const f32x4* gp = (const f32x4*)(g + k0 + 16 * kk);
#pragma unroll
        for (int i4 = 0; i4 < 4; ++i4) { const f32x4 gv = gp[i4];
#pragma unroll
            for (int e = 0; e < 4; ++e) v[4 * i4 + e] = v[4 * i4 + e] * gv[e]; } }
#pragma unroll
    for (int q = 0; q < 4; ++q) { const int j = 4 * n4 + q; int dr; if (mode == 0) dr = d0 + j; else { const int jj = (c0 + j) >> 1; dr = 256 * (jj >> 7) + (jj & 127) + 128 * (j & 1); }
        u32x4 o0, o1;
        o0.x = pk2(v[0][q], v[1][q]); o0.y = pk2(v[2][q], v[3][q]); o0.z = pk2(v[4][q], v[5][q]); o0.w = pk2(v[6][q], v[7][q]);
        o1.x = pk2(v[8][q], v[9][q]); o1.y = pk2(v[10][q], v[11][q]); o1.z = pk2(v[12][q], v[13][q]); o1.w = pk2(v[14][q], v[15][q]);
        bf16* dst = WT + (size_t)dr * K + k0 + 16 * kk; *(u32x4*)dst = o0; *(u32x4*)(dst + 8) = o1; }
}
__device__ __forceinline__ int win_src_col(int n) { return n < 3072 ? n : (n < 6144 ? n + 16 : n + 24); }

__device__ __forceinline__ void p0_weights(const Args& a, int gw, int NGW, int lane) {
    unsigned char* ws = a.ws;
    constexpr int I_WIN = 112 * 32, I_WPP = 32 * 4, I_WOUT = 32 * 32;
    for (int it = gw; it < I_WIN + I_WPP + I_WOUT; it += NGW) {
        int r = it;
        if (r >= I_WIN + I_WPP) { r -= I_WIN + I_WPP; const int kb = r >> 5, nb = r & 31; tr_tile(argin(a, 11), DM, 64 * nb, 64 * kb, nullptr, (bf16*)(ws + WS_WOUT), DM, 64 * nb, 0, lane); continue; }
        if (r < I_WIN) { const int kb = r / 112, nb = r - kb * 112; tr_tile(argin(a, 3), DIN, win_src_col(64 * nb), 64 * kb, argin(a, 2), (bf16*)(ws + WS_WIN), DM, 64 * nb, 0, lane); continue; } r -= I_WIN;
        { const int kb = r >> 5, nb = r & 31; tr_tile(argin(a, 21), DM, 64 * nb, 64 * kb, nullptr, (bf16*)(ws + WS_WPP), PLE, 64 * nb, 0, lane); }
    }
}
constexpr int POOL_WGU = 32 * 16 * 16, POOL_WDN = 32 * 16 * 8, POOL_WPG = 16 * 8, NPOOL = POOL_WGU + POOL_WDN + POOL_WPG;
struct PoolTile { const float* W; const float* g; unsigned char* WT; int ldn, c0, k0, d0, mode; };
__device__ __forceinline__ void pool_tile_desc(const Args& a, int r, PoolTile& t) {
    unsigned char* ws = a.ws;
    if (r < POOL_WGU) { const int e = r >> 8, kb = (r >> 4) & 15, nb = r & 15; t.W = argin(a, 15) + (size_t)e * DM * 4096; t.g = argin(a, 12); t.WT = ws + WS_WGU + (size_t)e * 4096 * DM; t.ldn = 4096; t.c0 = 256 * nb; t.k0 = 128 * kb; t.d0 = 0; t.mode = 1; return; } r -= POOL_WGU;
    if (r < POOL_WDN) { const int e = r >> 7, kb = (r >> 3) & 15, nb = r & 7; t.W = argin(a, 17) + (size_t)e * DM * DM; t.g = nullptr; t.WT = ws + WS_WDN + (size_t)e * DM * DM; t.ldn = DM; t.c0 = 256 * nb; t.k0 = 128 * kb; t.d0 = 256 * nb; t.mode = 0; return; } r -= POOL_WDN;
    { const int kb = r >> 3, nb = r & 7; t.W = argin(a, 20); t.g = argin(a, 19); t.WT = ws + WS_WPG; t.ldn = DM; t.c0 = 256 * nb; t.k0 = 128 * kb; t.d0 = 256 * nb; t.mode = 0; }
}
#define POOL_LOAD(t, v) do { const float* _src = (t).W + (size_t)((t).k0 + 16 * wid) * (t).ldn + (t).c0 + 4 * lane; _Pragma("unroll") for (int _i = 0; _i < 16; ++_i) (v)[_i] = __builtin_nontemporal_load((const f32x4*)(_src + (size_t)_i * (t).ldn)); } while (0)
__device__ __forceinline__ void convert_pool(const Args& a, LAS unsigned char* lds, int tid, int wid, int lane) {
    unsigned* ctr = (unsigned*)(a.ws + WS_CTL) + CW_POOL + (a.aux == 6 ? 64 : 0);
    LAS unsigned char* T = lds;
    LAS int* nxt = (LAS int*)(lds + 40960);
    f32x4 v[16]; PoolTile cur, nx; int have;
    if (tid == 0) nxt[0] = (int)__hip_atomic_fetch_add(ctr, 1u, __ATOMIC_RELAXED, __HIP_MEMORY_SCOPE_AGENT);
    __syncthreads();
    int r = __builtin_amdgcn_readfirstlane(nxt[0]); have = r < NPOOL;
    if (have) { pool_tile_desc(a, r, cur); POOL_LOAD(cur, v); }
    int slot = 1;
    while (have) {
        if (tid == 0) nxt[slot] = (int)__hip_atomic_fetch_add(ctr, 1u, __ATOMIC_RELAXED, __HIP_MEMORY_SCOPE_AGENT);
        { f32x4 gs[4];
#pragma unroll
          for (int i4 = 0; i4 < 4; ++i4) gs[i4] = cur.g ? *(const f32x4*)(cur.g + cur.k0 + 16 * wid + 4 * i4) * W8_SCALE : (f32x4){W8_SCALE, W8_SCALE, W8_SCALE, W8_SCALE};
#pragma unroll
          for (int i = 0; i < 16; ++i) v[i] = v[i] * gs[i >> 2][i & 3];
#pragma unroll
          for (int q = 0; q < 4; ++q) { u32x4 o;
              o.x = pk4_fp8(v[0][q], v[1][q], v[2][q], v[3][q]); o.y = pk4_fp8(v[4][q], v[5][q], v[6][q], v[7][q]); o.z = pk4_fp8(v[8][q], v[9][q], v[10][q], v[11][q]); o.w = pk4_fp8(v[12][q], v[13][q], v[14][q], v[15][q]);
              *(LAS u32x4*)(T + (4 * lane + q) * 128 + ((wid ^ (lane & 7)) << 4)) = o; } }
        __syncthreads();
        const int rn = __builtin_amdgcn_readfirstlane(nxt[slot]); const int have_n = rn < NPOOL;
        if (have_n) { pool_tile_desc(a, rn, nx); POOL_LOAD(nx, v); }
#pragma unroll
        for (int it = 0; it < 4; ++it) { const int row = 32 * wid + 8 * it + (lane >> 3), c = lane & 7;
            const u32x4 o = *(const LAS u32x4*)(T + row * 128 + ((c ^ ((row >> 2) & 7)) << 4));
            int dr; if (cur.mode == 0) dr = cur.d0 + row; else { const int jj = (cur.c0 + row) >> 1; dr = 256 * (jj >> 7) + (jj & 127) + 128 * (row & 1); }
            __builtin_nontemporal_store(o, (u32x4*)(cur.WT + (size_t)dr * DM + cur.k0 + 16 * c)); }
        __syncthreads();
        cur = nx; have = have_n; slot ^= 1;
    }
}
#undef POOL_LOAD

template <class Side>
__device__ __forceinline__ void skinny_mfma(const float* A, const bf16* Whi, const bf16* Wlo, LAS float* red, LAS float* Ls, int tid, int wid, int lane, const Side& side) {
    const int g4 = lane >> 4, c15 = lane & 15;
    f32x4 acc[4][2];
#pragma unroll
    for (int rt = 0; rt < 4; ++rt) { acc[rt][0] = (f32x4){0.f, 0.f, 0.f, 0.f}; acc[rt][1] = (f32x4){0.f, 0.f, 0.f, 0.f}; }
    const float* ap = A + (size_t)c15 * DM + 256 * wid + 8 * g4;
    const bf16* bh = Whi + (size_t)c15 * DM + 256 * wid + 8 * g4; const bf16* bl = Wlo + (size_t)c15 * DM + 256 * wid + 8 * g4;
    f32x4 av[2][4][2]; u32x4 bv[2][2][2];
#define SK_LOAD(buf, ks) do { _Pragma("unroll") for (int rt = 0; rt < 4; ++rt) { av[buf][rt][0] = *(const f32x4*)(ap + (size_t)(16 * rt) * DM + 32 * (ks)); av[buf][rt][1] = *(const f32x4*)(ap + (size_t)(16 * rt) * DM + 32 * (ks) + 4); } \
        _Pragma("unroll") for (int ct = 0; ct < 2; ++ct) { bv[buf][ct][0] = *(const u32x4*)(bh + (size_t)(16 * ct) * DM + 32 * (ks)); bv[buf][ct][1] = *(const u32x4*)(bl + (size_t)(16 * ct) * DM + 32 * (ks)); } } while (0)
    SK_LOAD(0, 0);
#pragma unroll
    for (int ks = 0; ks < 8; ++ks) { const int cb = ks & 1;
        if (ks < 7) SK_LOAD(cb ^ 1, ks + 1);
#pragma unroll
        for (int rt = 0; rt < 4; ++rt) { const f32x4 v0 = av[cb][rt][0], v1 = av[cb][rt][1];
            side(rt, 256 * wid + 32 * ks + 8 * g4, v0, v1);
            u32x4 hi, lo; hi.x = pk2(v0[0], v0[1]); hi.y = pk2(v0[2], v0[3]); hi.z = pk2(v1[0], v1[1]); hi.w = pk2(v1[2], v1[3]);
            lo.x = pk2(v0[0] - bflo(hi.x), v0[1] - bfhi(hi.x)); lo.y = pk2(v0[2] - bflo(hi.y), v0[3] - bfhi(hi.y)); lo.z = pk2(v1[0] - bflo(hi.z), v1[1] - bfhi(hi.z)); lo.w = pk2(v1[2] - bflo(hi.w), v1[3] - bfhi(hi.w));
            const bf16x8 ah = __builtin_bit_cast(bf16x8, hi), al = __builtin_bit_cast(bf16x8, lo);
#pragma unroll
            for (int ct = 0; ct < 2; ++ct) { const bf16x8 wh = __builtin_bit_cast(bf16x8, bv[cb][ct][0]), wl = __builtin_bit_cast(bf16x8, bv[cb][ct][1]);
                acc[rt][ct] = MMA16(ah, wh, acc[rt][ct]); acc[rt][ct] = MMA16(al, wh, acc[rt][ct]); acc[rt][ct] = MMA16(ah, wl, acc[rt][ct]); } } }
#undef SK_LOAD
#pragma unroll
    for (int rt = 0; rt < 4; ++rt)
#pragma unroll
        for (int ct = 0; ct < 2; ++ct)
#pragma unroll
            for (int rg = 0; rg < 4; ++rg) red[(wid * 64 + 16 * rt + 4 * g4 + rg) * 33 + 16 * ct + c15] = acc[rt][ct][rg];
    __syncthreads();
    { const int row = tid >> 3, n4 = (tid & 7) * 4;
#pragma unroll
      for (int q = 0; q < 4; ++q) { float s = 0.f;
#pragma unroll
          for (int w = 0; w < 8; ++w) s += red[(w * 64 + row) * 33 + n4 + q];
          Ls[row * 33 + n4 + q] = s; } }
    __syncthreads();
}

__device__ __forceinline__ void xgate_unit(const Args& a, int u, LAS unsigned char* lds, int tid, int wid, int lane) {
    asm volatile("" : "+v"(tid), "+v"(lane));
    unsigned char* sm = a.ws + WS_SMALL;
    LAS float* red = (LAS float*)lds; LAS float* Gs = (LAS float*)(lds + 67584); LAS float* gl = (LAS float*)(lds + 67584 + 8448); LAS float* il = gl + 64 * 12;
    const int t0 = u * 64;
    skinny_mfma(argin(a, 0) + (size_t)t0 * DM, (const bf16*)(a.ws + WS_WSK), (const bf16*)(a.ws + WS_WSK) + 32 * DM, red, Gs, tid, wid, lane, [](int, int, const f32x4&, const f32x4&) {});
    if (tid < 64) { const int l = tid, t = t0 + l; float* BETA = (float*)(sm + SM_BETA); float* IC = (float*)(sm + SM_IC); const float rs = ((const float*)(sm + SM_RS1))[t];
        const float* a_log = argin(a, 5); const float* dt_b = argin(a, 6); const float* b_i = argin(a, 8); const float* b_f = argin(a, 9);
        for (int h = 0; h < 8; ++h) { const float av = Gs[l * 33 + h] * rs; gl[l * 12 + h] = -expf(a_log[h]) * softplusf(av + dt_b[h]); BETA[t * 8 + h] = 1.f / (1.f + expf(-Gs[l * 33 + 8 + h] * rs)); }
        for (int h = 0; h < 4; ++h) { const float ip = 15.f * tanhf((Gs[l * 33 + 16 + h] * rs + b_i[h]) * (1.f / 15.f)); il[l * 4 + h] = ip; IC[t * 4 + h] = ip;
            const float fp = 15.f * tanhf((Gs[l * 33 + 20 + h] * rs + b_f[h]) * (1.f / 15.f)); gl[l * 12 + 8 + h] = -softplusf(-fp); } }
    __syncthreads();
    {
        float* GC = (float*)(sm + SM_GC); float* FC = (float*)(sm + SM_FC);
        for (int j = wid; j < 12; j += 8) { float v = gl[lane * 12 + j];
#pragma unroll
            for (int off = 1; off < 64; off <<= 1) { const float vp = __shfl_up(v, off); if (lane >= off) v += vp; }
            if (j < 8) GC[(t0 + lane) * 8 + j] = v; else { const int h = j - 8; FC[(t0 + lane) * 4 + h] = v; const float tot = __shfl(v, 63); float am = tot - v + il[lane * 4 + h];
#pragma unroll
                for (int off = 1; off < 64; off <<= 1) am = fmaxf(am, __shfl_xor(am, off));
                if (lane == 0) { ((float*)(sm + SM_FLAST))[u * 4 + h] = tot; ((float*)(sm + SM_AMAX))[u * 4 + h] = am; } } }
    }
    __syncthreads();
}

__device__ __forceinline__ int tsw(int row, int l, int sh) { return row * 72 + ((((l >> 3) ^ (row >> sh)) & 7) << 3) + (l & 7); }
__device__ __forceinline__ bf16x8 fragsw(const LAS bf16* base, int rt  , int ks, int lane, int sh) {
    return *(const LAS bf16x8*)(base + (16 * rt + (lane & 15)) * 72 + ((((4 * ks + (lane >> 4)) ^ ((16 * rt) >> sh)) & 7) << 3));
}
#define MMA4F(a, b, c) __builtin_amdgcn_mfma_f32_16x16x4f32(a, b, c, 0, 0, 0)

struct GdnPre { u32x4 z[3]; f32x4 cw; };
#define GDN_ZLOAD(ugx, tz, R) do { const int _b = (ugx) >> 9, _h = ((ugx) >> 6) & 7, _c = (ugx) & 63; const bf16* _zb = (const bf16*)(a.ws + WS_Z) + ((long)(_b * SEQL + _c * 64 - 3)) * NZ + (tz) * 1024 + _h * 128 + (tid & 15) * 8; \
        _Pragma("unroll") for (int _k = 0; _k < 3; ++_k) { const int _r = (tid >> 4) + 32 * _k; const bool _ok = (_k < 2 || tid < 48) && (_c * 64 - 3 + _r >= 0); \
            (R)[_k] = _ok ? *(const u32x4*)(_zb + (long)_r * NZ) : (u32x4){0u, 0u, 0u, 0u}; } } while (0)
#define GDN_ZPUT(R, ZSx) do { *(LAS u32x4*)((ZSx) + ((tid >> 4)) * 136 + (tid & 15) * 8) = (R)[0]; *(LAS u32x4*)((ZSx) + ((tid >> 4) + 32) * 136 + (tid & 15) * 8) = (R)[1]; \
        if (tid < 48) *(LAS u32x4*)((ZSx) + ((tid >> 4) + 64) * 136 + (tid & 15) * 8) = (R)[2]; } while (0)
#define GDN_CWLOAD(ugx, dst) do { if (tid < 384) { const int _h = ((ugx) >> 6) & 7, _tj = tid >> 5; (dst) = *(const f32x4*)(argin(a, 4) + (_tj & 3) * 3072 + (_tj >> 2) * 1024 + _h * 128 + (tid & 31) * 4); } } while (0)
#define GDN_CONV(tz, ZSx, out) do { _Pragma("unroll") for (int _i = 0; _i < 16; ++_i) (out)[_i] = 0.f; \
        _Pragma("unroll") for (int _j = 0; _j < 4; ++_j) { const LAS bf16* _zr = (ZSx) + (l + _j) * 136 + cg * 16; const u32x4 _w0 = *(const LAS u32x4*)_zr, _w1 = *(const LAS u32x4*)(_zr + 8); \
            const LAS float* _cw = CWs + ((tz) * 4 + _j) * 128 + cg * 16; const f32x4 _c0 = *(const LAS f32x4*)_cw, _c1 = *(const LAS f32x4*)(_cw + 4), _c2 = *(const LAS f32x4*)(_cw + 8), _c3 = *(const LAS f32x4*)(_cw + 12); \
            (out)[0] += _c0[0] * bflo(_w0.x); (out)[1] += _c0[1] * bfhi(_w0.x); (out)[2] += _c0[2] * bflo(_w0.y); (out)[3] += _c0[3] * bfhi(_w0.y); \
            (out)[4] += _c1[0] * bflo(_w0.z); (out)[5] += _c1[1] * bfhi(_w0.z); (out)[6] += _c1[2] * bflo(_w0.w); (out)[7] += _c1[3] * bfhi(_w0.w); \
            (out)[8] += _c2[0] * bflo(_w1.x); (out)[9] += _c2[1] * bfhi(_w1.x); (out)[10] += _c2[2] * bflo(_w1.y); (out)[11] += _c2[3] * bfhi(_w1.y); \
            (out)[12] += _c3[0] * bflo(_w1.z); (out)[13] += _c3[1] * bfhi(_w1.z); (out)[14] += _c3[2] * bflo(_w1.w); (out)[15] += _c3[3] * bfhi(_w1.w); } \
        _Pragma("unroll") for (int _i = 0; _i < 16; ++_i) { const float _v = (out)[_i]; (out)[_i] = _v * __builtin_amdgcn_rcpf(1.f + __expf(-_v)); } } while (0)

__device__ __forceinline__ void gdn_prep_unit(const Args& a, int ug, int ug_next, GdnPre& pre, LAS unsigned char* lds, int tid, int wid, int lane) {
    asm volatile("" : "+v"(tid), "+v"(lane));
    unsigned char* ws = a.ws; unsigned char* sm = ws + WS_SMALL;
    LAS bf16* KDt = (LAS bf16*)lds; LAS bf16* KBGt = (LAS bf16*)(lds + 18432); LAS bf16* VBt = (LAS bf16*)(lds + 36864); LAS bf16* Qs = (LAS bf16*)(lds + 55296); LAS bf16* Ks = (LAS bf16*)(lds + 72704);
    LAS bf16* GTt = (LAS bf16*)(lds + 55296); LAS bf16* Ti = (LAS bf16*)(lds + 73728); LAS bf16* TiT = (LAS bf16*)(lds + 82944);
    LAS float* Mm = (LAS float*)(lds + 92160); LAS float* TT = (LAS float*)(lds + 109568); LAS float* Td = (LAS float*)(lds + 126976); LAS float* gcs = (LAS float*)(lds + 134752); LAS float* bts = (LAS float*)(lds + 135008);
    LAS bf16* ZS0 = (LAS bf16*)(lds + 92160); LAS bf16* ZS1 = (LAS bf16*)(lds + 110384); LAS float* CWs = (LAS float*)(lds + 128608);
    const int b = ug >> 9, h = (ug >> 6) & 7, c = ug & 63, t0 = b * SEQL + c * 64;
    const int l = tid >> 3, cg = tid & 7, g4 = lane >> 4, c15 = lane & 15;
    const float gcl = ((const float*)(sm + SM_GC))[(t0 + l) * 8 + h], btl = ((const float*)(sm + SM_BETA))[(t0 + l) * 8 + h], gclast = ((const float*)(sm + SM_GC))[(t0 + 63) * 8 + h];
    {
        float qv[16], kv[16], vv[16]; u32x4 R[3];
        GDN_ZPUT(pre.z, ZS0); if (tid < 384) *(LAS f32x4*)(CWs + 4 * tid) = pre.cw;
        GDN_ZLOAD(ug, 1, R);
        __syncthreads();
        GDN_CONV(0, ZS0, qv);
        GDN_ZPUT(R, ZS1); GDN_ZLOAD(ug, 2, R);
        __syncthreads();
        GDN_CONV(1, ZS1, kv);
        GDN_ZPUT(R, ZS0);
        if (ug_next >= 0) { GDN_ZLOAD(ug_next, 0, pre.z); GDN_CWLOAD(ug_next, pre.cw); }
        __syncthreads();
        GDN_CONV(2, ZS0, vv);
        float sq = 0.f, sk = 0.f;
#pragma unroll
        for (int i = 0; i < 16; ++i) { sq += qv[i] * qv[i]; sk += kv[i] * kv[i]; }
#pragma unroll
        for (int o = 1; o < 8; o <<= 1) { sq += __shfl_xor(sq, o); sk += __shfl_xor(sk, o); }
        const float rq = rsqrtf(sq + EPS) * 0.08838834764831845f, rk = rsqrtf(sk + EPS);
        const float eg = expf(gcl), ekd = expf(gclast - gcl);
        unsigned qw[8], kw[8], qdw[8];
#pragma unroll
        for (int i = 0; i < 8; ++i) { const float q0 = qv[2 * i] * rq, q1 = qv[2 * i + 1] * rq, k0 = kv[2 * i] * rk, k1 = kv[2 * i + 1] * rk;
            qw[i] = pk2(q0, q1); kw[i] = pk2(k0, k1); qdw[i] = pk2(q0 * eg, q1 * eg);
            const int d = cg * 16 + 2 * i;
            KBGt[tsw(d, l, 4)] = f2bf(k0 * btl * eg); KBGt[tsw(d + 1, l, 4)] = f2bf(k1 * btl * eg);
            KDt[tsw(d, l, 4)] = f2bf(k0 * ekd); KDt[tsw(d + 1, l, 4)] = f2bf(k1 * ekd);
            VBt[tsw(d, l, 4)] = f2bf(vv[2 * i] * btl); VBt[tsw(d + 1, l, 4)] = f2bf(vv[2 * i + 1] * btl); }
        *(LAS u32x4*)(Qs + l * 136 + cg * 16) = (u32x4){qw[0], qw[1], qw[2], qw[3]}; *(LAS u32x4*)(Qs + l * 136 + cg * 16 + 8) = (u32x4){qw[4], qw[5], qw[6], qw[7]};
        *(LAS u32x4*)(Ks + l * 136 + cg * 16) = (u32x4){kw[0], kw[1], kw[2], kw[3]}; *(LAS u32x4*)(Ks + l * 136 + cg * 16 + 8) = (u32x4){kw[4], kw[5], kw[6], kw[7]};
        bf16* qd = (bf16*)(ws + WS_GQD) + (size_t)ug * 8192 + l * 128 + cg * 16;
        *(u32x4*)qd = (u32x4){qdw[0], qdw[1], qdw[2], qdw[3]}; *(u32x4*)(qd + 8) = (u32x4){qdw[4], qdw[5], qdw[6], qdw[7]};
        if (cg == 0) { gcs[l] = gcl; bts[l] = btl; }
    }
    __syncthreads();
    {
        const int wv = wid & 3; const bool isQ = wid >= 4; const LAS bf16* Ab = isQ ? Qs : Ks;
        f32x4 acc[4];
#pragma unroll
        for (int n = 0; n < 4; ++n) acc[n] = (f32x4){0.f, 0.f, 0.f, 0.f};
#pragma unroll
        for (int ks = 0; ks < 4; ++ks) { const bf16x8 af = frag(Ab, 16 * wv, 136, 32 * ks, lane);
#pragma unroll
            for (int n = 0; n < 4; ++n) acc[n] = MMA16(af, frag(Ks, 16 * n, 136, 32 * ks, lane), acc[n]); }
        bf16* AT = (bf16*)(ws + WS_GAT) + (size_t)ug * 4096;
#pragma unroll
        for (int n = 0; n < 4; ++n)
#pragma unroll
            for (int rg = 0; rg < 4; ++rg) { const int i = 16 * wv + 4 * g4 + rg, j = 16 * n + c15;
                const float dec = (j <= i) ? __expf(gcs[i] - gcs[j]) : 0.f;
                if (!isQ) Mm[i * 68 + j] = (j < i) ? bts[i] * acc[n][rg] * dec : 0.f;
                else AT[i * 64 + j] = f2bf(acc[n][rg] * dec); }
    }
    __syncthreads();
    if (wid == 0) {
        const int blk = g4;
        unsigned mb = (unsigned)(size_t)(Mm + (16 * blk) * 68 + 16 * blk), ml = mb + 4u * (unsigned)c15;
        asm volatile("" : "+v"(mb), "+v"(ml));
        float X[16];
#pragma unroll
        for (int i = 0; i < 16; ++i) { float s = -*(const LAS float*)(size_t)(ml + (unsigned)(i * 68 * 4));
#pragma unroll
            for (int j4 = 0; j4 < (i + 3) / 4; ++j4) { const f32x4 mv = *(const LAS f32x4*)(size_t)(mb + (unsigned)((i * 68 + 4 * j4) * 4));
#pragma unroll
                for (int q = 0; q < 4; ++q) if (4 * j4 + q < i) s -= mv[q] * X[4 * j4 + q]; }
            X[i] = s; }
        const float cf = (float)c15;
#pragma unroll
        for (int i = 0; i < 16; ++i) { X[i] += fmaxf(0.f, 1.f - fabsf(cf - (float)i)); Td[(blk * 16 + i) * 20 + c15] = X[i]; Ti[(16 * blk + i) * 72 + 16 * blk + c15] = f2bf(X[i]); }
        LAS float* ttp = TT + (16 * blk + c15) * 68 + 16 * blk; LAS bf16* tip = TiT + (16 * blk + c15) * 72 + 16 * blk;
#pragma unroll
        for (int i4 = 0; i4 < 4; ++i4) *(LAS f32x4*)(ttp + 4 * i4) = (f32x4){X[4 * i4], X[4 * i4 + 1], X[4 * i4 + 2], X[4 * i4 + 3]};
        *(LAS u32x4*)tip = (u32x4){pk2(X[0], X[1]), pk2(X[2], X[3]), pk2(X[4], X[5]), pk2(X[6], X[7])}; *(LAS u32x4*)(tip + 8) = (u32x4){pk2(X[8], X[9]), pk2(X[10], X[11]), pk2(X[12], X[13]), pk2(X[14], X[15])};
    } else if (wid >= 4) {
        for (int p = tid - 256; p < 384; p += 256) { const int arr = p / 192, q = p - arr * 192, bi6 = q >> 5, r = (q & 31) >> 1, hf = q & 1;
            const int bi = bi6 < 3 ? 0 : (bi6 < 5 ? 1 : 2), bj = bi6 < 3 ? bi6 + 1 : (bi6 < 5 ? bi6 - 1 : 3);
            if (arr) *(LAS u32x4*)(TiT + (16 * bj + r) * 72 + 16 * bi + 8 * hf) = (u32x4){0u, 0u, 0u, 0u};
            else *(LAS u32x4*)(Ti + (16 * bi + r) * 72 + 16 * bj + 8 * hf) = (u32x4){0u, 0u, 0u, 0u}; }
    }
    __syncthreads();
#pragma unroll
    for (int dg = 1; dg < 4; ++dg) {
        if (wid < 4 - dg) { const int bi = wid + dg, bj = wid;
            f32x4 P = (f32x4){0.f, 0.f, 0.f, 0.f};
            for (int k = bj; k < bi; ++k) { const f32x4 a4 = *(const LAS f32x4*)(Mm + (16 * bi + c15) * 68 + 16 * k + 4 * g4), b4 = *(const LAS f32x4*)(TT + (16 * bj + c15) * 68 + 16 * k + 4 * g4);
#pragma unroll
                for (int s = 0; s < 4; ++s) P = MMA4F(a4[s], b4[s], P); }
            const f32x4 t4 = *(const LAS f32x4*)(Td + (bi * 16 + c15) * 20 + 4 * g4);
            f32x4 Q = (f32x4){0.f, 0.f, 0.f, 0.f};
#pragma unroll
            for (int s = 0; s < 4; ++s) Q = MMA4F(t4[s], P[s], Q);
            Q = -Q;
            *(LAS f32x4*)(TT + (16 * bj + c15) * 68 + 16 * bi + 4 * g4) = Q;
            *(LAS u32x2*)(TiT + (16 * bj + c15) * 72 + 16 * bi + 4 * g4) = (u32x2){pk2(Q[0], Q[1]), pk2(Q[2], Q[3])};
#pragma unroll
            for (int rg = 0; rg < 4; ++rg) Ti[(16 * bi + 4 * g4 + rg) * 72 + 16 * bj + c15] = f2bf(Q[rg]);
        }
        __syncthreads();
    }
    {
        const int wv = wid & 3; const LAS bf16* Bb = wid < 4 ? VBt : KBGt; bf16* OUT = (bf16*)(ws + (wid < 4 ? WS_GU : WS_GW)) + (size_t)ug * 8192;
#pragma unroll
        for (int e2 = 0; e2 < 2; ++e2) { const int en = 2 * wv + e2; f32x4 acc[4];
#pragma unroll
            for (int it = 0; it < 4; ++it) acc[it] = (f32x4){0.f, 0.f, 0.f, 0.f};
#pragma unroll
            for (int ks = 0; ks < 2; ++ks) { const bf16x8 af = fragsw(Bb, en, ks, lane, 4);
#pragma unroll
                for (int it = 0; it < 4; ++it) acc[it] = MMA16(af, frag(Ti, 16 * it, 72, 32 * ks, lane), acc[it]); }
#pragma unroll
            for (int it = 0; it < 4; ++it) { const u32x2 pv = (u32x2){pk2(acc[it][0], acc[it][1]), pk2(acc[it][2], acc[it][3])};
                *(u32x2*)(OUT + (((en * 4 + it) * 64) + lane) * 4) = pv; } }
    }
    {
        const int mt = wid & 3;
#pragma unroll
        for (int d4 = 0; d4 < 4; ++d4) { const int dn = (wid >> 2) * 4 + d4; f32x4 acc = (f32x4){0.f, 0.f, 0.f, 0.f};
#pragma unroll
            for (int ks = 0; ks < 2; ++ks) acc = MMA16(frag(TiT, 16 * mt, 72, 32 * ks, lane), fragsw(KDt, dn, ks, lane, 4), acc);
            *(LAS u32x2*)(GTt + (16 * dn + c15) * 72 + 16 * mt + 4 * g4) = (u32x2){pk2(acc[0], acc[1]), pk2(acc[2], acc[3])}; }
        if (tid == 0) ((float*)(sm + SM_GLAST))[ug] = expf(gcs[63]);
    }
    __syncthreads();
    {
        bf16* AP = (bf16*)(ws + WS_GAP) + (size_t)ug * 16384; bf16* BB = (bf16*)(ws + WS_GBB) + (size_t)ug * 16384;
        bf16x8 kf[2], gf[2];
#pragma unroll
        for (int ks = 0; ks < 2; ++ks) { kf[ks] = fragsw(KBGt, wid, ks, lane, 4); gf[ks] = frag(GTt, 16 * wid, 72, 32 * ks, lane); }
#pragma unroll
        for (int n = 0; n < 8; ++n) { f32x4 a1 = (f32x4){0.f, 0.f, 0.f, 0.f}, b1 = (f32x4){0.f, 0.f, 0.f, 0.f};
#pragma unroll
            for (int ks = 0; ks < 2; ++ks) { a1 = MMA16(kf[ks], frag(GTt, 16 * n, 72, 32 * ks, lane), a1); b1 = MMA16(gf[ks], fragsw(VBt, n, ks, lane, 4), b1); }
            *(u32x2*)(AP + (((n * 4 + (wid >> 1)) * 64) + ((2 * wid + (g4 >> 1)) & 3) * 16 + c15) * 8 + 4 * (g4 & 1)) = (u32x2){pk2(-a1[0], -a1[1]), pk2(-a1[2], -a1[3])};
            *(u32x2*)(BB + (((((n >> 1) * 8 + wid) * 2 + (n & 1)) * 64) + lane) * 4) = (u32x2){pk2(b1[0], b1[1]), pk2(b1[2], b1[3])}; }
    }
    __syncthreads();
}

struct MlPre { u32x4 q0, q1, k0, k1, v[4]; float fl, am, fc, ic; };
#define ML_PREP_LOAD(umx, P) do { const int _b = (umx) >> 8, _h = ((umx) >> 6) & 3, _c = (umx) & 63, _t0 = _b * SEQL + _c * 64; const bf16* _zr = (const bf16*)(a.ws + WS_Z) + (size_t)(_t0 + (tid >> 3)) * NZ; const int _cg = tid & 7; \
        (P).q0 = *(const u32x4*)(_zr + ZMQ + _h * 128 + _cg * 16); (P).q1 = *(const u32x4*)(_zr + ZMQ + _h * 128 + _cg * 16 + 8); (P).k0 = *(const u32x4*)(_zr + ZMK + _h * 128 + _cg * 16); (P).k1 = *(const u32x4*)(_zr + ZMK + _h * 128 + _cg * 16 + 8); \
        _Pragma("unroll") for (int _s = 0; _s < 4; ++_s) (P).v[_s] = *(const u32x4*)(_zr + ZMV + _h * 256 + _cg * 32 + _s * 8); \
        if (tid < 64) { const unsigned char* _sm = a.ws + WS_SMALL; (P).fl = ((const float*)(_sm + SM_FLAST))[(_b * 64 + tid) * 4 + _h]; (P).am = ((const float*)(_sm + SM_AMAX))[(_b * 64 + tid) * 4 + _h]; \
            (P).fc = ((const float*)(_sm + SM_FC))[(_t0 + tid) * 4 + _h]; (P).ic = ((const float*)(_sm + SM_IC))[(_t0 + tid) * 4 + _h]; } } while (0)
__device__ __forceinline__ void ml_prep_unit(const Args& a, int um, int um_next, MlPre& pre, LAS unsigned char* lds, int tid, int wid, int lane) {
    asm volatile("" : "+v"(tid), "+v"(lane));
    unsigned char* ws = a.ws; unsigned char* sm = ws + WS_SMALL;
    LAS bf16* Qs = (LAS bf16*)lds; LAS bf16* Ks = (LAS bf16*)(lds + 17408); LAS bf16* VTs = (LAS bf16*)(lds + 34816); LAS bf16* KWTs = (LAS bf16*)(lds + 71680);
    LAS float* FL = (LAS float*)(lds + 90112); LAS float* AM = FL + 64; LAS float* fcs = FL + 128; LAS float* ics = FL + 192; LAS float* mis = FL + 256; LAS float* wks = FL + 320;
    const int c = um & 63;
    const int l = tid >> 3, cg = tid & 7, g4 = lane >> 4, c15 = lane & 15;
    {
        const u32x4 q0 = pre.q0, q1 = pre.q1, k0 = pre.k0, k1 = pre.k1;
        *(LAS u32x4*)(Qs + l * 136 + cg * 16) = q0; *(LAS u32x4*)(Qs + l * 136 + cg * 16 + 8) = q1;
        const float sc = 0.08838834764831845f;
        u32x4 ko0, ko1;
        ko0.x = pk2(bflo(k0.x) * sc, bfhi(k0.x) * sc); ko0.y = pk2(bflo(k0.y) * sc, bfhi(k0.y) * sc); ko0.z = pk2(bflo(k0.z) * sc, bfhi(k0.z) * sc); ko0.w = pk2(bflo(k0.w) * sc, bfhi(k0.w) * sc);
        ko1.x = pk2(bflo(k1.x) * sc, bfhi(k1.x) * sc); ko1.y = pk2(bflo(k1.y) * sc, bfhi(k1.y) * sc); ko1.z = pk2(bflo(k1.z) * sc, bfhi(k1.z) * sc); ko1.w = pk2(bflo(k1.w) * sc, bfhi(k1.w) * sc);
        *(LAS u32x4*)(Ks + l * 136 + cg * 16) = ko0; *(LAS u32x4*)(Ks + l * 136 + cg * 16 + 8) = ko1;
#pragma unroll
        for (int s4 = 0; s4 < 4; ++s4) { const u32x4 v = pre.v[s4]; const int e0 = cg * 32 + s4 * 8;
            VTs[tsw(e0 + 0, l, 5)] = (bf16)(v.x & 0xffffu); VTs[tsw(e0 + 1, l, 5)] = (bf16)(v.x >> 16); VTs[tsw(e0 + 2, l, 5)] = (bf16)(v.y & 0xffffu); VTs[tsw(e0 + 3, l, 5)] = (bf16)(v.y >> 16);
            VTs[tsw(e0 + 4, l, 5)] = (bf16)(v.z & 0xffffu); VTs[tsw(e0 + 5, l, 5)] = (bf16)(v.z >> 16); VTs[tsw(e0 + 6, l, 5)] = (bf16)(v.w & 0xffffu); VTs[tsw(e0 + 7, l, 5)] = (bf16)(v.w >> 16); }
        if (tid < 64) { FL[tid] = pre.fl; AM[tid] = pre.am; fcs[tid] = pre.fc; ics[tid] = pre.ic; }
        if (um_next >= 0) ML_PREP_LOAD(um_next, pre);
    }
    __syncthreads();
    if (tid < 64) {
        float A = FL[tid], B = AM[tid], v = ics[tid] - fcs[tid];
#pragma unroll
        for (int off = 1; off < 64; off <<= 1) { const float Ap = __shfl_up(A, off), Bp = __shfl_up(B, off), vp = __shfl_up(v, off);
            if (tid >= off) { B = fmaxf(Bp + A, B); A = Ap + A; v = fmaxf(v, vp); } }
        const float mm = fmaxf(A, B);
        float mprev = __shfl_up(mm, 1); if (tid == 0) mprev = 0.f;
        const float mst = __shfl(mprev, c), mn = __shfl(mm, c), flc = FL[c];
        if (tid == 0) ((float*)(sm + SM_MDEC))[um] = expf(flc + mst - mn);
        const float inter = fcs[tid] + mst, mi = fmaxf(fcs[tid] + v, inter); mis[tid] = mi;
        ((float*)(sm + SM_MSI))[um * 64 + tid] = expf(inter - mi); ((float*)(sm + SM_MEN))[um * 64 + tid] = expf(-mi); wks[tid] = expf(flc - fcs[tid] + ics[tid] - mn); }
    __syncthreads();
    if (wid < 4) {
        f32x4 acc[4];
#pragma unroll
        for (int n = 0; n < 4; ++n) acc[n] = (f32x4){0.f, 0.f, 0.f, 0.f};
#pragma unroll
        for (int ks = 0; ks < 4; ++ks) { const bf16x8 af = frag(Qs, 16 * wid, 136, 32 * ks, lane);
#pragma unroll
            for (int n = 0; n < 4; ++n) acc[n] = MMA16(af, frag(Ks, 16 * n, 136, 32 * ks, lane), acc[n]); }
        bf16* WT = (bf16*)(ws + WS_MWT) + (size_t)um * 4096; float rsum[4] = {0.f, 0.f, 0.f, 0.f};
#pragma unroll
        for (int n = 0; n < 4; ++n)
#pragma unroll
            for (int rg = 0; rg < 4; ++rg) { const int i = 16 * wid + 4 * g4 + rg, j = 16 * n + c15;
                const float wv = (j <= i) ? __expf(fcs[i] - fcs[j] + ics[j] - mis[i]) * acc[n][rg] : 0.f; rsum[rg] += wv; WT[i * 64 + j] = f2bf(wv); }
#pragma unroll
        for (int rg = 0; rg < 4; ++rg) { float s = rsum[rg];
#pragma unroll
            for (int o = 1; o < 16; o <<= 1) s += __shfl_xor(s, o);
            if (c15 == 0) ((float*)(sm + SM_MWS))[um * 64 + 16 * wid + 4 * g4 + rg] = s; }
    } else {
        const int t2 = tid - 256, l2 = t2 >> 2, part = t2 & 3; const float wk = wks[l2];
#pragma unroll 8
        for (int i = 0; i < 32; ++i) { const int d = part * 32 + i; KWTs[tsw(d, l2, 5)] = f2bf(wk * bf2f(Ks[l2 * 136 + d])); }
    }
    __syncthreads();
    {
        bf16* BM = (bf16*)(ws + WS_MBM) + (size_t)um * 32768;
        bf16x8 kf[2];
#pragma unroll
        for (int ks = 0; ks < 2; ++ks) kf[ks] = fragsw(KWTs, wid, ks, lane, 5);
#pragma unroll
        for (int n = 0; n < 16; ++n) { f32x4 b1 = (f32x4){0.f, 0.f, 0.f, 0.f};
#pragma unroll
            for (int ks = 0; ks < 2; ++ks) b1 = MMA16(kf[ks], fragsw(VTs, n, ks, lane, 5), b1);
            *(u32x2*)(BM + (((n * 8 + wid) * 64) + lane) * 4) = (u32x2){pk2(b1[0], b1[1]), pk2(b1[2], b1[3])}; }
        if (tid < 128) { float s = 0.f;
#pragma unroll
            for (int c8 = 0; c8 < 8; ++c8) { const u32x4 kv = *(const LAS u32x4*)(KWTs + tid * 72 + c8 * 8); s += (bflo(kv.x) + bfhi(kv.x)) + (bflo(kv.y) + bfhi(kv.y)) + (bflo(kv.z) + bfhi(kv.z)) + (bflo(kv.w) + bfhi(kv.w)); }
            ((float*)(sm + SM_MKS))[um * 128 + tid] = s; }
        bf16* VT = (bf16*)(ws + WS_MVT) + (size_t)um * 16384;
        for (int p = tid; p < 2048; p += 512) { const int row = p >> 3, seg = p & 7; *(u32x4*)(VT + row * 64 + seg * 8) = *(const LAS u32x4*)(VTs + row * 72 + ((seg ^ (row >> 5)) & 7) * 8); }
    }
    __syncthreads();
}

__device__ __forceinline__ void gdn_scan_item(const Args& a, int item, LAS unsigned char* lds, int tid, int wid, int lane) {
    asm volatile("" : "+v"(tid), "+v"(lane));
    unsigned char* ws = a.ws; unsigned char* sm = ws + WS_SMALL;
    LAS bf16* STs = (LAS bf16*)lds;
    LAS float* gls = (LAS float*)(lds + 8704);
    const int bh = item >> 3, n = item & 7, g4 = lane >> 4, c15 = lane & 15;
    const int ug0 = bh * 64;
    const size_t toff = (size_t)ug0 * 16384 + (size_t)(((((n >> 1) * 8 + wid) * 2 + (n & 1)) * 64) + lane) * 4;
    const bf16* APl = (const bf16*)(ws + WS_GAP) + (size_t)ug0 * 16384 + wid * 2048 + lane * 8;
    const bf16* BBl = (const bf16*)(ws + WS_GBB) + toff; bf16* SSl = (bf16*)(ws + WS_GSS) + toff;
    f32x4 S = (f32x4){0.f, 0.f, 0.f, 0.f};
    for (int i = tid; i < 16 * 136; i += 512) STs[i] = 0;
    if (tid < 64) gls[tid] = ((const float*)(sm + SM_GLAST))[ug0 + tid];
    u32x4 ap[8][4]; u32x2 bb[8];
#define GS_FILL(st, c) do { const bf16* _pa = APl + (size_t)(c) * 16384; const bf16* _pb = BBl + (size_t)(c) * 16384; \
        asm volatile("global_load_dwordx4 %0, %5, off\n\tglobal_load_dwordx4 %1, %5, off offset:1024\n\tglobal_load_dwordx4 %2, %5, off offset:2048\n\tglobal_load_dwordx4 %3, %5, off offset:3072\n\t" \
                     "global_load_dwordx2 %4, %6, off" \
                     : "=&v"(ap[st][0]), "=&v"(ap[st][1]), "=&v"(ap[st][2]), "=&v"(ap[st][3]), "=&v"(bb[st]) : "v"(_pa), "v"(_pb) : "memory"); } while (0)
#pragma unroll
    for (int st = 0; st < 8; ++st) GS_FILL(st, st);
    int cur = 0;
    __syncthreads();
    for (int c0 = 0; c0 < 64; c0 += 8) {
#pragma unroll
        for (int st = 0; st < 8; ++st) { const int c = c0 + st;
            asm volatile("s_waitcnt vmcnt(30)" : "+v"(ap[st][0]), "+v"(ap[st][1]), "+v"(ap[st][2]), "+v"(ap[st][3]), "+v"(bb[st]) :: "memory");
            const LAS bf16* STc = STs + cur * (16 * 136); LAS bf16* STn = STs + (cur ^ 1) * (16 * 136);
            const float gl = gls[c];
            *(u32x2*)(SSl + (size_t)c * 16384) = (u32x2){pk2(S[0], S[1]), pk2(S[2], S[3])};
            f32x4 acc; acc[0] = gl * S[0] + bflo(bb[st].x); acc[1] = gl * S[1] + bfhi(bb[st].x); acc[2] = gl * S[2] + bflo(bb[st].y); acc[3] = gl * S[3] + bfhi(bb[st].y);
#pragma unroll
            for (int ks = 0; ks < 4; ++ks) acc = MMA16(__builtin_bit_cast(bf16x8, ap[st][ks]), frag(STc, 0, 136, 32 * ks, lane), acc);
            S = acc; *(LAS u32x2*)(STn + c15 * 136 + 16 * wid + 4 * g4) = (u32x2){pk2(acc[0], acc[1]), pk2(acc[2], acc[3])};
            { const int cn = c + 8 < 64 ? c + 8 : 63; GS_FILL(st, cn); }
            __syncthreads();
            cur ^= 1;
        }
    }
    asm volatile("s_waitcnt vmcnt(0)" ::: "memory");
#undef GS_FILL
}
__device__ __forceinline__ void ml_scan_item(const Args& a, int item, int tid) {
    unsigned char* ws = a.ws; unsigned char* sm = ws + WS_SMALL;
    const int bh = item >> 4, part = item & 15, um0 = bh * 64; const size_t el = (size_t)part * 2048 + (size_t)tid * 4;
    const bf16* BM = (const bf16*)(ws + WS_MBM) + (size_t)um0 * 32768 + el; bf16* CS = (bf16*)(ws + WS_MCS) + (size_t)um0 * 32768 + el;
    const float* DEC = (const float*)(sm + SM_MDEC) + um0; const float* KS = (const float*)(sm + SM_MKS) + um0 * 128; float* NS = (float*)(sm + SM_MNS) + um0 * 128;
    float C[4] = {0.f, 0.f, 0.f, 0.f}; float n = 0.f; const bool don = (part == 0 && tid < 128);
    for (int c0 = 0; c0 < 64; c0 += 16) {
        u32x2 bv[16]; float dc[16], kv[16];
#pragma unroll
        for (int j = 0; j < 16; ++j) { bv[j] = *(const u32x2*)(BM + (size_t)(c0 + j) * 32768); dc[j] = DEC[c0 + j]; kv[j] = don ? KS[(c0 + j) * 128 + tid] : 0.f; }
#pragma unroll
        for (int j = 0; j < 16; ++j) {
            *(u32x2*)(CS + (size_t)(c0 + j) * 32768) = (u32x2){pk2(C[0], C[1]), pk2(C[2], C[3])};
            if (don) { NS[(c0 + j) * 128 + tid] = n; n = dc[j] * n + kv[j]; }
            C[0] = dc[j] * C[0] + bflo(bv[j].x); C[1] = dc[j] * C[1] + bfhi(bv[j].x); C[2] = dc[j] * C[2] + bflo(bv[j].y); C[3] = dc[j] * C[3] + bfhi(bv[j].y); }
    }
}

struct GdnOutPre { u32x4 s4[4], w2[2], q2[2], a1, z0, z1; u32x2 u4[4]; };
#define GDN_OUT_LOAD(ugx, P) do { const bf16* _S = (const bf16*)(a.ws + WS_GSS) + (size_t)(ugx) * 16384; const bf16* _W = (const bf16*)(a.ws + WS_GW) + (size_t)(ugx) * 8192; const bf16* _Q = (const bf16*)(a.ws + WS_GQD) + (size_t)(ugx) * 8192; \
        const bf16* _A = (const bf16*)(a.ws + WS_GAT) + (size_t)(ugx) * 4096; const bf16* _U = (const bf16*)(a.ws + WS_GU) + (size_t)(ugx) * 8192; \
        _Pragma("unroll") for (int _i = 0; _i < 4; ++_i) (P).s4[_i] = *(const u32x4*)(_S + (tid + 512 * _i) * 8); \
        _Pragma("unroll") for (int _i = 0; _i < 2; ++_i) { const int _p = tid + 512 * _i; (P).w2[_i] = *(const u32x4*)(_W + _p * 8); (P).q2[_i] = *(const u32x4*)(_Q + (_p >> 4) * 128 + (_p & 15) * 8); } \
        (P).a1 = *(const u32x4*)(_A + (tid >> 3) * 64 + (tid & 7) * 8); \
        _Pragma("unroll") for (int _lt = 0; _lt < 4; ++_lt) (P).u4[_lt] = *(const u32x2*)(_U + ((((tid >> 6) * 4 + _lt) * 64) + (tid & 63)) * 4); \
        { const int _b = (ugx) >> 9, _h = ((ugx) >> 6) & 7, _c = (ugx) & 63; const bf16* _zr = (const bf16*)(a.ws + WS_Z) + (size_t)(_b * SEQL + _c * 64 + (tid >> 3)) * NZ + ZG + _h * 128 + (tid & 7) * 16; \
          (P).z0 = *(const u32x4*)_zr; (P).z1 = *(const u32x4*)(_zr + 8); } } while (0)
__device__ __forceinline__ void gdn_out_unit(const Args& a, int ug, int ug_next, GdnOutPre& pre, LAS unsigned char* lds, int tid, int wid, int lane) {
    asm volatile("" : "+v"(tid), "+v"(lane));
    unsigned char* ws = a.ws;
    LAS bf16* Ss = (LAS bf16*)lds; LAS bf16* Ws = (LAS bf16*)(lds + 34816); LAS bf16* QDs = (LAS bf16*)(lds + 52224); LAS bf16* ATs = (LAS bf16*)(lds + 69632); LAS bf16* VNt = (LAS bf16*)(lds + 78848);
    LAS float* Os = (LAS float*)lds;
    const int b = ug >> 9, h = (ug >> 6) & 7, c = ug & 63, t0 = b * SEQL + c * 64, g4 = lane >> 4, c15 = lane & 15;
    u32x2 u4r[4]; u32x4 z0, z1;
    {
#pragma unroll
        for (int i = 0; i < 4; ++i) { const int p = tid + 512 * i;
#pragma unroll
            for (int hq = 0; hq < 2; ++hq) { const int q = 2 * p + hq, lr = q & 63, et = (q >> 6) & 1, w = (q >> 7) & 7, es = q >> 10;
                *(LAS u32x2*)(Ss + (es * 32 + 16 * et + (lr & 15)) * 136 + 16 * w + 4 * (lr >> 4)) = hq ? (u32x2){pre.s4[i].z, pre.s4[i].w} : (u32x2){pre.s4[i].x, pre.s4[i].y}; } }
#pragma unroll
        for (int i = 0; i < 2; ++i) { const int p = tid + 512 * i; *(LAS u32x4*)(QDs + (p >> 4) * 136 + (p & 15) * 8) = pre.q2[i];
#pragma unroll
            for (int hq = 0; hq < 2; ++hq) { const int q = 2 * p + hq, lr = q & 63, it = (q >> 6) & 3, en = q >> 8;
                *(LAS u32x2*)(Ws + (16 * it + (lr & 15)) * 136 + 16 * en + 4 * (lr >> 4)) = hq ? (u32x2){pre.w2[i].z, pre.w2[i].w} : (u32x2){pre.w2[i].x, pre.w2[i].y}; } }
        *(LAS u32x4*)(ATs + (tid >> 3) * 72 + (tid & 7) * 8) = pre.a1;
#pragma unroll
        for (int lt = 0; lt < 4; ++lt) u4r[lt] = pre.u4[lt];
        z0 = pre.z0; z1 = pre.z1;
        if (ug_next >= 0) GDN_OUT_LOAD(ug_next, pre);
    }
    __syncthreads();
    f32x4 O[4];
    {
        bf16x8 sf[4];
#pragma unroll
        for (int ks = 0; ks < 4; ++ks) sf[ks] = frag(Ss, 16 * wid, 136, 32 * ks, lane);
#pragma unroll
        for (int lt = 0; lt < 4; ++lt) { f32x4 P = (f32x4){0.f, 0.f, 0.f, 0.f}; const u32x2 u4 = u4r[lt];
#pragma unroll
            for (int ks = 0; ks < 4; ++ks) P = MMA16(sf[ks], frag(Ws, 16 * lt, 136, 32 * ks, lane), P);
            const float v0 = bflo(u4.x) - P[0], v1 = bfhi(u4.x) - P[1], v2 = bflo(u4.y) - P[2], v3 = bfhi(u4.y) - P[3];
            LAS bf16* vp = VNt + (16 * wid + 4 * g4) * 72 + 16 * lt + c15; vp[0] = f2bf(v0); vp[72] = f2bf(v1); vp[144] = f2bf(v2); vp[216] = f2bf(v3); }
        LDS_WAIT();
#pragma unroll
        for (int lt = 0; lt < 4; ++lt) { f32x4 o = (f32x4){0.f, 0.f, 0.f, 0.f};
#pragma unroll
            for (int ks = 0; ks < 4; ++ks) o = MMA16(frag(QDs, 16 * lt, 136, 32 * ks, lane), sf[ks], o);
#pragma unroll
            for (int ks = 0; ks < 2; ++ks) o = MMA16(frag(ATs, 16 * lt, 72, 32 * ks, lane), frag(VNt, 16 * wid, 72, 32 * ks, lane), o);
            O[lt] = o; }
    }
    __syncthreads();
#pragma unroll
    for (int lt = 0; lt < 4; ++lt)
#pragma unroll
        for (int rg = 0; rg < 4; ++rg) Os[(16 * lt + 4 * g4 + rg) * 132 + 16 * wid + c15] = O[lt][rg];
    __syncthreads();
    {
        const int l = tid >> 3, cg = tid & 7; const LAS f32x4* op = (const LAS f32x4*)(Os + l * 132 + cg * 16);
        const f32x4 o0 = op[0], o1 = op[1], o2 = op[2], o3 = op[3];
        float ss = ((o0[0] * o0[0] + o0[1] * o0[1]) + (o0[2] * o0[2] + o0[3] * o0[3])) + ((o1[0] * o1[0] + o1[1] * o1[1]) + (o1[2] * o1[2] + o1[3] * o1[3]))
                 + ((o2[0] * o2[0] + o2[1] * o2[1]) + (o2[2] * o2[2] + o2[3] * o2[3])) + ((o3[0] * o3[0] + o3[1] * o3[1]) + (o3[2] * o3[2] + o3[3] * o3[3]));
#pragma unroll
        for (int o = 1; o < 8; o <<= 1) ss += __shfl_xor(ss, o);
        const float r = rsqrtf(ss * (1.f / 128.f) + EPS);
        const LAS float* gn = (const LAS float*)(lds + GN_LDS) + cg * 16; const f32x4 g0 = *(const LAS f32x4*)gn, g1 = *(const LAS f32x4*)(gn + 4), g2 = *(const LAS f32x4*)(gn + 8), g3 = *(const LAS f32x4*)(gn + 12);
#define GY(ov, gv, zw, k) pk2(ov[2 * (k)] * r * gv[2 * (k)] * (bflo(zw) * sigm(bflo(zw))), ov[2 * (k) + 1] * r * gv[2 * (k) + 1] * (bfhi(zw) * sigm(bfhi(zw))))
        bf16* yp = (bf16*)(ws + WS_Y) + (size_t)(t0 + l) * DM + h * 128 + cg * 16;
        *(u32x4*)yp = (u32x4){GY(o0, g0, z0.x, 0), GY(o0, g0, z0.y, 1), GY(o1, g1, z0.z, 0), GY(o1, g1, z0.w, 1)};
        *(u32x4*)(yp + 8) = (u32x4){GY(o2, g2, z1.x, 0), GY(o2, g2, z1.y, 1), GY(o3, g3, z1.z, 0), GY(o3, g3, z1.w, 1)};
#undef GY
    }
    __syncthreads();
}
struct MlOutPre { u32x4 c4[8], q2[2], v4[4], w1; float nsv, siv; };
#define ML_OUT_LOAD(umx, P) do { const int _b = (umx) >> 8, _h = ((umx) >> 6) & 3, _c = (umx) & 63, _t0 = _b * SEQL + _c * 64; \
        const bf16* _C = (const bf16*)(a.ws + WS_MCS) + (size_t)(umx) * 32768; const bf16* _Z = (const bf16*)(a.ws + WS_Z); const bf16* _WT = (const bf16*)(a.ws + WS_MWT) + (size_t)(umx) * 4096; const bf16* _VT = (const bf16*)(a.ws + WS_MVT) + (size_t)(umx) * 16384; \
        _Pragma("unroll") for (int _i = 0; _i < 8; ++_i) { const int _p = tid + 512 * _i; (P).c4[_i] = *(const u32x4*)(_C + _p * 8); } \
        _Pragma("unroll") for (int _i = 0; _i < 2; ++_i) { const int _p = tid + 512 * _i; (P).q2[_i] = *(const u32x4*)(_Z + (size_t)(_t0 + (_p >> 4)) * NZ + ZMQ + _h * 128 + (_p & 15) * 8); } \
        _Pragma("unroll") for (int _i = 0; _i < 4; ++_i) { const int _p = tid + 512 * _i; (P).v4[_i] = *(const u32x4*)(_VT + (_p >> 3) * 64 + (_p & 7) * 8); } \
        (P).w1 = *(const u32x4*)(_WT + (tid >> 3) * 64 + (tid & 7) * 8); \
        (P).nsv = tid < 128 ? ((const float*)(a.ws + WS_SMALL + SM_MNS))[(umx) * 128 + tid] : 0.f; (P).siv = tid < 64 ? ((const float*)(a.ws + WS_SMALL + SM_MSI))[(umx) * 64 + tid] : 0.f; } while (0)
__device__ __forceinline__ void ml_out_unit(const Args& a, int um, int um_next, MlOutPre& pre, LAS unsigned char* lds, int tid, int wid, int lane) {
    asm volatile("" : "+v"(tid), "+v"(lane));
    unsigned char* ws = a.ws; unsigned char* sm = ws + WS_SMALL;
    LAS bf16* Cs = (LAS bf16*)lds; LAS bf16* Qs = (LAS bf16*)(lds + 69632); LAS bf16* WTs = (LAS bf16*)(lds + 87040); LAS bf16* VTs = (LAS bf16*)(lds + 96256);
    LAS float* ns = (LAS float*)(lds + 133120); LAS float* sis = ns + 128; LAS float* dns = ns + 192;
    LAS float* Hs = (LAS float*)lds;
    const int b = um >> 8, h = (um >> 6) & 3, c = um & 63, t0 = b * SEQL + c * 64, g4 = lane >> 4, c15 = lane & 15;
    u32x4 zo[4];
    { const bf16* zr0 = (const bf16*)(ws + WS_Z) + (size_t)(t0 + (tid >> 3)) * NZ + ZMO + h * 256 + (tid & 7) * 32;
#pragma unroll
      for (int i = 0; i < 4; ++i) zo[i] = *(const u32x4*)(zr0 + 8 * i); }
    {
#pragma unroll
        for (int i = 0; i < 8; ++i) { const int p = tid + 512 * i;
#pragma unroll
            for (int hq = 0; hq < 2; ++hq) { const int q = 2 * p + hq, lr = q & 63, w = (q >> 6) & 7, n = q >> 9;
                *(LAS u32x2*)(Cs + (16 * n + (lr & 15)) * 136 + 16 * w + 4 * (lr >> 4)) = hq ? (u32x2){pre.c4[i].z, pre.c4[i].w} : (u32x2){pre.c4[i].x, pre.c4[i].y}; } }
#pragma unroll
        for (int i = 0; i < 2; ++i) { const int p = tid + 512 * i; *(LAS u32x4*)(Qs + (p >> 4) * 136 + (p & 15) * 8) = pre.q2[i]; }
#pragma unroll
        for (int i = 0; i < 4; ++i) { const int p = tid + 512 * i; *(LAS u32x4*)(VTs + (p >> 3) * 72 + (p & 7) * 8) = pre.v4[i]; }
        *(LAS u32x4*)(WTs + (tid >> 3) * 72 + (tid & 7) * 8) = pre.w1;
        if (tid < 128) ns[tid] = pre.nsv;
        if (tid < 64) sis[tid] = pre.siv;
        if (um_next >= 0) ML_OUT_LOAD(um_next, pre);
    }
    __syncthreads();
    {
        const int l = tid >> 3, part = tid & 7; float s = 0.f;
#pragma unroll
        for (int hq = 0; hq < 2; ++hq) { const u32x4 qv = *(const LAS u32x4*)(Qs + l * 136 + part * 16 + 8 * hq); const f32x4 n0 = *(const LAS f32x4*)(ns + part * 16 + 8 * hq), n1 = *(const LAS f32x4*)(ns + part * 16 + 8 * hq + 4);
            s += (bflo(qv.x) * n0[0] + bfhi(qv.x) * n0[1]) + (bflo(qv.y) * n0[2] + bfhi(qv.y) * n0[3]) + (bflo(qv.z) * n1[0] + bfhi(qv.z) * n1[1]) + (bflo(qv.w) * n1[2] + bfhi(qv.w) * n1[3]); }
#pragma unroll
        for (int o = 1; o < 8; o <<= 1) s += __shfl_xor(s, o);
        if (part == 0) dns[l] = 1.f / fmaxf(fabsf(sis[l] * s + ((const float*)(sm + SM_MWS))[um * 64 + l]), ((const float*)(sm + SM_MEN))[um * 64 + l]);
    }
    f32x4 N[2][4];
#pragma unroll
    for (int e2 = 0; e2 < 2; ++e2) { const int et = 2 * wid + e2; bf16x8 cf[4];
#pragma unroll
        for (int ks = 0; ks < 4; ++ks) cf[ks] = frag(Cs, 16 * et, 136, 32 * ks, lane);
#pragma unroll
        for (int lt = 0; lt < 4; ++lt) { f32x4 n4 = (f32x4){0.f, 0.f, 0.f, 0.f};
#pragma unroll
            for (int ks = 0; ks < 4; ++ks) n4 = MMA16(frag(Qs, 16 * lt, 136, 32 * ks, lane), cf[ks], n4);
#pragma unroll
            for (int rg = 0; rg < 4; ++rg) n4[rg] *= sis[16 * lt + 4 * g4 + rg];
#pragma unroll
            for (int ks = 0; ks < 2; ++ks) n4 = MMA16(frag(WTs, 16 * lt, 72, 32 * ks, lane), frag(VTs, 16 * et, 72, 32 * ks, lane), n4);
            N[e2][lt] = n4; } }
    __syncthreads();
#pragma unroll
    for (int e2 = 0; e2 < 2; ++e2)
#pragma unroll
        for (int lt = 0; lt < 4; ++lt)
#pragma unroll
            for (int rg = 0; rg < 4; ++rg) { const int l = 16 * lt + 4 * g4 + rg; Hs[l * 260 + 16 * (2 * wid + e2) + c15] = N[e2][lt][rg] * dns[l]; }
    __syncthreads();
    {
        const int l = tid >> 3, cg = tid & 7; const LAS f32x4* hp = (const LAS f32x4*)(Hs + l * 260 + cg * 32);
        f32x4 hv[8]; float ss = 0.f;
#pragma unroll
        for (int i = 0; i < 8; ++i) { hv[i] = hp[i]; ss += (hv[i][0] * hv[i][0] + hv[i][1] * hv[i][1]) + (hv[i][2] * hv[i][2] + hv[i][3] * hv[i][3]); }
#pragma unroll
        for (int o = 1; o < 8; o <<= 1) ss += __shfl_xor(ss, o);
        const float r = rsqrtf(ss * (1.f / 256.f) + EPS);
        const LAS float* mn = (const LAS float*)(lds + GN_LDS + 512) + h * 256 + cg * 32;
        bf16* yp = (bf16*)(ws + WS_Y) + (size_t)(t0 + l) * DM + 1024 + h * 256 + cg * 32;
#pragma unroll
        for (int i = 0; i < 4; ++i) { const u32x4 zw = zo[i]; const f32x4 m0 = *(const LAS f32x4*)(mn + 8 * i), m1 = *(const LAS f32x4*)(mn + 8 * i + 4); const f32x4 h0 = hv[2 * i], h1 = hv[2 * i + 1];
            u32x4 y; y.x = pk2(h0[0] * r * m0[0] * sigm(bflo(zw.x)), h0[1] * r * m0[1] * sigm(bfhi(zw.x))); y.y = pk2(h0[2] * r * m0[2] * sigm(bflo(zw.y)), h0[3] * r * m0[3] * sigm(bfhi(zw.y)));
            y.z = pk2(h1[0] * r * m1[0] * sigm(bflo(zw.z)), h1[1] * r * m1[1] * sigm(bfhi(zw.z))); y.w = pk2(h1[2] * r * m1[2] * sigm(bflo(zw.w)), h1[3] * r * m1[3] * sigm(bfhi(zw.w)));
            *(u32x4*)(yp + 8 * i) = y; }
    }
    __syncthreads();
}

__device__ __forceinline__ void router_unit(const Args& a, int u, LAS unsigned char* lds, int tid, int wid, int lane) {
    asm volatile("" : "+v"(tid), "+v"(lane));
    unsigned char* ws = a.ws; unsigned char* sm = ws + WS_SMALL;
    const float* H1 = (const float*)(ws + WS_H1);
    LAS float* red = (LAS float*)lds; LAS float* Ls = (LAS float*)(lds + 67584); LAS int* sel = (LAS int*)(lds + 67584 + 8448); LAS int* rks = sel + 256; LAS float* rsl = (LAS float*)(rks + 256);
    const int t0 = u * 64, g4 = lane >> 4, c15 = lane & 15;
    if (tid < 64) { const float* SSQ = (const float*)(sm + SM_SSQ1) + (size_t)(t0 + tid) * 32; float s = 0.f;
#pragma unroll
        for (int q = 0; q < 8; ++q) { const f32x4 v = *(const f32x4*)(SSQ + 4 * q); s += (v[0] + v[1]) + (v[2] + v[3]); }
        const float r = rsqrtf(s * (1.f / DM) + EPS); rsl[tid] = r; ((float*)(sm + SM_RS2))[t0 + tid] = r; }
    __syncthreads();
    float rr[4];
#pragma unroll
    for (int rt = 0; rt < 4; ++rt) rr[rt] = rsl[16 * rt + c15];
    unsigned char* qb = ws + WS_H1B + (size_t)(t0 + c15) * DM;
    skinny_mfma(H1 + (size_t)t0 * DM, (const bf16*)(ws + WS_WSK) + 64 * DM, (const bf16*)(ws + WS_WSK) + 96 * DM, red, Ls, tid, wid, lane,
        [&](int rt, int k, const f32x4& v0, const f32x4& v1) { const float r = rr[rt];
            *(u32x2*)(qb + (size_t)(16 * rt) * DM + k) = (u32x2){pk4_fp8(v0[0] * r, v0[1] * r, v0[2] * r, v0[3] * r), pk4_fp8(v1[0] * r, v1[1] * r, v1[2] * r, v1[3] * r)}; });
    if (tid < 64) { const int l = tid, t = t0 + l; float tv[4]; int ti[4]; const float r = rsl[l]; const float* b_r = argin(a, 14);
        float lg[32];
#pragma unroll
        for (int c4 = 0; c4 < 8; ++c4) { const f32x4 bq = *(const f32x4*)(b_r + 4 * c4);
#pragma unroll
            for (int e = 0; e < 4; ++e) lg[4 * c4 + e] = Ls[l * 33 + 4 * c4 + e] * r + bq[e]; }
        unsigned taken = 0u;
#pragma unroll
        for (int k = 0; k < 4; ++k) { float best = -INFINITY; int bi = 0;
#pragma unroll
            for (int c = 0; c < 32; ++c) { const bool ok = !((taken >> c) & 1u) && lg[c] > best; best = ok ? lg[c] : best; bi = ok ? c : bi; }
            tv[k] = best; ti[k] = bi; taken |= 1u << bi; }
        const float e1 = expf(tv[1] - tv[0]), e2 = expf(tv[2] - tv[0]), e3 = expf(tv[3] - tv[0]); const float inv = 1.f / (1.f + e1 + e2 + e3);
        int* TOPI = (int*)(sm + SM_TOPI); float* TOPG = (float*)(sm + SM_TOPG);
        *(i32x4*)(TOPI + t * 4) = (i32x4){ti[0], ti[1], ti[2], ti[3]};
        *(f32x4*)(TOPG + t * 4) = (f32x4){inv, e1 * inv, e2 * inv, e3 * inv};
        sel[l * 4 + 0] = ti[0]; sel[l * 4 + 1] = ti[1]; sel[l * 4 + 2] = ti[2]; sel[l * 4 + 3] = ti[3]; }
    __syncthreads();
    int my_e = 0, my_lr = 0;
    if (tid < 256) {
        my_e = sel[tid];
#pragma unroll 4
        for (int e = 0; e < 32; ++e) { const unsigned long long m = __ballot(my_e == e); if (my_e == e) my_lr = __popcll(m & ((1ull << lane) - 1ull)); if (lane == 0) rks[wid * 32 + e] = __popcll(m); }
    }
    __syncthreads();
    if (tid < 256) { int rk = my_lr; for (int w = 0; w < wid; ++w) rk += rks[w * 32 + my_e]; ((int*)(sm + SM_LRANK))[t0 * 4 + tid] = rk; }
    if (tid < 32) { const int cnt = (rks[tid] + rks[32 + tid]) + (rks[64 + tid] + rks[96 + tid]);
        ((int*)(sm + SM_UCNT))[u * 32 + tid] = cnt; atomicAdd((int*)(ws + WS_CTL) + CW_CNTE + tid, cnt); }
    __syncthreads();
}

constexpr int NPHASE = 13;
__global__ void __launch_bounds__(NWAVES * 64, 2) mk_fwd(Args args) {
    extern __shared__ __attribute__((aligned(16))) unsigned char lds_raw[];
    LAS unsigned char* lds = (LAS unsigned char*)lds_raw;
    volatile LAS unsigned* MISC = (volatile LAS unsigned*)(lds + MISC_OFF);
    const int wave = __builtin_amdgcn_readfirstlane((int)threadIdx.x >> 6);
#define PHASE_IDS int lane_; asm volatile("v_mbcnt_lo_u32_b32 %0, -1, 0\n\tv_mbcnt_hi_u32_b32 %0, -1, %0" : "=v"(lane_)); const int tid = wave * 64 + lane_; const int lane = lane_; (void)lane;
    const int G = gridDim.x, bx = blockIdx.x;
    unsigned char* ws = args.ws; unsigned char* sm = ws + WS_SMALL;
    const int gw = bx * NWAVES + wave, NGW = G * NWAVES;
    { PHASE_IDS for (int u = tid; u < 64; u += NWAVES * 64) MISC[u] = 0u; }
    __syncthreads();
#if MK_SPLIT
#define GRID_BAR() do { } while (0)
#else
    XcdBarrier bar; { PHASE_IDS bar = xcd_barrier_post((unsigned*)(ws + WS_CTL) + CW_BAR, MISC + 8, tid == 0); }
#define GRID_BAR() xcd_barrier(bar, tid == 0)
#endif
#if MK_SPLIT
    const int lo = args.ph_lo, hi = args.ph_hi;
#else
    constexpr int lo = 0, hi = NPHASE;
#endif
#ifndef PH_MASK
#define PH_MASK 0xffffffffu
#endif
#define IN(k) ((((PH_MASK) >> (k)) & 1u) && lo <= (k) && (k) < hi)
#define BOTH(k) (IN(k) && IN((k) + 1))

    if (IN(0)) {
        PHASE_IDS
        {
            const float* x = argin(args, 0); bf16* xb = (bf16*)(ws + WS_XB);
            for (int t = gw; t < NTOK; t += NGW) { float ss = 0.f;
#pragma unroll
                for (int j = 0; j < 8; ++j) { const int col = 4 * lane + 256 * j; const f32x4 v = *(const f32x4*)(x + (size_t)t * DM + col); ss += (v[0] * v[0] + v[1] * v[1]) + (v[2] * v[2] + v[3] * v[3]);
                    *(u32x2*)(xb + (size_t)t * DM + col) = (u32x2){pk2(v[0], v[1]), pk2(v[2], v[3])}; }
                ss = wave_sum(ss); if (lane == 0) ((float*)(sm + SM_RS1))[t] = rsqrtf(ss * (1.f / DM) + EPS); } }
        {
            const float* w_in = argin(args, 3); const float* g_mix = argin(args, 2); const float* w_r = argin(args, 13); const float* g_ffn = argin(args, 12); bf16* wsk = (bf16*)(ws + WS_WSK);
            for (int i = bx * 512 + tid; i < 2 * 32 * DM; i += G * 512) { const int which = i >> 16, n = (i >> 11) & 31, k = i & 2047; float v;
                if (which == 0) { const int col = n < 16 ? 3072 + n : 6160 + (n - 16); v = n < 24 ? w_in[(size_t)k * DIN + col] * g_mix[k] : 0.f; } else v = w_r[(size_t)k * 32 + n] * g_ffn[k];
                const bf16 hi = f2bf(v); wsk[(size_t)(which * 64 + n) * DM + k] = hi; wsk[(size_t)(which * 64 + 32 + n) * DM + k] = f2bf(v - bf2f(hi)); } }
        p0_weights(args, gw, NGW, lane);
        { const float* p = argin(args, 1); bf16* pb = (bf16*)(ws + WS_PB);
          for (size_t i = (size_t)bx * 512 + tid; i < (size_t)NTOK * PLE / 4; i += (size_t)G * 512) { const f32x4 v = *(const f32x4*)(p + 4 * i); u32x2 w; w.x = pk2(v[0], v[1]); w.y = pk2(v[2], v[3]); *(u32x2*)(pb + 4 * i) = w; } }
        if (BOTH(0)) GRID_BAR();
    }
    if (IN(1)) {
        PHASE_IDS
        const int GA = (G == 256) ? 144 : G;
        if (args.aux == 6) { if (bx >= GA) { PHASE_IDS __syncthreads(); convert_pool(args, lds, tid, wave, lane); } }
        else {
        if (GA == G || bx >= GA) { const int u0 = (GA == G) ? bx : bx - GA, us = (GA == G) ? G : G - GA; for (int u = u0; u < NCHT; u += us) xgate_unit(args, u, lds, tid, wave, lane); }
        if (bx < GA) {
            { pg8::Gemm g{ws + WS_XB, ws + WS_WIN, DM * 2, 0, nullptr, 0, 0}; pg8::Order S; S.init(NTOK / 256, NZ / 256, GA, bx, nullptr);
              pg8::EpiZ E{(bf16*)(ws + WS_Z), NZ, (const float*)(sm + SM_RS1)};
              pg8::gemm_phase<pg8::EpiZ, false, true>(lds, g, S, E, tid); }
            { pg8::Gemm g{ws + WS_PB, ws + WS_WPP, PLE * 2, 0, nullptr, 0, 0}; pg8::Order S; S.init(NTOK / 256, DM / 256, GA, (bx + 128) % GA, nullptr);
              pg8::EpiPe E{(bf16*)(ws + WS_PE), (float*)(sm + SM_PESSQ)};
              pg8::gemm_phase<pg8::EpiPe, false, true>(lds, g, S, E, tid); }
        }
        { PHASE_IDS __syncthreads(); convert_pool(args, lds, tid, wave, lane); }
        }
        if (BOTH(1)) GRID_BAR();
    }
    if (IN(2)) {
        PHASE_IDS
        { GdnPre pre; pre.z[0] = pre.z[1] = pre.z[2] = (u32x4){0u, 0u, 0u, 0u}; pre.cw = (f32x4){0.f, 0.f, 0.f, 0.f};
          { const Args& a = args; if (bx < 2048) { GDN_ZLOAD(bx, 0, pre.z); GDN_CWLOAD(bx, pre.cw); } }
          for (int u = bx; u < 2048; u += G) gdn_prep_unit(args, u, (u + G < 2048) ? u + G : -1, pre, lds, tid, wave, lane); }
        { const Args& a = args; MlPre mp; const int u0 = bx + ((2048 - bx + G - 1) / G) * G;
          if (u0 < 3072) ML_PREP_LOAD(u0 - 2048, mp);
          for (int u = u0; u < 3072; u += G) ml_prep_unit(args, u - 2048, (u + G < 3072) ? u + G - 2048 : -1, mp, lds, tid, wave, lane); }
        if (BOTH(2)) GRID_BAR();
    }
    if (IN(3)) {
        PHASE_IDS
        for (int it = bx; it < 256; it += G) { const int itx = (G == 256) ? ((((it & 7) * 4 + (it >> 6)) << 3) | ((it >> 3) & 7)) : it;
            gdn_scan_item(args, itx, lds, tid, wave, lane); ml_scan_item(args, it, tid); __syncthreads(); }
        if (BOTH(3)) GRID_BAR();
    }
    if (IN(4)) {
        PHASE_IDS
        { const Args& a = args;
          { LAS float* gns = (LAS float*)(lds + GN_LDS); const float* gsrc = argin(args, 7); const float* msrc = argin(args, 10); if (tid < 128) gns[tid] = gsrc[tid]; gns[128 + tid] = msrc[tid]; gns[640 + tid] = msrc[512 + tid]; __syncthreads(); }
          { GdnOutPre pre; if (bx < 2048) GDN_OUT_LOAD(bx, pre);
            if (args.aux != 2) for (int u = bx; u < 2048; u += G) gdn_out_unit(args, u, (u + G < 2048) ? u + G : -1, pre, lds, tid, wave, lane); }
          { MlOutPre pre; const int u0 = bx + ((2048 - bx + G - 1) / G) * G;
            if (u0 < 3072) ML_OUT_LOAD(u0 - 2048, pre);
            if (args.aux != 1) for (int u = u0; u < 3072; u += G) ml_out_unit(args, u - 2048, (u + G < 3072) ? u + G - 2048 : -1, pre, lds, tid, wave, lane); } }
        if (BOTH(4)) GRID_BAR();
    }
    if (IN(5)) {
        PHASE_IDS
        pg8::Gemm g{ws + WS_Y, ws + WS_WOUT, DM * 2, 0, nullptr, 0, 0}; pg8::Order S; S.init(NTOK / 256, DM / 256, G, bx, nullptr);
        pg8::EpiOut E{argin(args, 0), (float*)(ws + WS_H1), (float*)(sm + SM_SSQ1)};
        pg8::gemm_phase<pg8::EpiOut, false, true>(lds, g, S, E, tid);
        if (BOTH(5)) GRID_BAR();
    }
    if (IN(6)) {
        PHASE_IDS
        for (int u = bx; u < NCHT; u += G) router_unit(args, u, lds, tid, wave, lane);
        if (BOTH(6)) GRID_BAR();
    }
    if (IN(7)) {
        PHASE_IDS
        LAS int* ps = (LAS int*)lds; LAS int* up = ps + 32; LAS int* cn = ps + 64;
        const int* CNTE = (const int*)(ws + WS_CTL) + CW_CNTE; const int* UCNT = (const int*)(sm + SM_UCNT);
        int* ROWTOK = (int*)(sm + SM_ROWTOK); float* ROWGATE = (float*)(sm + SM_ROWGATE); float* ROWRS = (float*)(sm + SM_ROWRS);
        if (tid < 64) {
            const int cnt = tid < 32 ? CNTE[tid] : 0, pad = ((cnt + 255) >> 8) << 8; int inc = pad;
#pragma unroll
            for (int off = 1; off < 32; off <<= 1) { const int p = __shfl_up(inc, off); if (tid >= off) inc += p; }
            if (tid < 32) { ps[tid] = inc - pad; cn[tid] = cnt; } }
        __syncthreads();
        for (int u = bx; u < NCHT; u += G) {
            { LAS int* pp = ps + 128; int s0 = 0, s1 = 0, s2 = 0, s3 = 0; const int e = tid & 31, part = tid >> 5;
              for (int v = part; v < u; v += 64) { s0 += UCNT[v * 32 + e]; if (v + 16 < u) s1 += UCNT[(v + 16) * 32 + e]; if (v + 32 < u) s2 += UCNT[(v + 32) * 32 + e]; if (v + 48 < u) s3 += UCNT[(v + 48) * 32 + e]; }
              pp[part * 32 + e] = (s0 + s1) + (s2 + s3); }
            __syncthreads();
            if (tid < 32) { int s = 0; for (int q = 0; q < 16; ++q) s += ps[128 + q * 32 + tid]; up[tid] = s; }
            __syncthreads();
            if (tid < 256) { const int ai = u * 256 + tid, t = ai >> 2; const int e = ((const int*)(sm + SM_TOPI))[ai]; const int dest = ps[e] + up[e] + ((const int*)(sm + SM_LRANK))[ai];
                ROWTOK[dest] = t; ROWGATE[dest] = ((const float*)(sm + SM_TOPG))[ai]; ROWRS[dest] = ((const float*)(sm + SM_RS2))[t]; ((int*)(sm + SM_DEST))[ai] = dest; }
            __syncthreads();
        }
        for (int e = bx; e < 32; e += G) { const int c0 = cn[e], c1 = ((c0 + 255) >> 8) << 8; for (int p = c0 + tid; p < c1; p += 512) { ROWTOK[ps[e] + p] = 0; ROWGATE[ps[e] + p] = 0.f; ROWRS[ps[e] + p] = 0.f; } }
        if (BOTH(7)) GRID_BAR();
    }
    if (IN(8) || IN(9)) {
        PHASE_IDS
        LAS int* tile_e = (LAS int*)(lds + MISC_OFF + 1024); LAS int* meta = (LAS int*)(lds + MISC_OFF + 512);
        if (tid < 64) {
            const int* CNTE = (const int*)(ws + WS_CTL) + CW_CNTE; const int nt = tid < 32 ? (CNTE[tid] + 255) >> 8 : 0; int inc = nt;
#pragma unroll
            for (int off = 1; off < 32; off <<= 1) { const int p = __shfl_up(inc, off); if (tid >= off) inc += p; }
            for (int i = 0; i < nt; ++i) tile_e[inc - nt + i] = tid;
            if (tid == 31) meta[0] = inc; }
        __syncthreads();
        const int n_mt = meta[0];
        if (IN(8)) {
            pg8::Gemm g{ws + WS_H1B, ws + WS_WGU, DM, (size_t)4096 * DM, (const int*)(sm + SM_ROWTOK), ONE_E8M0, W8_E8M0}; pg8::Order S;
            S.init(n_mt, 16, G, bx, tile_e);
            pg8::EpiMoe1 E{ws + WS_ACT, argin(args, 16)};
            pg8::gemm_phase<pg8::EpiMoe1, true, true, true>(lds, g, S, E, tid);
            if (BOTH(8)) GRID_BAR();
        }
        if (IN(9)) {
            pg8::Gemm g{ws + WS_ACT, ws + WS_WDN, DM, (size_t)DM * DM, nullptr, ACT8_E8M0, W8_E8M0}; pg8::Order S;
            S.init(n_mt, 8, G, bx, tile_e);
            pg8::EpiMoe2 E{ws + WS_YB, argin(args, 18), (const float*)(sm + SM_ROWGATE)};
            pg8::gemm_phase<pg8::EpiMoe2, false, true, true>(lds, g, S, E, tid);
            if (BOTH(9)) GRID_BAR();
        }
    }
    if (IN(10)) {
        PHASE_IDS
        const float* H1 = (const float*)(ws + WS_H1); const unsigned char* YB = ws + WS_YB; bf16* H2 = (bf16*)(ws + WS_H2); unsigned char* H2Q = ws + WS_H2B;
        const int* DEST = (const int*)(sm + SM_DEST); const float* PESSQ = (const float*)(sm + SM_PESSQ);
        for (int t = gw; t < NTOK; t += NGW) { const i32x4 dd = *(const i32x4*)(DEST + t * 4); float ss = 0.f;
            f32x4 hvv[8]; unsigned yv[8][4];
#pragma unroll
            for (int j = 0; j < 8; ++j) { const int col = 4 * lane + 256 * j; hvv[j] = *(const f32x4*)(H1 + (size_t)t * DM + col);
                yv[j][0] = *(const unsigned*)(YB + (size_t)dd[0] * DM + col); yv[j][1] = *(const unsigned*)(YB + (size_t)dd[1] * DM + col); yv[j][2] = *(const unsigned*)(YB + (size_t)dd[2] * DM + col); yv[j][3] = *(const unsigned*)(YB + (size_t)dd[3] * DM + col); }
            asm volatile("" ::: "memory");
#pragma unroll
            for (int j = 0; j < 8; ++j) { const int col = 4 * lane + 256 * j; f32x4 hv = hvv[j]; const unsigned y0 = yv[j][0], y1 = yv[j][1], y2 = yv[j][2], y3 = yv[j][3];
                const f32x2 a0 = __builtin_amdgcn_cvt_pk_f32_fp8(y0, false) + __builtin_amdgcn_cvt_pk_f32_fp8(y1, false) + (__builtin_amdgcn_cvt_pk_f32_fp8(y2, false) + __builtin_amdgcn_cvt_pk_f32_fp8(y3, false));
                const f32x2 a1 = __builtin_amdgcn_cvt_pk_f32_fp8(y0, true) + __builtin_amdgcn_cvt_pk_f32_fp8(y1, true) + (__builtin_amdgcn_cvt_pk_f32_fp8(y2, true) + __builtin_amdgcn_cvt_pk_f32_fp8(y3, true));
                hv[0] += a0[0] * (1.f / YB8_SCALE); hv[1] += a0[1] * (1.f / YB8_SCALE); hv[2] += a1[0] * (1.f / YB8_SCALE); hv[3] += a1[1] * (1.f / YB8_SCALE);
                *(u32x2*)(H2 + (size_t)t * DM + col) = (u32x2){pk2(hv[0], hv[1]), pk2(hv[2], hv[3])}; *(unsigned*)(H2Q + (size_t)t * DM + col) = pk4_fp8(hv[0] * ACT8_SCALE, hv[1] * ACT8_SCALE, hv[2] * ACT8_SCALE, hv[3] * ACT8_SCALE);
                ss += (hv[0] * hv[0] + hv[1] * hv[1]) + (hv[2] * hv[2] + hv[3] * hv[3]); }
            ss = wave_sum(ss); const float ps = wave_sum(lane < 32 ? PESSQ[(size_t)t * 32 + lane] : 0.f);
            if (lane == 0) { ((float*)(sm + SM_RS3))[t] = rsqrtf(ss * (1.f / DM) + EPS); ((float*)(sm + SM_RSPE))[t] = rsqrtf(ps * (1.f / DM) + EPS); } }
        if (BOTH(10)) GRID_BAR();
    }
    if (IN(11)) {
        PHASE_IDS
        pg8::Gemm g{ws + WS_H2B, ws + WS_WPG, DM, 0, nullptr, ACT8_E8M0, W8_E8M0}; pg8::Order S; S.init(NTOK / 256, DM / 256, G, bx, nullptr);
        pg8::EpiPg E{(const bf16*)(ws + WS_H2), (const bf16*)(ws + WS_PE), (const float*)(sm + SM_RS3), (const float*)(sm + SM_RSPE), argin(args, 22), (bf16*)(ws + WS_H3), (float*)(sm + SM_SSQ3)};
        pg8::gemm_phase<pg8::EpiPg, false, true, true>(lds, g, S, E, tid);
        if (BOTH(11)) GRID_BAR();
    }
#ifdef DBG_OUT
    if (IN(12)) {
        PHASE_IDS
        for (int t = gw; t < NTOK; t += NGW) {
#pragma unroll
            for (int j = 0; j < 8; ++j) { const int col = 4 * lane + 256 * j; f32x4 v;
#if DBG_OUT == 1
                { const u32x2 w = *(const u32x2*)((const bf16*)(ws + WS_Z) + (size_t)t * NZ + col); v = (f32x4){bflo(w.x), bfhi(w.x), bflo(w.y), bfhi(w.y)}; }
#elif DBG_OUT == 3
                v = *(const f32x4*)((const float*)(ws + WS_OSC) + (size_t)t * DM + col);
#elif DBG_OUT == 2
                { const size_t idx = (size_t)t * 1024 + (col & 1023);
                  if (col < 1024) v = *(const f32x4*)((const float*)(ws + WS_GU) + idx);
                  else { for (int q = 0; q < 4; ++q) { const size_t ix = idx + q; float a = bf2f(((const bf16*)(ws + WS_MVT))[ix]) + bf2f(((const bf16*)(ws + WS_MKWT))[ix & 8388607]) + bf2f(((const bf16*)(ws + WS_MWT))[ix & 4194303])
                      + bf2f(((const bf16*)(ws + WS_GW))[ix]) + bf2f(((const bf16*)(ws + WS_GKDT))[ix]) + bf2f(((const bf16*)(ws + WS_GQD))[ix]) + bf2f(((const bf16*)(ws + WS_GAT))[ix & 8388607])
                      + ((const float*)(sm + SM_MSI))[ix & 65535] + ((const float*)(sm + SM_MEN))[ix & 65535] + ((const float*)(sm + SM_MWS))[ix & 65535] + ((const float*)(sm + SM_GLAST))[ix & 2047] + ((const float*)(sm + SM_MDEC))[ix & 1023];
                      v[q] = a; } } }
#elif DBG_OUT == 31
                v = col < 1024 ? *(const f32x4*)((const float*)(ws + WS_OSC) + (size_t)t * DM + col) : (f32x4){0.f, 0.f, 0.f, 0.f};
#elif DBG_OUT == 32
                v = col >= 1024 ? *(const f32x4*)((const float*)(ws + WS_OSC) + (size_t)t * DM + col) : (f32x4){0.f, 0.f, 0.f, 0.f};
#elif DBG_OUT == 5
                v = *(const f32x4*)((const float*)(ws + WS_H1) + (size_t)t * DM + col);
#elif DBG_OUT == 10
                v = *(const f32x4*)((const float*)(ws + WS_H2) + (size_t)t * DM + col);
#endif
                *(f32x4*)(args.out + (size_t)t * DM + col) = v; } }
    }
#else
    if (IN(12)) {
        PHASE_IDS
        const bf16* H3 = (const bf16*)(ws + WS_H3); const float* SSQ3 = (const float*)(sm + SM_SSQ3); const float* gf = argin(args, 23);
        for (int t = gw; t < NTOK; t += NGW) { u32x2 hw[8]; f32x4 gv[8];
#pragma unroll
            for (int j = 0; j < 8; ++j) { const int col = 4 * lane + 256 * j; hw[j] = *(const u32x2*)(H3 + (size_t)t * DM + col); gv[j] = *(const f32x4*)(gf + col); }
            const float r = rsqrtf(wave_sum(lane < 32 ? SSQ3[(size_t)t * 32 + lane] : 0.f) * (1.f / DM) + EPS);
#pragma unroll
            for (int j = 0; j < 8; ++j) { const int col = 4 * lane + 256 * j; const f32x4 hv = (f32x4){bflo(hw[j].x), bfhi(hw[j].x), bflo(hw[j].y), bfhi(hw[j].y)};
                *(f32x4*)(args.out + (size_t)t * DM + col) = hv * gv[j] * r; } }
    }
#endif
#ifdef DBG_DET
    if (lo == 13) { PHASE_IDS
        unsigned long long s1 = 0ull, s2 = 0ull;
        auto acc_region = [&](const unsigned* p, size_t nwords) { for (size_t i = (size_t)bx * 512 + tid; i < nwords; i += (size_t)G * 512) { const unsigned w = p[i]; s1 += w; s2 += (unsigned long long)w * ((unsigned)i | 1u); } };
#if DBG_DET == 0
        acc_region((const unsigned*)(ws + WS_WIN), (size_t)(WS_Z - WS_WIN) / 4);
        acc_region((const unsigned*)(sm + SM_RS1), (size_t)(SM_GLAST - SM_RS1) / 4);
#elif DBG_DET == 1
        acc_region((const unsigned*)(ws + WS_Z), (size_t)(WS_GW - WS_Z) / 4);
        acc_region((const unsigned*)(sm + SM_PESSQ), (size_t)(2 << 20) / 4);
#elif DBG_DET == 2
        acc_region((const unsigned*)(ws + WS_GW), (size_t)(WS_OSC - WS_GW) / 4);
        acc_region((const unsigned*)(sm + SM_GLAST), (size_t)(SM_DEN - SM_GLAST) / 4);
#elif DBG_DET == 3
        acc_region((const unsigned*)(ws + WS_OSC), (size_t)(WS_Y - WS_OSC) / 4);
        acc_region((const unsigned*)(sm + SM_DEN), (size_t)(256 << 10) / 4);
#endif
        for (int o = 1; o < 64; o <<= 1) { s1 += __shfl_xor(s1, o); s2 += __shfl_xor(s2, o); }
        if (lane == 0) { unsigned long long* slot = (unsigned long long*)(ws + WS_CTL) + 8192 + 2 * args.aux; atomicAdd(slot, s1); atomicAdd(slot + 1, s2); }
    }
    if (lo == 14) { PHASE_IDS
        const unsigned long long* slot = (const unsigned long long*)(ws + WS_CTL) + 8192;
        const float v = (slot[0] == slot[2] && slot[1] == slot[3]) ? 0.f : 3.f;
        for (size_t i = (size_t)bx * 512 + tid; i < (size_t)NTOK * DM; i += (size_t)G * 512) args.out[i] = v;
    }
#endif
#undef IN
#undef BOTH
}

extern "C" void kernel_launch(void* const* d_in, const int* in_sizes, int n_in, void* d_out, int out_size, void* d_ws, size_t ws_size, hipStream_t stream) {
    static int grid = 0;
    if (grid == 0) {
        if (n_in != 24 || out_size != NTOK * DM || ws_size < WS_END) { fprintf(stderr, "kernel_launch: unexpected problem (n_in %d, out %d, ws %zu)\n", n_in, out_size, ws_size); grid = -1; return; }
        int dev = 0, cus = 0, per_cu = 0;
        if (hipGetDevice(&dev) != hipSuccess || hipDeviceGetAttribute(&cus, hipDeviceAttributeMultiprocessorCount, dev) != hipSuccess) { grid = -1; return; }
        if (hipFuncSetAttribute((const void*)mk_fwd, hipFuncAttributeMaxDynamicSharedMemorySize, LDS_BYTES) != hipSuccess) { fprintf(stderr, "kernel_launch: hipFuncSetAttribute failed\n"); grid = -1; return; }
        if (hipOccupancyMaxActiveBlocksPerMultiprocessor(&per_cu, (const void*)mk_fwd, NWAVES * 64, LDS_BYTES) != hipSuccess || per_cu < 1) fprintf(stderr, "kernel_launch: occupancy query reports %d\n", per_cu);
        (void)hipGetLastError();
        grid = cus;
    }
    if (grid < 0) return;
    (void)hipMemsetAsync((char*)d_ws + WS_CTL, 0, CTL_ZERO_BYTES, stream);
    Args a{};
    for (int i = 0; i < 24; ++i) a.in[i] = (const float*)d_in[i];
    a.out = (float*)d_out; a.ws = (unsigned char*)d_ws;
#ifdef DBG_DET
    for (int rep = 0; rep < 2; ++rep) {
        for (int ph = 0; ph <= DBG_DET; ++ph) { a.ph_lo = ph; a.ph_hi = ph + 1; hipLaunchKernelGGL(mk_fwd, dim3(grid), dim3(NWAVES * 64), LDS_BYTES, stream, a); }
        a.ph_lo = 13; a.ph_hi = 13; a.aux = rep; hipLaunchKernelGGL(mk_fwd, dim3(grid), dim3(NWAVES * 64), LDS_BYTES, stream, a); a.aux = 0;
    }
    a.ph_lo = 14; a.ph_hi = 14; hipLaunchKernelGGL(mk_fwd, dim3(grid), dim3(NWAVES * 64), LDS_BYTES, stream, a);
    return;
#endif
#if MK_SPLIT
#ifndef DUP_MASK
#define DUP_MASK 0u
#endif
    for (int ph = 0; ph < NPHASE; ++ph) { a.ph_lo = ph; a.ph_hi = ph + 1; const int reps = ((DUP_MASK >> ph) & 1u) ? 2 : 1;
        for (int r = 0; r < reps; ++r) { a.aux = (r == 1) ? DUP_AUX : 0; hipLaunchKernelGGL(mk_fwd, dim3(grid), dim3(NWAVES * 64), LDS_BYTES, stream, a); a.aux = 0; } }
#else
    a.ph_lo = 0; a.ph_hi = NPHASE; hipLaunchKernelGGL(mk_fwd, dim3(grid), dim3(NWAVES * 64), LDS_BYTES, stream, a);
#endif
}
```

```cpp
#include <hip/hip_runtime.h>
#include <cstdio>
#include <cstdint>


#ifndef DUP_AUX
#define DUP_AUX 0
#endif
#ifndef P3_DUP
#define P3_DUP 0
#endif
#ifndef P2_DUP
#define P2_DUP 0
#endif
#ifndef MK_SPLIT
#define DUP_MASK 0x0u
#define MK_SPLIT 0
#endif

#define LAS __attribute__((address_space(3)))
typedef unsigned short bf16;
typedef short bf16x8 __attribute__((ext_vector_type(8)));
typedef float f32x4 __attribute__((ext_vector_type(4)));
typedef float f32x2 __attribute__((ext_vector_type(2)));
typedef unsigned u32x4 __attribute__((ext_vector_type(4)));
typedef unsigned u32x2 __attribute__((ext_vector_type(2)));
typedef int i32x8 __attribute__((ext_vector_type(8)));
typedef int i32x4 __attribute__((ext_vector_type(4)));

constexpr int NTOK = 16384, DM = 2048, SEQL = 4096, NCHT = 256  ;
constexpr int DIN = 7192, NZ = 7168, PLE = 256, NEXP = 32;
constexpr int ZQ = 0, ZK = 1024, ZV = 2048, ZG = 3072, ZMQ = 4096, ZMK = 4608, ZMV = 5120, ZMO = 6144;
constexpr int MAXROWS = 73728;
constexpr float EPS = 1e-6f;

constexpr size_t MiB = 1ull << 20;
constexpr size_t WS_CTL = 0, CTL_ZERO_BYTES = 1 * MiB;
constexpr size_t WS_WIN = 1 * MiB, WS_WOUT = 29 * MiB, WS_WPG = 37 * MiB, WS_WPP = 45 * MiB, WS_WGU = 46 * MiB, WS_WDN = 558 * MiB;
constexpr size_t WS_XB = 814 * MiB, WS_PB = 878 * MiB, WS_Z = 886 * MiB, WS_PE = 1110 * MiB;
constexpr size_t WS_GW = 1174 * MiB, WS_GQD = 1206 * MiB, WS_GKDT = 1238 * MiB, WS_GAT = 1270 * MiB, WS_GU = 1286 * MiB;
constexpr size_t WS_MWT = 1350 * MiB, WS_MKWT = 1358 * MiB, WS_MVT = 1374 * MiB;
constexpr size_t WS_OSC = 1406 * MiB, WS_Y = 1534 * MiB, WS_H1 = 1598 * MiB, WS_H1B = 1726 * MiB;
constexpr size_t WS_ACT = 1790 * MiB, WS_YB = 2078 * MiB, WS_H2 = 2366 * MiB, WS_H2B = 2494 * MiB, WS_H3 = 2558 * MiB;
constexpr size_t WS_SMALL = 2686 * MiB;
constexpr size_t WS_WSK = 3038 * MiB;
constexpr size_t WS_GAP = 2718 * MiB, WS_GBB = 2782 * MiB, WS_GSS = 2846 * MiB, WS_MBM = 2910 * MiB, WS_MCS = 2974 * MiB, WS_END = 3039 * MiB;
constexpr size_t SM_RS1 = 0, SM_GC = 64 << 10, SM_BETA = SM_GC + (512 << 10), SM_FC = SM_BETA + (512 << 10), SM_IC = SM_FC + (256 << 10);
constexpr size_t SM_FLAST = SM_IC + (256 << 10), SM_AMAX = SM_FLAST + 4096, SM_GLAST = SM_AMAX + 4096;
constexpr size_t SM_MSI = SM_GLAST + 8192, SM_MEN = SM_MSI + (256 << 10), SM_MWS = SM_MEN + (256 << 10), SM_MDEC = SM_MWS + (256 << 10);
constexpr size_t SM_DEN = SM_MDEC + 4096, SM_PESSQ = SM_DEN + (256 << 10), SM_SSQ1 = SM_PESSQ + (2 << 20), SM_SSQ3 = SM_SSQ1 + (2 << 20);
constexpr size_t SM_RS2 = SM_SSQ3 + (2 << 20), SM_RS3 = SM_RS2 + (64 << 10), SM_RSPE = SM_RS3 + (64 << 10);
constexpr size_t SM_TOPI = SM_RSPE + (64 << 10), SM_TOPG = SM_TOPI + (256 << 10), SM_LRANK = SM_TOPG + (256 << 10), SM_DEST = SM_LRANK + (256 << 10);
constexpr size_t SM_UCNT = SM_DEST + (256 << 10), SM_ROWTOK = SM_UCNT + (32 << 10), SM_ROWGATE = SM_ROWTOK + (288 << 10), SM_ROWRS = SM_ROWGATE + (288 << 10);
constexpr size_t SM_MKS = SM_ROWRS + (288 << 10), SM_MNS = SM_MKS + (512 << 10);
constexpr size_t SM_END = SM_MNS + (512 << 10);
static_assert(SM_END <= 32 * MiB, "small arrays");
constexpr int CW_BAR = 4096, CW_CNTE = 8192, CW_POOL = 8320;

constexpr int RING_BYTES = 131072, MISC_OFF = 139264, LDS_BYTES = 155648;
constexpr int NWAVES = 8;
constexpr int GN_LDS = 134144;

typedef __bf16 bf16v2_t __attribute__((ext_vector_type(2)));
__device__ __forceinline__ unsigned pk2(float lo, float hi) { const f32x2 v = {lo, hi}; return __builtin_bit_cast(unsigned, __builtin_convertvector(v, bf16v2_t)); }
__device__ __forceinline__ bf16 f2bf(float f) { return __builtin_bit_cast(unsigned short, (__bf16)f); }
__device__ __forceinline__ unsigned pk4_fp8(float a, float b, float c, float d) { unsigned w = 0u; w = __builtin_amdgcn_cvt_pk_fp8_f32(a, b, w, false); w = __builtin_amdgcn_cvt_pk_fp8_f32(c, d, w, true); return w; }
constexpr float W8_SCALE = 32.f; constexpr int W8_E8M0 = 0x7a7a7a7a;
constexpr float ACT8_SCALE = 4.f; constexpr int ACT8_E8M0 = 0x7d7d7d7d;
constexpr int ONE_E8M0 = 0x7f7f7f7f;
constexpr float YB8_SCALE = 16.f;
constexpr float Y8_SCALE = 16.f; constexpr int Y8_E8M0 = 0x7b7b7b7b;
__device__ __forceinline__ float bf2f(bf16 b) { return __uint_as_float(((unsigned)b) << 16); }
#define NTL4(p) __builtin_nontemporal_load((const u32x4*)(p))
#define NTL2(p) __builtin_nontemporal_load((const u32x2*)(p))
#define NTL1(p) __builtin_nontemporal_load((const unsigned*)(p))
__device__ __forceinline__ float bflo(unsigned w) { return __uint_as_float(w << 16); }
__device__ __forceinline__ float bfhi(unsigned w) { return __uint_as_float(w & 0xffff0000u); }
__device__ __forceinline__ float wave_sum(float v) {
#pragma unroll
    for (int o = 1; o < 64; o <<= 1) v += __shfl_xor(v, o);
    return v;
}
__device__ __forceinline__ float sigm(float x) { return __builtin_amdgcn_rcpf(1.f + __expf(-x)); }
__device__ __forceinline__ float softplusf(float x) { return fmaxf(x, 0.f) + log1pf(expf(-fabsf(x))); }
#define LDS_WAIT() asm volatile("s_waitcnt lgkmcnt(0)" ::: "memory")

#define XB_TMO      128
#define XB_XCNT(j)  (256  + 64 * (j))
#define XB_XSUB(j)  (1280 + 64 * (j))
#define XB_XGEN(j)  (2304 + 64 * (j))
#define XB_TOP      3328
#define XB_TOPGEN   3392
#define XCD_BAR_WORDS 3456
#define XB_SPIN_CAP (1u << 18)
__device__ __forceinline__ unsigned xb_ld(unsigned* p)              { return __hip_atomic_load(p, __ATOMIC_RELAXED, __HIP_MEMORY_SCOPE_AGENT); }
__device__ __forceinline__ unsigned xb_add(unsigned* p, unsigned v) { return __hip_atomic_fetch_add(p, v, __ATOMIC_RELAXED, __HIP_MEMORY_SCOPE_AGENT); }
__device__ __forceinline__ unsigned xb_xcc_id() { return (unsigned)__builtin_amdgcn_s_getreg((3 << 11) | 20) & 0xFu; }
#define XB_SPIN(cond, bar) do { unsigned _sp = 0; while (cond) { __builtin_amdgcn_s_sleep(1); \
    if ((++_sp & 255u) == 0u) { if (xb_ld(&(bar)[XB_TMO])) break; if (_sp > XB_SPIN_CAP) { atomicAdd(&(bar)[XB_TMO], 1u); break; } } } } while (0)
struct XcdBarrier { unsigned* bar; unsigned x; volatile LAS unsigned* st; };
__device__ __forceinline__ XcdBarrier xcd_barrier_post(unsigned* bar, volatile LAS unsigned* st, bool tid0) {
    XcdBarrier b; b.bar = bar; b.x = xb_xcc_id(); b.st = st;
    if (tid0) (void)xb_add(&bar[XB_XCNT(b.x)], 1u);
    return b;
}
__device__ __forceinline__ void xcd_barrier_complete(unsigned* bar, unsigned x, unsigned& nloc, unsigned& nx) {
    const unsigned G = gridDim.x * gridDim.y * gridDim.z;
    unsigned sum, cnt, mine, sp = 0u;
    for (;;) {
        sum = 0u; cnt = 0u; mine = 0u;
#pragma unroll
        for (unsigned j = 0; j < 16; ++j) { const unsigned c = xb_ld(&bar[XB_XCNT(j)]); sum += c; cnt += (c > 0u) ? 1u : 0u; mine = (j == x) ? c : mine; }
        if (sum == G) break;
        __builtin_amdgcn_s_sleep(1);
        if ((++sp & 255u) == 0u) { if (xb_ld(&bar[XB_TMO])) break; if (sp > XB_SPIN_CAP) { atomicAdd(&bar[XB_TMO], 1u); break; } }
    }
    nloc = mine > 0u ? mine : 1u; nx = cnt > 0u ? cnt : 1u;
}
__device__ __forceinline__ void xcd_barrier(const XcdBarrier& b, bool tid0) {
    asm volatile("s_waitcnt vmcnt(0)" ::: "memory");
    __syncthreads();
    if (tid0) {
        unsigned* bar = b.bar;
        __builtin_amdgcn_s_waitcnt(0);
        unsigned nloc = b.st[0], nx = b.st[1];
        if (nloc == 0u) { xcd_barrier_complete(bar, b.x, nloc, nx); b.st[0] = nloc; b.st[1] = nx; }
        const unsigned old = xb_add(&bar[XB_XSUB(b.x)], 1u);
        const unsigned gen = old / nloc;
        if (old + 1u == (gen + 1u) * nloc) {
            __builtin_amdgcn_fence(__ATOMIC_RELEASE, "agent");
            asm volatile("s_waitcnt vmcnt(0)" ::: "memory");
            const unsigned og = xb_add(&bar[XB_TOP], 1u);
            const unsigned tg = og / nx;
            if (og + 1u == (tg + 1u) * nx) xb_add(&bar[XB_TOPGEN], 1u);
            else XB_SPIN(xb_ld(&bar[XB_TOPGEN]) == tg, bar);
            __builtin_amdgcn_fence(__ATOMIC_ACQUIRE, "agent");
            xb_add(&bar[XB_XGEN(b.x)], 1u);
            asm volatile("s_waitcnt vmcnt(0)" ::: "memory");
        } else {
            XB_SPIN(xb_ld(&bar[XB_XGEN(b.x)]) == gen, bar);
            __builtin_amdgcn_fence(__ATOMIC_ACQUIRE, "agent");
            asm volatile("s_waitcnt vmcnt(0)" ::: "memory");
        }
    }
    __syncthreads();
}

namespace pg8 {
constexpr int EPI_LDS = 143360;

constexpr int BM = 256, BK = 64, HALF = 128, HTB = HALF * BK * 2, STAGE_BYTES = 8 * HTB, NXCD = 8, WGM = 8;
__host__ __device__ __forceinline__ int lds_byte(int r, int c) { const int st = (r >> 4) * 2 + (c >> 5), rr = r & 15, cc = c & 31, ob = rr * 64 + cc * 2; return st * 1024 + (ob ^ (((ob >> 9) & 1) << 5)); }
__host__ __device__ __forceinline__ void stage_rc(int b, int& R, int& C) { const int st = b / 1024, sb = b % 1024, swz = sb ^ (((sb >> 9) & 1) << 5); R = (st >> 1) * 16 + swz / 64; C = (st & 1) * 32 + (swz % 64) / 2; }
__host__ __device__ __forceinline__ int perm32(int rho) { const int n = rho >> 4, i = rho & 15; return 8 * (i >> 2) + 4 * n + (i & 3); }
struct Unit { int pm, pn, e; };
struct Gemm { const void* A; const void* Bt; int K; size_t bstride; const int* rowtab; int sclA, sclB; };
struct Order {
    int nM, nN, nwg, G, c, wgm; const LAS int* tile_e;
    __device__ __forceinline__ void init(int nM_, int nN_, int G_, int c_, const LAS int* te, int wgm_ = WGM) { nM = nM_; nN = nN_; nwg = nM * nN; G = G_; c = c_; tile_e = te; wgm = wgm_; }
    __device__ __forceinline__ bool next(int i, Unit& u) const {
        const long L = (long)i * G + c; if (L >= nwg) return false;
        int wgid = (int)L; { const int q = nwg / NXCD, r = nwg % NXCD, xcd = wgid % NXCD, off = wgid / NXCD; wgid = (xcd < r ? xcd * (q + 1) : r * (q + 1) + (xcd - r) * q) + off; }
        const int nig = wgm * nN, gid = wgid / nig, fm = gid * wgm, gsz = (nM - fm) < wgm ? (nM - fm) : wgm;
        u.pm = fm + ((wgid % nig) % gsz); u.pn = (wgid % nig) / gsz; u.e = tile_e ? tile_e[u.pm] : 0; return true;
    }
};

struct ListOrder {
    const LAS int* ul;
    __device__ __forceinline__ bool next(int i, Unit& u) const { const int pm = ul[4 * i]; if (pm < 0) return false; u.pm = pm; u.pn = ul[4 * i + 1]; u.e = ul[4 * i + 2]; return true; }
};

template <class Epi, bool GATHER, bool ALIGN_EPI, bool FP8 = false, class Ord = Order>
__device__ __forceinline__ void gemm_phase(LAS unsigned char* lds, const Gemm g, const Ord& S, const Epi& E, const int tid) {
    const int wid = __builtin_amdgcn_readfirstlane(tid >> 6), lane = tid & 63, wr = wid >> 2, wc = wid & 3, fr = lane & 15, fq = lane >> 4;
    const int K = g.K, nt = K / 128;
    unsigned voffA[2], voffB[2]; int Rg[2], Cg[2];
#pragma unroll
    for (int i = 0; i < 2; ++i) { int R, C; stage_rc(tid * 16 + i * 8192, R, C); const int Rb = Epi::PERM ? ((R & ~31) + perm32(R & 31)) : R;
        voffA[i] = (unsigned)(R * K + C * 2); voffB[i] = (unsigned)(Rb * K + C * 2); Rg[i] = R; Cg[i] = C; }
    unsigned vAc[2][2], vAn[2][2];
    const size_t kstep = (size_t)128;
    const size_t hstep = (size_t)HALF * K;
    const size_t tstep = 2 * hstep;
    const unsigned ldsw = (unsigned)wid * 1024u;
    const int aoff = lds_byte(wr * 64 + fr, fq * 8), boff = lds_byte(wc * 32 + fr, fq * 8);
    const int lc1 = 2 * (fq & 1);
    const int aoff8a = lds_byte(wr * 64 + fr, (fq >> 1) * 32 + lc1 * 8), aoff8b = lds_byte(wr * 64 + fr, (fq >> 1) * 32 + (lc1 ^ 1) * 8);
    const int boff8a = lds_byte(wc * 32 + fr, (fq >> 1) * 32 + lc1 * 8), boff8b = lds_byte(wc * 32 + fr, (fq >> 1) * 32 + (lc1 ^ 1) * 8);
#define PG8_SA(b, h) (((b) * 2 + (h)) * HTB)
#define PG8_SB(b, h) ((4 + (b) * 2 + (h)) * HTB)
#define PG8_STAGE(bufoff, gbase, voff) do { _Pragma("unroll") for (int _i = 0; _i < 2; ++_i) \
        __builtin_amdgcn_global_load_lds((const unsigned*)((const char*)(gbase) + (voff)[_i]), (LAS unsigned*)(lds + (bufoff) + ldsw + _i * 8192), 16, 0, 0); } while (0)
#define PG8_STAGE_A(bufoff, kp, h, nx) do { if constexpr (GATHER) { _Pragma("unroll") for (int _i = 0; _i < 2; ++_i) { const unsigned _vo = (nx) ? vAn[h][_i] : vAc[h][_i]; \
        __builtin_amdgcn_global_load_lds((const unsigned*)((const char*)(kp) + _vo), (LAS unsigned*)(lds + (bufoff) + ldsw + _i * 8192), 16, 0, 0); } } \
        else { PG8_STAGE(bufoff, (kp) + (h) * hstep, voffA); } } while (0)
#define PG8_LD8(base, o1, o2) __builtin_shufflevector(*(const LAS i32x4*)(lds + (base) + (o1)), *(const LAS i32x4*)(lds + (base) + (o2)), 0, 1, 2, 3, 4, 5, 6, 7)
#define PG8_LDA(dst, b, h) do { if constexpr (FP8) { _Pragma("unroll") for (int m = 0; m < 4; ++m) dst##8[m] = PG8_LD8(PG8_SA(b, h) + m * 2048, aoff8a, aoff8b); } \
        else { _Pragma("unroll") for (int m = 0; m < 4; ++m) _Pragma("unroll") for (int k = 0; k < 2; ++k) dst[m][k] = *(const LAS bf16x8*)(lds + PG8_SA(b, h) + aoff + m * 2048 + k * 1024); } } while (0)
#define PG8_LDB(dst, b, h) do { if constexpr (FP8) { _Pragma("unroll") for (int n = 0; n < 2; ++n) dst##8[n] = PG8_LD8(PG8_SB(b, h) + n * 2048, boff8a, boff8b); } \
        else { _Pragma("unroll") for (int n = 0; n < 2; ++n) _Pragma("unroll") for (int k = 0; k < 2; ++k) dst[n][k] = *(const LAS bf16x8*)(lds + PG8_SB(b, h) + boff + n * 2048 + k * 1024); } } while (0)
#define PG8_MMA(ai, bj, At, Bt) do { __builtin_amdgcn_s_setprio(1); if constexpr (FP8) { _Pragma("unroll") for (int m = 0; m < 4; ++m) _Pragma("unroll") for (int n = 0; n < 2; ++n) \
        asm volatile("v_mfma_scale_f32_16x16x128_f8f6f4 %0, %1, %2, %0, %3, %4 op_sel_hi:[0,0,0]" : "+v"(acc[ai][bj][m][n]) : "v"(Bt##8[n]), "v"(At##8[m]), "v"(sclBv), "v"(sclAv)); } \
        else { _Pragma("unroll") for (int m = 0; m < 4; ++m) _Pragma("unroll") for (int n = 0; n < 2; ++n) _Pragma("unroll") for (int k = 0; k < 2; ++k) \
        acc[ai][bj][m][n] = __builtin_amdgcn_mfma_f32_16x16x32_bf16(Bt[n][k], At[m][k], acc[ai][bj][m][n], 0, 0, 0); } __builtin_amdgcn_s_setprio(0); } while (0)
#define PG8_WAIT_V(n) asm volatile("s_waitcnt vmcnt(" #n ")" ::: "memory")
#define PG8_WAIT_L(n) asm volatile("s_waitcnt lgkmcnt(" #n ")" ::: "memory")
#define PG8_BAR __builtin_amdgcn_s_barrier()
#define PG8_SCHED __builtin_amdgcn_sched_barrier(0)
#define PG8_GOFF(dst, u) do { if constexpr (GATHER) { _Pragma("unroll") for (int _h = 0; _h < 2; ++_h) _Pragma("unroll") for (int _i = 0; _i < 2; ++_i) \
        dst[_h][_i] = (unsigned)g.rowtab[(u).pm * BM + _h * HALF + Rg[_i]] * (unsigned)K + (unsigned)(Cg[_i] * 2); } } while (0)
    Unit cur, nxt; int ui = 0;
    if (!S.next(0, cur)) return;
    f32x4 acc[2][2][4][2];
#pragma unroll
    for (int a = 0; a < 2; ++a)
#pragma unroll
        for (int b = 0; b < 2; ++b)
#pragma unroll
            for (int m = 0; m < 4; ++m)
#pragma unroll
                for (int n = 0; n < 2; ++n) acc[a][b][m][n] = (f32x4){0.f, 0.f, 0.f, 0.f};
    bf16x8 At[4][2], B0[2][2], B1[2][2]; i32x8 At8[4], B08[2], B18[2];
    const int sclAv = g.sclA, sclBv = g.sclB;
    PG8_GOFF(vAc, cur);
#pragma unroll
    for (int _h = 0; _h < 2; ++_h)
#pragma unroll
        for (int _i = 0; _i < 2; ++_i) vAn[_h][_i] = vAc[_h][_i];
    const char* cA = GATHER ? (const char*)g.A : (const char*)g.A + (size_t)cur.pm * tstep;
    const char* cB = (const char*)g.Bt + (size_t)cur.e * g.bstride + (size_t)cur.pn * tstep;
    PG8_STAGE(PG8_SB(0, 0), cB, voffB); PG8_STAGE(PG8_SB(0, 1), cB + hstep, voffB); PG8_STAGE_A(PG8_SA(0, 0), cA, 0, false); PG8_STAGE_A(PG8_SA(0, 1), cA, 1, false);
    if (wr == 1) PG8_BAR;
    PG8_WAIT_V(2); PG8_BAR;
    PG8_STAGE(PG8_SB(1, 0), cB + kstep, voffB); PG8_STAGE_A(PG8_SA(1, 0), cA + kstep, 0, false); PG8_STAGE(PG8_SB(1, 1), cB + hstep + kstep, voffB);
    PG8_WAIT_V(6); PG8_BAR;
    for (;;) {
        const bool has_next = S.next(ui + 1, nxt);
        if (has_next) { PG8_GOFF(vAn, nxt); }
        E.pre(lds, cur, tid, ui);
        const char* nA = GATHER ? (const char*)g.A : (has_next ? (const char*)g.A + (size_t)nxt.pm * tstep : cA);
        const char* nB = has_next ? (const char*)g.Bt + (size_t)nxt.e * g.bstride + (size_t)nxt.pn * tstep : cB;
        for (int t = 0; t < nt; t += 2) {
            const bool last = (t == nt - 2);
            const char* a1 = cA + (size_t)(t + 1) * kstep;
            const char* a2 = last ? nA : cA + (size_t)(t + 2) * kstep; const char* b2 = last ? nB : cB + (size_t)(t + 2) * kstep;
            const char* a3 = a2 + kstep; const char* b3 = b2 + kstep;
            PG8_LDB(B0, 0, 0); PG8_LDB(B1, 0, 1); PG8_SCHED; PG8_LDA(At, 0, 0); PG8_STAGE_A(PG8_SA(1, 1), a1, 1, false);
            PG8_WAIT_V(8); PG8_WAIT_L(0); PG8_BAR; PG8_MMA(0, 0, At, B0); PG8_MMA(0, 1, At, B1); PG8_BAR; PG8_SCHED;
            PG8_LDA(At, 0, 1); PG8_STAGE(PG8_SB(0, 0), b2, voffB); PG8_STAGE(PG8_SB(0, 1), b2 + hstep, voffB); PG8_STAGE_A(PG8_SA(0, 0), a2, 0, last);
            PG8_WAIT_V(8); PG8_WAIT_L(0); PG8_BAR; PG8_MMA(1, 0, At, B0); PG8_MMA(1, 1, At, B1); PG8_BAR; PG8_SCHED;
            PG8_LDB(B0, 1, 0); PG8_LDB(B1, 1, 1); PG8_SCHED; PG8_LDA(At, 1, 0); PG8_STAGE_A(PG8_SA(0, 1), a2, 1, last);
            PG8_WAIT_V(8); PG8_WAIT_L(0); PG8_BAR; PG8_MMA(0, 0, At, B0); PG8_MMA(0, 1, At, B1); PG8_BAR; PG8_SCHED;
            PG8_LDA(At, 1, 1); PG8_STAGE(PG8_SB(1, 0), b3, voffB); PG8_STAGE(PG8_SB(1, 1), b3 + hstep, voffB); PG8_STAGE_A(PG8_SA(1, 0), a3, 0, last);
            PG8_WAIT_V(8); PG8_WAIT_L(0); PG8_BAR; PG8_MMA(1, 0, At, B0); PG8_MMA(1, 1, At, B1); PG8_BAR; PG8_SCHED;
        }
        if constexpr (ALIGN_EPI) { if (wr == 0) PG8_BAR; }
        E(acc, cur, wr, wc, fr, fq, lds, ui);
        if (!has_next) break;
#pragma unroll
        for (int a = 0; a < 2; ++a)
#pragma unroll
            for (int b = 0; b < 2; ++b)
#pragma unroll
                for (int m = 0; m < 4; ++m)
#pragma unroll
                    for (int n = 0; n < 2; ++n) acc[a][b][m][n] = (f32x4){0.f, 0.f, 0.f, 0.f};
        cur = nxt; cA = nA; cB = nB; ++ui;
#pragma unroll
        for (int _h = 0; _h < 2; ++_h)
#pragma unroll
            for (int _i = 0; _i < 2; ++_i) vAc[_h][_i] = vAn[_h][_i];
        if constexpr (ALIGN_EPI) { if (wr == 1) PG8_BAR; }
    }
    PG8_WAIT_V(0);
    if constexpr (!ALIGN_EPI) { if (wr == 0) PG8_BAR; }
    PG8_BAR;
#undef PG8_SA
#undef PG8_SB
#undef PG8_STAGE
#undef PG8_STAGE_A
#undef PG8_LDA
#undef PG8_LDB
#undef PG8_MMA
#undef PG8_LD8
#undef PG8_WAIT_V
#undef PG8_WAIT_L
#undef PG8_BAR
#undef PG8_SCHED
#undef PG8_GOFF
}

typedef const f32x4 (&AccRef)[2][2][4][2];

struct EpiZ {
    static constexpr bool PERM = true;
    bf16* Z; int ldc; const float* rs;
    __device__ __forceinline__ void pre(LAS unsigned char*, const Unit&, int, int) const {}
    __device__ __forceinline__ void operator()(AccRef acc, const Unit& u, int wr, int wc, int fr, int fq, LAS unsigned char* lds, int ui) const {
        const int row0 = u.pm * BM + wr * 64 + fr, col0 = u.pn * BM + wc * 32 + 8 * fq;
#pragma unroll
        for (int ai = 0; ai < 2; ++ai)
#pragma unroll
            for (int m = 0; m < 4; ++m) { const int r = row0 + ai * HALF + m * 16; bf16* rowp = Z + (size_t)r * ldc + col0;
#pragma unroll
                for (int bj = 0; bj < 2; ++bj) { const f32x4 v0 = acc[ai][bj][m][0], v1 = acc[ai][bj][m][1];
                    u32x4 w; w.x = pk2(v0[0], v0[1]); w.y = pk2(v0[2], v0[3]); w.z = pk2(v1[0], v1[1]); w.w = pk2(v1[2], v1[3]);
                    *(u32x4*)(rowp + bj * HALF) = w; } }
    }
};
struct EpiPe {
    static constexpr bool PERM = true;
    bf16* O; float* ssq;
    __device__ __forceinline__ void pre(LAS unsigned char*, const Unit&, int, int) const {}
    __device__ __forceinline__ void operator()(AccRef acc, const Unit& u, int wr, int wc, int fr, int fq, LAS unsigned char* lds, int ui) const {
        const int row0 = u.pm * BM + wr * 64 + fr, col0 = u.pn * BM + wc * 32 + 8 * fq;
#pragma unroll
        for (int ai = 0; ai < 2; ++ai)
#pragma unroll
            for (int m = 0; m < 4; ++m) { const int r = row0 + ai * HALF + m * 16; bf16* rowp = O + (size_t)r * DM + col0; float ss = 0.f;
#pragma unroll
                for (int bj = 0; bj < 2; ++bj) { const f32x4 v0 = acc[ai][bj][m][0], v1 = acc[ai][bj][m][1];
                    ss += (v0[0] * v0[0] + v0[1] * v0[1]) + (v0[2] * v0[2] + v0[3] * v0[3]) + (v1[0] * v1[0] + v1[1] * v1[1]) + (v1[2] * v1[2] + v1[3] * v1[3]);
                    u32x4 w; w.x = pk2(v0[0], v0[1]); w.y = pk2(v0[2], v0[3]); w.z = pk2(v1[0], v1[1]); w.w = pk2(v1[2], v1[3]);
                    *(u32x4*)(rowp + bj * HALF) = w; }
                ss += __shfl_xor(ss, 16); ss += __shfl_xor(ss, 32);
                if (fq == 0) ssq[(size_t)r * 32 + u.pn * 4 + wc] = ss; }
    }
};
struct EpiOut {
    static constexpr bool PERM = true;
    const bf16* XB; bf16* H; float* ssq; const float* rs1;
    __device__ __forceinline__ void pre(LAS unsigned char*, const Unit&, int, int) const {}
    __device__ __forceinline__ void operator()(AccRef acc, const Unit& u, int wr, int wc, int fr, int fq, LAS unsigned char* lds, int ui) const {
        const int row0 = u.pm * BM + wr * 64 + fr, col0 = u.pn * BM + wc * 32 + 8 * fq;
#pragma unroll
        for (int ai = 0; ai < 2; ++ai) { u32x4 xv[4][2]; float rsv[4];
#pragma unroll
            for (int m = 0; m < 4; ++m) { rsv[m] = rs1[row0 + ai * HALF + m * 16];
#pragma unroll
                for (int bj = 0; bj < 2; ++bj) xv[m][bj] = *(const u32x4*)(XB + (size_t)(row0 + ai * HALF + m * 16) * DM + col0 + bj * HALF); }
            asm volatile("" ::: "memory");
#pragma unroll
            for (int m = 0; m < 4; ++m) { const int r = row0 + ai * HALF + m * 16; bf16* rowp = H + (size_t)r * DM + col0; float ss = 0.f; const float ir = __builtin_amdgcn_rcpf(rsv[m]);
#pragma unroll
                for (int bj = 0; bj < 2; ++bj) { f32x4 v0 = acc[ai][bj][m][0], v1 = acc[ai][bj][m][1]; const u32x4 xw = xv[m][bj];
                    v0[0] += bflo(xw.x) * ir; v0[1] += bfhi(xw.x) * ir; v0[2] += bflo(xw.y) * ir; v0[3] += bfhi(xw.y) * ir; v1[0] += bflo(xw.z) * ir; v1[1] += bfhi(xw.z) * ir; v1[2] += bflo(xw.w) * ir; v1[3] += bfhi(xw.w) * ir;
                    ss += (v0[0] * v0[0] + v0[1] * v0[1]) + (v0[2] * v0[2] + v0[3] * v0[3]) + (v1[0] * v1[0] + v1[1] * v1[1]) + (v1[2] * v1[2] + v1[3] * v1[3]);
                    u32x4 w; w.x = pk2(v0[0], v0[1]); w.y = pk2(v0[2], v0[3]); w.z = pk2(v1[0], v1[1]); w.w = pk2(v1[2], v1[3]);
                    *(u32x4*)(rowp + bj * HALF) = w; }
                ss += __shfl_xor(ss, 16); ss += __shfl_xor(ss, 32);
                if (fq == 0) ssq[(size_t)r * 32 + u.pn * 4 + wc] = ss; } }
    }
};
struct EpiMoe1 {
    static constexpr bool PERM = true;
    unsigned char* ACT; const float* bgu;
    __device__ __forceinline__ void pre(LAS unsigned char* lds, const Unit& u, int tid, int ui) const { if (tid < 64) *(LAS f32x4*)(lds + EPI_LDS + (ui & 1) * 2048 + 16 * tid) = *(const f32x4*)(bgu + (size_t)u.e * 4096 + 2 * (u.pn * HALF) + 4 * tid); }
    __device__ __forceinline__ void operator()(AccRef acc, const Unit& u, int wr, int wc, int fr, int fq, LAS unsigned char* lds, int ui) const {
        const int row0 = u.pm * BM + wr * 64 + fr, j0 = u.pn * HALF + wc * 32 + 8 * fq;
        const LAS f32x4* bq = (const LAS f32x4*)(lds + EPI_LDS + (ui & 1) * 2048 + 8 * (wc * 32 + 8 * fq));
        const f32x4 b0 = bq[0], b1 = bq[1], b2 = bq[2], b3 = bq[3];
        const float bg[8] = {b0[0], b0[2], b1[0], b1[2], b2[0], b2[2], b3[0], b3[2]}, bu[8] = {b0[1], b0[3], b1[1], b1[3], b2[1], b2[3], b3[1], b3[3]};
#pragma unroll
        for (int ai = 0; ai < 2; ++ai)
#pragma unroll
            for (int m = 0; m < 4; ++m) { const int r = row0 + ai * HALF + m * 16; float o[8];
#pragma unroll
                for (int n = 0; n < 2; ++n)
#pragma unroll
                    for (int q = 0; q < 4; ++q) { float gt = acc[ai][0][m][n][q] + bg[4 * n + q], up = acc[ai][1][m][n][q] + bu[4 * n + q];
                        gt = fminf(gt, 7.f); up = fminf(fmaxf(up, -7.f), 7.f); o[4 * n + q] = gt * sigm(1.702f * gt) * (up + 1.f) * ACT8_SCALE; }
                u32x2 w; w.x = pk4_fp8(o[0], o[1], o[2], o[3]); w.y = pk4_fp8(o[4], o[5], o[6], o[7]);
                *(u32x2*)(ACT + (size_t)r * DM + j0) = w; }
    }
};
struct EpiMoe2 {
    static constexpr bool PERM = true;
    unsigned char* YB; const float* bdn; const float* rowgate;
    __device__ __forceinline__ void pre(LAS unsigned char* lds, const Unit& u, int tid, int ui) const { if (tid < 64) { LAS unsigned char* b = lds + EPI_LDS + (ui & 1) * 2048 + 16 * tid;
        *(LAS f32x4*)b = *(const f32x4*)(bdn + (size_t)u.e * DM + u.pn * BM + 4 * tid); *(LAS f32x4*)(b + 1024) = *(const f32x4*)(rowgate + (size_t)u.pm * BM + 4 * tid); } }
    __device__ __forceinline__ void operator()(AccRef acc, const Unit& u, int wr, int wc, int fr, int fq, LAS unsigned char* lds, int ui) const {
        const int row0 = u.pm * BM + wr * 64 + fr, col0 = u.pn * BM + wc * 32 + 8 * fq;
        const LAS unsigned char* eb = lds + EPI_LDS + (ui & 1) * 2048;
        f32x4 bv[2][2];
#pragma unroll
        for (int bj = 0; bj < 2; ++bj)
#pragma unroll
            for (int n = 0; n < 2; ++n) bv[bj][n] = *(const LAS f32x4*)(eb + 4 * (bj * HALF + wc * 32 + 8 * fq + 4 * n));
#pragma unroll
        for (int ai = 0; ai < 2; ++ai)
#pragma unroll
            for (int m = 0; m < 4; ++m) { const int r = row0 + ai * HALF + m * 16; const float gt = *(const LAS float*)(eb + 1024 + 4 * (wr * 64 + fr + ai * HALF + m * 16)) * YB8_SCALE; unsigned char* rowp = YB + (size_t)r * DM + col0;
#pragma unroll
                for (int bj = 0; bj < 2; ++bj) { const f32x4 v0 = (acc[ai][bj][m][0] + bv[bj][0]) * gt, v1 = (acc[ai][bj][m][1] + bv[bj][1]) * gt;
                    *(u32x2*)(rowp + bj * HALF) = (u32x2){pk4_fp8(v0[0], v0[1], v0[2], v0[3]), pk4_fp8(v1[0], v1[1], v1[2], v1[3])}; } }
    }
};
struct EpiPg {
    static constexpr bool PERM = true;
    const bf16* H2; const bf16* PE; const float* rs3; const float* rspe; const float* gpost; bf16* H3; float* ssq;
    __device__ __forceinline__ void pre(LAS unsigned char*, const Unit&, int, int) const {}
    __device__ __forceinline__ void operator()(AccRef acc, const Unit& u, int wr, int wc, int fr, int fq, LAS unsigned char* lds, int ui) const {
        const int row0 = u.pm * BM + wr * 64 + fr, col0 = u.pn * BM + wc * 32 + 8 * fq;
#pragma unroll
        for (int ai = 0; ai < 2; ++ai)
#pragma unroll
            for (int m = 0; m < 4; ++m) { const int r = row0 + ai * HALF + m * 16; const size_t off = (size_t)r * DM + col0; const float s3 = rs3[r], sp = rspe[r]; float ss = 0.f;
#pragma unroll
                for (int bj = 0; bj < 2; ++bj) { const size_t o = off + bj * HALF; const f32x4 gp0 = *(const f32x4*)(gpost + col0 + bj * HALF), gp1 = *(const f32x4*)(gpost + col0 + bj * HALF + 4);
                    const u32x4 pw = *(const u32x4*)(PE + o), hw = *(const u32x4*)(H2 + o); const f32x4 a0 = acc[ai][bj][m][0] * s3, a1 = acc[ai][bj][m][1] * s3;
                    float h[8];
                    h[0] = bflo(hw.x) + sigm(a0[0]) * (bflo(pw.x) * sp * gp0[0]); h[1] = bfhi(hw.x) + sigm(a0[1]) * (bfhi(pw.x) * sp * gp0[1]);
                    h[2] = bflo(hw.y) + sigm(a0[2]) * (bflo(pw.y) * sp * gp0[2]); h[3] = bfhi(hw.y) + sigm(a0[3]) * (bfhi(pw.y) * sp * gp0[3]);
                    h[4] = bflo(hw.z) + sigm(a1[0]) * (bflo(pw.z) * sp * gp1[0]); h[5] = bfhi(hw.z) + sigm(a1[1]) * (bfhi(pw.z) * sp * gp1[1]);
                    h[6] = bflo(hw.w) + sigm(a1[2]) * (bflo(pw.w) * sp * gp1[2]); h[7] = bfhi(hw.w) + sigm(a1[3]) * (bfhi(pw.w) * sp * gp1[3]);
                    *(u32x4*)(H3 + o) = (u32x4){pk2(h[0], h[1]), pk2(h[2], h[3]), pk2(h[4], h[5]), pk2(h[6], h[7])};
                    ss += ((h[0] * h[0] + h[1] * h[1]) + (h[2] * h[2] + h[3] * h[3])) + ((h[4] * h[4] + h[5] * h[5]) + (h[6] * h[6] + h[7] * h[7])); }
                ss += __shfl_xor(ss, 16); ss += __shfl_xor(ss, 32);
                if (fq == 0) ssq[(size_t)r * 32 + u.pn * 4 + wc] = ss; }
    }
};
}

__device__ __forceinline__ bf16x8 frag(const LAS bf16* base, int row0, int ld, int k0, int lane) {
    return *(const LAS bf16x8*)(base + (row0 + (lane & 15)) * ld + k0 + 8 * (lane >> 4));
}
#define MMA16(a, b, c) __builtin_amdgcn_mfma_f32_16x16x32_bf16(a, b, c, 0, 0, 0)

struct Args { const float* in[24]; float* out; unsigned char* ws; int ph_lo, ph_hi, aux, pad; };
__device__ __forceinline__ const float* argin(const Args& a, int k) { asm volatile("" : "+s"(k)); return a.in[k]; }

__device__ __forceinline__ void tr_tile(const float* W, int ldn, int c0, int k0, const float* g, bf16* WT, int K, int d0, int mode, int lane) {
    const int kk = lane >> 4, n4 = lane & 15;
    const float* src = W + (size_t)(k0 + 16 * kk) * ldn + c0 + 4 * n4;
    f32x4 v[16];
#pragma unroll
    for (int i = 0; i < 16; ++i) v[i] = __builtin_nontemporal_load((const f32x4*)(src + (size_t)i * ldn));
    if (g) { const f32x4* gp = (const f32x4*)(g + k0 + 16 * kk);
#pragma unroll
        for (int i4 = 0; i4 < 4; ++i4) { const f32x4 gv = gp[i4];
#pragma unroll
            for (int e = 0; e < 4; ++e) v[4 * i4 + e] = v[4 * i4 + e] * gv[e]; } }
#pragma unroll
    for (int q = 0; q < 4; ++q) { const int j = 4 * n4 + q; int dr; if (mode == 0) dr = d0 + j; else { const int jj = (c0 + j) >> 1; dr = 256 * (jj >> 7) + (jj & 127) + 128 * (j & 1); }
        u32x4 o0, o1;
        o0.x = pk2(v[0][q], v[1][q]); o0.y = pk2(v[2][q], v[3][q]); o0.z = pk2(v[4][q], v[5][q]); o0.w = pk2(v[6][q], v[7][q]);
        o1.x = pk2(v[8][q], v[9][q]); o1.y = pk2(v[10][q], v[11][q]); o1.z = pk2(v[12][q], v[13][q]); o1.w = pk2(v[14][q], v[15][q]);
        bf16* dst = WT + (size_t)dr * K + k0 + 16 * kk; *(u32x4*)dst = o0; *(u32x4*)(dst + 8) = o1; }
}
__device__ __forceinline__ int win_src_col(int n) { return n < 3072 ? n : (n < 6144 ? n + 16 : n + 24); }

__device__ __forceinline__ void p0_weights(const Args& a, int gw, int NGW, int lane) {
    unsigned char* ws = a.ws;
    constexpr int I_WIN = 112 * 32, I_WPP = 32 * 4, I_WOUT = 32 * 32;
    for (int it = gw; it < I_WIN + I_WPP + I_WOUT; it += NGW) {
        int r = it;
        if (r >= I_WIN + I_WPP) { r -= I_WIN + I_WPP; const int kb = r >> 5, nb = r & 31; tr_tile(argin(a, 11), DM, 64 * nb, 64 * kb, nullptr, (bf16*)(ws + WS_WOUT), DM, 64 * nb, 0, lane); continue; }
        if (r < I_WIN) { const int kb = r / 112, nb = r - kb * 112; tr_tile(argin(a, 3), DIN, win_src_col(64 * nb), 64 * kb, argin(a, 2), (bf16*)(ws + WS_WIN), DM, 64 * nb, 0, lane); continue; } r -= I_WIN;
        { const int kb = r >> 5, nb = r & 31; tr_tile(argin(a, 21), DM, 64 * nb, 64 * kb, nullptr, (bf16*)(ws + WS_WPP), PLE, 64 * nb, 0, lane); }
    }
}
constexpr int POOL_WGU = 32 * 16 * 16, POOL_WDN = 32 * 16 * 8, POOL_WPG = 16 * 8, NPOOL = POOL_WGU + POOL_WDN + POOL_WPG;
struct PoolTile { const float* W; const float* g; unsigned char* WT; int ldn, c0, k0, d0, mode; };
__device__ __forceinline__ void pool_tile_desc(const Args& a, int r, PoolTile& t) {
    unsigned char* ws = a.ws;
    if (r < POOL_WGU) { const int e = r >> 8, kb = (r >> 4) & 15, nb = r & 15; t.W = argin(a, 15) + (size_t)e * DM * 4096; t.g = argin(a, 12); t.WT = ws + WS_WGU + (size_t)e * 4096 * DM; t.ldn = 4096; t.c0 = 256 * nb; t.k0 = 128 * kb; t.d0 = 0; t.mode = 1; return; } r -= POOL_WGU;
    if (r < POOL_WDN) { const int e = r >> 7, kb = (r >> 3) & 15, nb = r & 7; t.W = argin(a, 17) + (size_t)e * DM * DM; t.g = nullptr; t.WT = ws + WS_WDN + (size_t)e * DM * DM; t.ldn = DM; t.c0 = 256 * nb; t.k0 = 128 * kb; t.d0 = 256 * nb; t.mode = 0; return; } r -= POOL_WDN;
    { const int kb = r >> 3, nb = r & 7; t.W = argin(a, 20); t.g = argin(a, 19); t.WT = ws + WS_WPG; t.ldn = DM; t.c0 = 256 * nb; t.k0 = 128 * kb; t.d0 = 256 * nb; t.mode = 0; }
}
#define POOL_LOAD(t, v) do { const float* _src = (t).W + (size_t)((t).k0 + 16 * wid) * (t).ldn + (t).c0 + 4 * lane; _Pragma("unroll") for (int _i = 0; _i < 16; ++_i) (v)[_i] = __builtin_nontemporal_load((const f32x4*)(_src + (size_t)_i * (t).ldn)); } while (0)
__device__ __forceinline__ void convert_pool(const Args& a, LAS unsigned char* lds, int tid, int wid, int lane) {
    unsigned* ctr = (unsigned*)(a.ws + WS_CTL) + CW_POOL + (a.aux == 6 ? 64 : 0);
    LAS unsigned char* T = lds;
    LAS int* nxt = (LAS int*)(lds + 40960);
    f32x4 v[16]; PoolTile cur, nx; int have;
    if (tid == 0) nxt[0] = (int)__hip_atomic_fetch_add(ctr, 1u, __ATOMIC_RELAXED, __HIP_MEMORY_SCOPE_AGENT);
    __syncthreads();
    int r = __builtin_amdgcn_readfirstlane(nxt[0]); have = r < NPOOL;
    if (have) { pool_tile_desc(a, r, cur); POOL_LOAD(cur, v); }
    int slot = 1;
    while (have) {
        if (tid == 0) nxt[slot] = (int)__hip_atomic_fetch_add(ctr, 1u, __ATOMIC_RELAXED, __HIP_MEMORY_SCOPE_AGENT);
        { f32x4 gs[4];
#pragma unroll
          for (int i4 = 0; i4 < 4; ++i4) gs[i4] = cur.g ? *(const f32x4*)(cur.g + cur.k0 + 16 * wid + 4 * i4) * W8_SCALE : (f32x4){W8_SCALE, W8_SCALE, W8_SCALE, W8_SCALE};
#pragma unroll
          for (int i = 0; i < 16; ++i) v[i] = v[i] * gs[i >> 2][i & 3];
#pragma unroll
          for (int q = 0; q < 4; ++q) { u32x4 o;
              o.x = pk4_fp8(v[0][q], v[1][q], v[2][q], v[3][q]); o.y = pk4_fp8(v[4][q], v[5][q], v[6][q], v[7][q]); o.z = pk4_fp8(v[8][q], v[9][q], v[10][q], v[11][q]); o.w = pk4_fp8(v[12][q], v[13][q], v[14][q], v[15][q]);
              *(LAS u32x4*)(T + (4 * lane + q) * 128 + ((wid ^ (lane & 7)) << 4)) = o; } }
        __syncthreads();
        const int rn = __builtin_amdgcn_readfirstlane(nxt[slot]); const int have_n = rn < NPOOL;
        if (have_n) { pool_tile_desc(a, rn, nx); POOL_LOAD(nx, v); }
#pragma unroll
        for (int it = 0; it < 4; ++it) { const int row = 32 * wid + 8 * it + (lane >> 3), c = lane & 7;
            const u32x4 o = *(const LAS u32x4*)(T + row * 128 + ((c ^ ((row >> 2) & 7)) << 4));
            int dr; if (cur.mode == 0) dr = cur.d0 + row; else { const int jj = (cur.c0 + row) >> 1; dr = 256 * (jj >> 7) + (jj & 127) + 128 * (row & 1); }
            __builtin_nontemporal_store(o, (u32x4*)(cur.WT + (size_t)dr * DM + cur.k0 + 16 * c)); }
        __syncthreads();
        cur = nx; have = have_n; slot ^= 1;
    }
}
#undef POOL_LOAD

template <bool ABF, class Side>
__device__ __forceinline__ void skinny_mfma(const void* A_, const bf16* Whi, const bf16* Wlo, LAS float* red, LAS float* Ls, int tid, int wid, int lane, const Side& side) {
    const int g4 = lane >> 4, c15 = lane & 15;
    f32x4 acc[4][2];
#pragma unroll
    for (int rt = 0; rt < 4; ++rt) { acc[rt][0] = (f32x4){0.f, 0.f, 0.f, 0.f}; acc[rt][1] = (f32x4){0.f, 0.f, 0.f, 0.f}; }
    const float* ap = (const float*)A_ + (size_t)c15 * DM + 256 * wid + 8 * g4;
    const bf16* apb = (const bf16*)A_ + (size_t)c15 * DM + 256 * wid + 8 * g4;
    const bf16* bh = Whi + (size_t)c15 * DM + 256 * wid + 8 * g4; const bf16* bl = Wlo + (size_t)c15 * DM + 256 * wid + 8 * g4;
    f32x4 av[2][ABF ? 1 : 4][2]; u32x4 avb[2][ABF ? 4 : 1]; u32x4 bv[2][2][2];
#define SK_LOAD(buf, ks) do { _Pragma("unroll") for (int rt = 0; rt < 4; ++rt) { if constexpr (ABF) avb[buf][rt] = *(const u32x4*)(apb + (size_t)(16 * rt) * DM + 32 * (ks)); \
            else { av[buf][rt][0] = *(const f32x4*)(ap + (size_t)(16 * rt) * DM + 32 * (ks)); av[buf][rt][1] = *(const f32x4*)(ap + (size_t)(16 * rt) * DM + 32 * (ks) + 4); } } \
        _Pragma("unroll") for (int ct = 0; ct < 2; ++ct) { bv[buf][ct][0] = *(const u32x4*)(bh + (size_t)(16 * ct) * DM + 32 * (ks)); bv[buf][ct][1] = *(const u32x4*)(bl + (size_t)(16 * ct) * DM + 32 * (ks)); } } while (0)
    SK_LOAD(0, 0);
#pragma unroll
    for (int ks = 0; ks < 8; ++ks) { const int cb = ks & 1;
        if (ks < 7) SK_LOAD(cb ^ 1, ks + 1);
#pragma unroll
        for (int rt = 0; rt < 4; ++rt) {
            if constexpr (ABF) { const u32x4 hw = avb[cb][rt]; const f32x4 v0 = (f32x4){bflo(hw.x), bfhi(hw.x), bflo(hw.y), bfhi(hw.y)}, v1 = (f32x4){bflo(hw.z), bfhi(hw.z), bflo(hw.w), bfhi(hw.w)};
                side(rt, 256 * wid + 32 * ks + 8 * g4, v0, v1);
                const bf16x8 ah = __builtin_bit_cast(bf16x8, hw);
#pragma unroll
                for (int ct = 0; ct < 2; ++ct) { const bf16x8 wh = __builtin_bit_cast(bf16x8, bv[cb][ct][0]), wl = __builtin_bit_cast(bf16x8, bv[cb][ct][1]);
                    acc[rt][ct] = MMA16(ah, wh, acc[rt][ct]); acc[rt][ct] = MMA16(ah, wl, acc[rt][ct]); }
                continue; }
            const f32x4 v0 = av[cb][ABF ? 0 : rt][0], v1 = av[cb][ABF ? 0 : rt][1];
            side(rt, 256 * wid + 32 * ks + 8 * g4, v0, v1);
            u32x4 hi, lo; hi.x = pk2(v0[0], v0[1]); hi.y = pk2(v0[2], v0[3]); hi.z = pk2(v1[0], v1[1]); hi.w = pk2(v1[2], v1[3]);
            lo.x = pk2(v0[0] - bflo(hi.x), v0[1] - bfhi(hi.x)); lo.y = pk2(v0[2] - bflo(hi.y), v0[3] - bfhi(hi.y)); lo.z = pk2(v1[0] - bflo(hi.z), v1[1] - bfhi(hi.z)); lo.w = pk2(v1[2] - bflo(hi.w), v1[3] - bfhi(hi.w));
            const bf16x8 ah = __builtin_bit_cast(bf16x8, hi), al = __builtin_bit_cast(bf16x8, lo);
#pragma unroll
            for (int ct = 0; ct < 2; ++ct) { const bf16x8 wh = __builtin_bit_cast(bf16x8, bv[cb][ct][0]), wl = __builtin_bit_cast(bf16x8, bv[cb][ct][1]);
                acc[rt][ct] = MMA16(ah, wh, acc[rt][ct]); acc[rt][ct] = MMA16(al, wh, acc[rt][ct]); acc[rt][ct] = MMA16(ah, wl, acc[rt][ct]); } } }
#undef SK_LOAD
#pragma unroll
    for (int rt = 0; rt < 4; ++rt)
#pragma unroll
        for (int ct = 0; ct < 2; ++ct)
#pragma unroll
            for (int rg = 0; rg < 4; ++rg) red[(wid * 64 + 16 * rt + 4 * g4 + rg) * 33 + 16 * ct + c15] = acc[rt][ct][rg];
    __syncthreads();
    { const int row = tid >> 3, n4 = (tid & 7) * 4;
#pragma unroll
      for (int q = 0; q < 4; ++q) { float s = 0.f;
#pragma unroll
          for (int w = 0; w < 8; ++w) s += red[(w * 64 + row) * 33 + n4 + q];
          Ls[row * 33 + n4 + q] = s; } }
    __syncthreads();
}

__device__ __forceinline__ void xgate_unit(const Args& a, int u, LAS unsigned char* lds, int tid, int wid, int lane) {
    asm volatile("" : "+v"(tid), "+v"(lane));
    unsigned char* sm = a.ws + WS_SMALL;
    LAS float* red = (LAS float*)lds; LAS float* Gs = (LAS float*)(lds + 67584); LAS float* gl = (LAS float*)(lds + 67584 + 8448); LAS float* il = gl + 64 * 12;
    const int t0 = u * 64;
    skinny_mfma<false>(argin(a, 0) + (size_t)t0 * DM, (const bf16*)(a.ws + WS_WSK), (const bf16*)(a.ws + WS_WSK) + 32 * DM, red, Gs, tid, wid, lane, [](int, int, const f32x4&, const f32x4&) {});
    if (tid < 64) { const int l = tid, t = t0 + l; float* BETA = (float*)(sm + SM_BETA); float* IC = (float*)(sm + SM_IC); const float rs = ((const float*)(sm + SM_RS1))[t];
        const float* a_log = argin(a, 5); const float* dt_b = argin(a, 6); const float* b_i = argin(a, 8); const float* b_f = argin(a, 9);
        for (int h = 0; h < 8; ++h) { const float av = Gs[l * 33 + h] * rs; gl[l * 12 + h] = -expf(a_log[h]) * softplusf(av + dt_b[h]); BETA[t * 8 + h] = 1.f / (1.f + expf(-Gs[l * 33 + 8 + h] * rs)); }
        for (int h = 0; h < 4; ++h) { const float ip = 15.f * tanhf((Gs[l * 33 + 16 + h] * rs + b_i[h]) * (1.f / 15.f)); il[l * 4 + h] = ip; IC[t * 4 + h] = ip;
            const float fp = 15.f * tanhf((Gs[l * 33 + 20 + h] * rs + b_f[h]) * (1.f / 15.f)); gl[l * 12 + 8 + h] = -softplusf(-fp); } }
    __syncthreads();
    {
        float* GC = (float*)(sm + SM_GC); float* FC = (float*)(sm + SM_FC);
        for (int j = wid; j < 12; j += 8) { float v = gl[lane * 12 + j];
#pragma unroll
            for (int off = 1; off < 64; off <<= 1) { const float vp = __shfl_up(v, off); if (lane >= off) v += vp; }
            if (j < 8) GC[(t0 + lane) * 8 + j] = v; else { const int h = j - 8; FC[(t0 + lane) * 4 + h] = v; const float tot = __shfl(v, 63); float am = tot - v + il[lane * 4 + h];
#pragma unroll
                for (int off = 1; off < 64; off <<= 1) am = fmaxf(am, __shfl_xor(am, off));
                if (lane == 0) { ((float*)(sm + SM_FLAST))[u * 4 + h] = tot; ((float*)(sm + SM_AMAX))[u * 4 + h] = am; } } }
    }
    __syncthreads();
}

__device__ __forceinline__ int tsw(int row, int l, int sh) { return row * 72 + ((((l >> 3) ^ (row >> sh)) & 7) << 3) + (l & 7); }
__device__ __forceinline__ bf16x8 fragsw(const LAS bf16* base, int rt  , int ks, int lane, int sh) {
    return *(const LAS bf16x8*)(base + (16 * rt + (lane & 15)) * 72 + ((((4 * ks + (lane >> 4)) ^ ((16 * rt) >> sh)) & 7) << 3));
}
#define MMA4F(a, b, c) __builtin_amdgcn_mfma_f32_16x16x4f32(a, b, c, 0, 0, 0)

struct GdnPre { u32x4 z[3]; f32x4 cw; };
#define GDN_ZLOAD(ugx, tz, R) do { const int _b = (ugx) >> 9, _h = ((ugx) >> 6) & 7, _c = (ugx) & 63; const bf16* _zb = (const bf16*)(a.ws + WS_Z) + ((long)(_b * SEQL + _c * 64 - 3)) * NZ + (tz) * 1024 + _h * 128 + (tid & 15) * 8; \
        _Pragma("unroll") for (int _k = 0; _k < 3; ++_k) { const int _r = (tid >> 4) + 32 * _k; const bool _ok = (_k < 2 || tid < 48) && (_c * 64 - 3 + _r >= 0); \
            (R)[_k] = _ok ? *(const u32x4*)(_zb + (long)_r * NZ) : (u32x4){0u, 0u, 0u, 0u}; } } while (0)
#define GDN_ZPUT(R, ZSx) do { *(LAS u32x4*)((ZSx) + ((tid >> 4)) * 136 + (tid & 15) * 8) = (R)[0]; *(LAS u32x4*)((ZSx) + ((tid >> 4) + 32) * 136 + (tid & 15) * 8) = (R)[1]; \
        if (tid < 48) *(LAS u32x4*)((ZSx) + ((tid >> 4) + 64) * 136 + (tid & 15) * 8) = (R)[2]; } while (0)
#define GDN_CWLOAD(ugx, dst) do { if (tid < 384) { const int _h = ((ugx) >> 6) & 7, _tj = tid >> 5; (dst) = *(const f32x4*)(argin(a, 4) + (_tj & 3) * 3072 + (_tj >> 2) * 1024 + _h * 128 + (tid & 31) * 4); } } while (0)
#define GDN_CONV(tz, ZSx, out) do { _Pragma("unroll") for (int _i = 0; _i < 16; ++_i) (out)[_i] = 0.f; \
        _Pragma("unroll") for (int _j = 0; _j < 4; ++_j) { const LAS bf16* _zr = (ZSx) + (l + _j) * 136 + cg * 16; const u32x4 _w0 = *(const LAS u32x4*)_zr, _w1 = *(const LAS u32x4*)(_zr + 8); \
            const LAS float* _cw = CWs + ((tz) * 4 + _j) * 128 + cg * 16; const f32x4 _c0 = *(const LAS f32x4*)_cw, _c1 = *(const LAS f32x4*)(_cw + 4), _c2 = *(const LAS f32x4*)(_cw + 8), _c3 = *(const LAS f32x4*)(_cw + 12); \
            (out)[0] += _c0[0] * bflo(_w0.x); (out)[1] += _c0[1] * bfhi(_w0.x); (out)[2] += _c0[2] * bflo(_w0.y); (out)[3] += _c0[3] * bfhi(_w0.y); \
            (out)[4] += _c1[0] * bflo(_w0.z); (out)[5] += _c1[1] * bfhi(_w0.z); (out)[6] += _c1[2] * bflo(_w0.w); (out)[7] += _c1[3] * bfhi(_w0.w); \
            (out)[8] += _c2[0] * bflo(_w1.x); (out)[9] += _c2[1] * bfhi(_w1.x); (out)[10] += _c2[2] * bflo(_w1.y); (out)[11] += _c2[3] * bfhi(_w1.y); \
            (out)[12] += _c3[0] * bflo(_w1.z); (out)[13] += _c3[1] * bfhi(_w1.z); (out)[14] += _c3[2] * bflo(_w1.w); (out)[15] += _c3[3] * bfhi(_w1.w); } \
        _Pragma("unroll") for (int _i = 0; _i < 16; ++_i) { const float _v = (out)[_i]; (out)[_i] = _v * __builtin_amdgcn_rcpf(1.f + __expf(-_v)); } } while (0)

__device__ __forceinline__ void gdn_prep_unit(const Args& a, int ug, int ug_next, GdnPre& pre, LAS unsigned char* lds, int tid, int wid, int lane) {
    asm volatile("" : "+v"(tid), "+v"(lane));
    unsigned char* ws = a.ws; unsigned char* sm = ws + WS_SMALL;
    LAS bf16* KDt = (LAS bf16*)lds; LAS bf16* KBGt = (LAS bf16*)(lds + 18432); LAS bf16* VBt = (LAS bf16*)(lds + 36864); LAS bf16* Qs = (LAS bf16*)(lds + 55296); LAS bf16* Ks = (LAS bf16*)(lds + 72704);
    LAS bf16* GTt = (LAS bf16*)(lds + 55296); LAS bf16* Ti = (LAS bf16*)(lds + 73728); LAS bf16* TiT = (LAS bf16*)(lds + 82944);
    LAS float* Mm = (LAS float*)(lds + 92160); LAS float* TT = (LAS float*)(lds + 109568); LAS float* Td = (LAS float*)(lds + 126976); LAS float* gcs = (LAS float*)(lds + 134752); LAS float* bts = (LAS float*)(lds + 135008);
    LAS bf16* ZS0 = (LAS bf16*)(lds + 92160); LAS bf16* ZS1 = (LAS bf16*)(lds + 110384); LAS float* CWs = (LAS float*)(lds + 128608);
    const int b = ug >> 9, h = (ug >> 6) & 7, c = ug & 63, t0 = b * SEQL + c * 64;
    const int l = tid >> 3, cg = tid & 7, g4 = lane >> 4, c15 = lane & 15;
    const float gcl = ((const float*)(sm + SM_GC))[(t0 + l) * 8 + h], btl = ((const float*)(sm + SM_BETA))[(t0 + l) * 8 + h], gclast = ((const float*)(sm + SM_GC))[(t0 + 63) * 8 + h];
    {
        float qv[16], kv[16], vv[16]; u32x4 R[3];
        GDN_ZPUT(pre.z, ZS0); if (tid < 384) *(LAS f32x4*)(CWs + 4 * tid) = pre.cw;
        GDN_ZLOAD(ug, 1, R);
        __syncthreads();
        GDN_CONV(0, ZS0, qv);
        GDN_ZPUT(R, ZS1); GDN_ZLOAD(ug, 2, R);
        __syncthreads();
        GDN_CONV(1, ZS1, kv);
        GDN_ZPUT(R, ZS0);
        if (ug_next >= 0) { GDN_ZLOAD(ug_next, 0, pre.z); GDN_CWLOAD(ug_next, pre.cw); }
        __syncthreads();
        GDN_CONV(2, ZS0, vv);
        float sq = 0.f, sk = 0.f;
#pragma unroll
        for (int i = 0; i < 16; ++i) { sq += qv[i] * qv[i]; sk += kv[i] * kv[i]; }
#pragma unroll
        for (int o = 1; o < 8; o <<= 1) { sq += __shfl_xor(sq, o); sk += __shfl_xor(sk, o); }
        const float rq = rsqrtf(sq + EPS) * 0.08838834764831845f, rk = rsqrtf(sk + EPS);
        const float eg = expf(gcl), ekd = expf(gclast - gcl);
        unsigned qw[8], kw[8], qdw[8];
#pragma unroll
        for (int i = 0; i < 8; ++i) { const float q0 = qv[2 * i] * rq, q1 = qv[2 * i + 1] * rq, k0 = kv[2 * i] * rk, k1 = kv[2 * i + 1] * rk;
            qw[i] = pk2(q0, q1); kw[i] = pk2(k0, k1); qdw[i] = pk2(q0 * eg, q1 * eg);
            const int d = cg * 16 + 2 * i;
            KBGt[tsw(d, l, 4)] = f2bf(k0 * btl * eg); KBGt[tsw(d + 1, l, 4)] = f2bf(k1 * btl * eg);
            KDt[tsw(d, l, 4)] = f2bf(k0 * ekd); KDt[tsw(d + 1, l, 4)] = f2bf(k1 * ekd);
            VBt[tsw(d, l, 4)] = f2bf(vv[2 * i] * btl); VBt[tsw(d + 1, l, 4)] = f2bf(vv[2 * i + 1] * btl); }
        *(LAS u32x4*)(Qs + l * 136 + cg * 16) = (u32x4){qw[0], qw[1], qw[2], qw[3]}; *(LAS u32x4*)(Qs + l * 136 + cg * 16 + 8) = (u32x4){qw[4], qw[5], qw[6], qw[7]};
        *(LAS u32x4*)(Ks + l * 136 + cg * 16) = (u32x4){kw[0], kw[1], kw[2], kw[3]}; *(LAS u32x4*)(Ks + l * 136 + cg * 16 + 8) = (u32x4){kw[4], kw[5], kw[6], kw[7]};
        bf16* qd = (bf16*)(ws + WS_GQD) + (size_t)ug * 8192 + l * 128 + cg * 16;
        *(u32x4*)qd = (u32x4){qdw[0], qdw[1], qdw[2], qdw[3]}; *(u32x4*)(qd + 8) = (u32x4){qdw[4], qdw[5], qdw[6], qdw[7]};
        if (cg == 0) { gcs[l] = gcl; bts[l] = btl; }
    }
    __syncthreads();
    {
        const int wv = wid & 3; const bool isQ = wid >= 4; const LAS bf16* Ab = isQ ? Qs : Ks;
        f32x4 acc[4];
#pragma unroll
        for (int n = 0; n < 4; ++n) acc[n] = (f32x4){0.f, 0.f, 0.f, 0.f};
#pragma unroll
        for (int ks = 0; ks < 4; ++ks) { const bf16x8 af = frag(Ab, 16 * wv, 136, 32 * ks, lane);
#pragma unroll
            for (int n = 0; n < 4; ++n) acc[n] = MMA16(frag(Ks, 16 * n, 136, 32 * ks, lane), af, acc[n]); }
        bf16* AT = (bf16*)(ws + WS_GAT) + (size_t)ug * 4096;
        const int i = 16 * wv + c15; const float gi = gcs[i], bi = bts[i];
#pragma unroll
        for (int n = 0; n < 4; ++n) { const int j0 = 16 * n + 4 * g4; const f32x4 gj = *(const LAS f32x4*)(gcs + j0); f32x4 o;
#pragma unroll
            for (int rg = 0; rg < 4; ++rg) { const int j = j0 + rg; const float dec = (j <= i) ? __expf(gi - gj[rg]) : 0.f;
                o[rg] = isQ ? acc[n][rg] * dec : ((j < i) ? bi * acc[n][rg] * dec : 0.f); }
            if (!isQ) *(LAS f32x4*)(Mm + i * 68 + j0) = o;
            else *(u32x2*)(AT + i * 64 + j0) = (u32x2){pk2(o[0], o[1]), pk2(o[2], o[3])}; }
    }
    __syncthreads();
    if (wid == 0) {
        const int blk = g4;
        unsigned mb = (unsigned)(size_t)(Mm + (16 * blk) * 68 + 16 * blk), ml = mb + 4u * (unsigned)c15;
        asm volatile("" : "+v"(mb), "+v"(ml));
        float X[16];
#pragma unroll
        for (int i = 0; i < 16; ++i) { float s = -*(const LAS float*)(size_t)(ml + (unsigned)(i * 68 * 4));
#pragma unroll
            for (int j4 = 0; j4 < (i + 3) / 4; ++j4) { const f32x4 mv = *(const LAS f32x4*)(size_t)(mb + (unsigned)((i * 68 + 4 * j4) * 4));
#pragma unroll
                for (int q = 0; q < 4; ++q) if (4 * j4 + q < i) s -= mv[q] * X[4 * j4 + q]; }
            X[i] = s; }
        const float cf = (float)c15;
#pragma unroll
        for (int i = 0; i < 16; ++i) { X[i] += fmaxf(0.f, 1.f - fabsf(cf - (float)i)); Td[(blk * 16 + i) * 20 + c15] = X[i]; Ti[(16 * blk + i) * 72 + 16 * blk + c15] = f2bf(X[i]); }
        LAS float* ttp = TT + (16 * blk + c15) * 68 + 16 * blk; LAS bf16* tip = TiT + (16 * blk + c15) * 72 + 16 * blk;
#pragma unroll
        for (int i4 = 0; i4 < 4; ++i4) *(LAS f32x4*)(ttp + 4 * i4) = (f32x4){X[4 * i4], X[4 * i4 + 1], X[4 * i4 + 2], X[4 * i4 + 3]};
        *(LAS u32x4*)tip = (u32x4){pk2(X[0], X[1]), pk2(X[2], X[3]), pk2(X[4], X[5]), pk2(X[6], X[7])}; *(LAS u32x4*)(tip + 8) = (u32x4){pk2(X[8], X[9]), pk2(X[10], X[11]), pk2(X[12], X[13]), pk2(X[14], X[15])};
    } else if (wid >= 4) {
        for (int p = tid - 256; p < 384; p += 256) { const int arr = p / 192, q = p - arr * 192, bi6 = q >> 5, r = (q & 31) >> 1, hf = q & 1;
            const int bi = bi6 < 3 ? 0 : (bi6 < 5 ? 1 : 2), bj = bi6 < 3 ? bi6 + 1 : (bi6 < 5 ? bi6 - 1 : 3);
            if (arr) *(LAS u32x4*)(TiT + (16 * bj + r) * 72 + 16 * bi + 8 * hf) = (u32x4){0u, 0u, 0u, 0u};
            else *(LAS u32x4*)(Ti + (16 * bi + r) * 72 + 16 * bj + 8 * hf) = (u32x4){0u, 0u, 0u, 0u}; }
    }
    __syncthreads();
#pragma unroll
    for (int dg = 1; dg < 4; ++dg) {
        if (wid < 4 - dg) { const int bi = wid + dg, bj = wid;
            f32x4 P = (f32x4){0.f, 0.f, 0.f, 0.f};
            for (int k = bj; k < bi; ++k) { const f32x4 a4 = *(const LAS f32x4*)(Mm + (16 * bi + c15) * 68 + 16 * k + 4 * g4), b4 = *(const LAS f32x4*)(TT + (16 * bj + c15) * 68 + 16 * k + 4 * g4);
#pragma unroll
                for (int s = 0; s < 4; ++s) P = MMA4F(a4[s], b4[s], P); }
            const f32x4 t4 = *(const LAS f32x4*)(Td + (bi * 16 + c15) * 20 + 4 * g4);
            f32x4 Q = (f32x4){0.f, 0.f, 0.f, 0.f};
#pragma unroll
            for (int s = 0; s < 4; ++s) Q = MMA4F(t4[s], P[s], Q);
            Q = -Q;
            *(LAS f32x4*)(TT + (16 * bj + c15) * 68 + 16 * bi + 4 * g4) = Q;
            *(LAS u32x2*)(TiT + (16 * bj + c15) * 72 + 16 * bi + 4 * g4) = (u32x2){pk2(Q[0], Q[1]), pk2(Q[2], Q[3])};
#pragma unroll
            for (int rg = 0; rg < 4; ++rg) Ti[(16 * bi + 4 * g4 + rg) * 72 + 16 * bj + c15] = f2bf(Q[rg]);
        }
        __syncthreads();
    }
    {
        const int wv = wid & 3; const LAS bf16* Bb = wid < 4 ? VBt : KBGt; bf16* OUT = (bf16*)(ws + (wid < 4 ? WS_GU : WS_GW)) + (size_t)ug * 8192;
#pragma unroll
        for (int e2 = 0; e2 < 2; ++e2) { const int en = 2 * wv + e2; f32x4 acc[4];
#pragma unroll
            for (int it = 0; it < 4; ++it) acc[it] = (f32x4){0.f, 0.f, 0.f, 0.f};
#pragma unroll
            for (int ks = 0; ks < 2; ++ks) { const bf16x8 af = fragsw(Bb, en, ks, lane, 4);
#pragma unroll
                for (int it = 0; it < 4; ++it) acc[it] = MMA16(af, frag(Ti, 16 * it, 72, 32 * ks, lane), acc[it]); }
#pragma unroll
            for (int it = 0; it < 4; ++it) { const u32x2 pv = (u32x2){pk2(acc[it][0], acc[it][1]), pk2(acc[it][2], acc[it][3])};
                *(u32x2*)(OUT + (((en * 4 + it) * 64) + lane) * 4) = pv; } }
    }
    {
        const int mt = wid & 3;
#pragma unroll
        for (int d4 = 0; d4 < 4; ++d4) { const int dn = (wid >> 2) * 4 + d4; f32x4 acc = (f32x4){0.f, 0.f, 0.f, 0.f};
#pragma unroll
            for (int ks = 0; ks < 2; ++ks) acc = MMA16(frag(TiT, 16 * mt, 72, 32 * ks, lane), fragsw(KDt, dn, ks, lane, 4), acc);
            *(LAS u32x2*)(GTt + (16 * dn + c15) * 72 + 16 * mt + 4 * g4) = (u32x2){pk2(acc[0], acc[1]), pk2(acc[2], acc[3])}; }
        if (tid == 0) ((float*)(sm + SM_GLAST))[ug] = expf(gcs[63]);
    }
    __syncthreads();
    {
        bf16* AP = (bf16*)(ws + WS_GAP) + (size_t)ug * 16384; bf16* BB = (bf16*)(ws + WS_GBB) + (size_t)ug * 16384;
        bf16x8 kf[2], gf[2];
#pragma unroll
        for (int ks = 0; ks < 2; ++ks) { kf[ks] = fragsw(KBGt, wid, ks, lane, 4); gf[ks] = frag(GTt, 16 * wid, 72, 32 * ks, lane); }
#pragma unroll
        for (int n = 0; n < 8; ++n) { f32x4 a1 = (f32x4){0.f, 0.f, 0.f, 0.f}, b1 = (f32x4){0.f, 0.f, 0.f, 0.f};
#pragma unroll
            for (int ks = 0; ks < 2; ++ks) { a1 = MMA16(kf[ks], frag(GTt, 16 * n, 72, 32 * ks, lane), a1); b1 = MMA16(gf[ks], fragsw(VBt, n, ks, lane, 4), b1); }
            *(u32x2*)(AP + (((n * 4 + (wid >> 1)) * 64) + ((2 * wid + (g4 >> 1)) & 3) * 16 + c15) * 8 + 4 * (g4 & 1)) = (u32x2){pk2(-a1[0], -a1[1]), pk2(-a1[2], -a1[3])};
            *(u32x2*)(BB + (((((n >> 1) * 8 + wid) * 2 + (n & 1)) * 64) + lane) * 4) = (u32x2){pk2(b1[0], b1[1]), pk2(b1[2], b1[3])}; }
    }
    __syncthreads();
}

struct MlPre { u32x4 q0, q1, k0, k1, v[4]; float fl, am, fc, ic; };
#define ML_PREP_LOAD(umx, P) do { const int _b = (umx) >> 8, _h = ((umx) >> 6) & 3, _c = (umx) & 63, _t0 = _b * SEQL + _c * 64; const bf16* _zr = (const bf16*)(a.ws + WS_Z) + (size_t)(_t0 + (tid >> 3)) * NZ; const int _cg = tid & 7; \
        (P).q0 = *(const u32x4*)(_zr + ZMQ + _h * 128 + _cg * 16); (P).q1 = *(const u32x4*)(_zr + ZMQ + _h * 128 + _cg * 16 + 8); (P).k0 = *(const u32x4*)(_zr + ZMK + _h * 128 + _cg * 16); (P).k1 = *(const u32x4*)(_zr + ZMK + _h * 128 + _cg * 16 + 8); \
        _Pragma("unroll") for (int _s = 0; _s < 4; ++_s) (P).v[_s] = *(const u32x4*)(_zr + ZMV + _h * 256 + _cg * 32 + _s * 8); \
        if (tid < 64) { const unsigned char* _sm = a.ws + WS_SMALL; (P).fl = ((const float*)(_sm + SM_FLAST))[(_b * 64 + tid) * 4 + _h]; (P).am = ((const float*)(_sm + SM_AMAX))[(_b * 64 + tid) * 4 + _h]; \
            (P).fc = ((const float*)(_sm + SM_FC))[(_t0 + tid) * 4 + _h]; (P).ic = ((const float*)(_sm + SM_IC))[(_t0 + tid) * 4 + _h]; } } while (0)
__device__ __forceinline__ void ml_prep_unit(const Args& a, int um, int um_next, MlPre& pre, LAS unsigned char* lds, int tid, int wid, int lane) {
    asm volatile("" : "+v"(tid), "+v"(lane));
    unsigned char* ws = a.ws; unsigned char* sm = ws + WS_SMALL;
    LAS bf16* Qs = (LAS bf16*)lds; LAS bf16* Ks = (LAS bf16*)(lds + 17408); LAS bf16* VTs = (LAS bf16*)(lds + 34816); LAS bf16* KWTs = (LAS bf16*)(lds + 71680);
    LAS float* FL = (LAS float*)(lds + 90112); LAS float* AM = FL + 64; LAS float* fcs = FL + 128; LAS float* ics = FL + 192; LAS float* mis = FL + 256; LAS float* wks = FL + 320;
    const int c = um & 63;
    const int l = tid >> 3, cg = tid & 7, g4 = lane >> 4, c15 = lane & 15;
    {
        const u32x4 q0 = pre.q0, q1 = pre.q1, k0 = pre.k0, k1 = pre.k1;
        *(LAS u32x4*)(Qs + l * 136 + cg * 16) = q0; *(LAS u32x4*)(Qs + l * 136 + cg * 16 + 8) = q1;
        const float sc = 0.08838834764831845f;
        u32x4 ko0, ko1;
        ko0.x = pk2(bflo(k0.x) * sc, bfhi(k0.x) * sc); ko0.y = pk2(bflo(k0.y) * sc, bfhi(k0.y) * sc); ko0.z = pk2(bflo(k0.z) * sc, bfhi(k0.z) * sc); ko0.w = pk2(bflo(k0.w) * sc, bfhi(k0.w) * sc);
        ko1.x = pk2(bflo(k1.x) * sc, bfhi(k1.x) * sc); ko1.y = pk2(bflo(k1.y) * sc, bfhi(k1.y) * sc); ko1.z = pk2(bflo(k1.z) * sc, bfhi(k1.z) * sc); ko1.w = pk2(bflo(k1.w) * sc, bfhi(k1.w) * sc);
        *(LAS u32x4*)(Ks + l * 136 + cg * 16) = ko0; *(LAS u32x4*)(Ks + l * 136 + cg * 16 + 8) = ko1;
#pragma unroll
        for (int s4 = 0; s4 < 4; ++s4) { const u32x4 v = pre.v[s4]; const int e0 = cg * 32 + s4 * 8;
            VTs[tsw(e0 + 0, l, 5)] = (bf16)(v.x & 0xffffu); VTs[tsw(e0 + 1, l, 5)] = (bf16)(v.x >> 16); VTs[tsw(e0 + 2, l, 5)] = (bf16)(v.y & 0xffffu); VTs[tsw(e0 + 3, l, 5)] = (bf16)(v.y >> 16);
            VTs[tsw(e0 + 4, l, 5)] = (bf16)(v.z & 0xffffu); VTs[tsw(e0 + 5, l, 5)] = (bf16)(v.z >> 16); VTs[tsw(e0 + 6, l, 5)] = (bf16)(v.w & 0xffffu); VTs[tsw(e0 + 7, l, 5)] = (bf16)(v.w >> 16); }
        if (tid < 64) { FL[tid] = pre.fl; AM[tid] = pre.am; fcs[tid] = pre.fc; ics[tid] = pre.ic; }
        if (um_next >= 0) ML_PREP_LOAD(um_next, pre);
    }
    __syncthreads();
    if (tid < 64) {
        float A = FL[tid], B = AM[tid], v = ics[tid] - fcs[tid];
#pragma unroll
        for (int off = 1; off < 64; off <<= 1) { const float Ap = __shfl_up(A, off), Bp = __shfl_up(B, off), vp = __shfl_up(v, off);
            if (tid >= off) { B = fmaxf(Bp + A, B); A = Ap + A; v = fmaxf(v, vp); } }
        const float mm = fmaxf(A, B);
        float mprev = __shfl_up(mm, 1); if (tid == 0) mprev = 0.f;
        const float mst = __shfl(mprev, c), mn = __shfl(mm, c), flc = FL[c];
        if (tid == 0) ((float*)(sm + SM_MDEC))[um] = expf(flc + mst - mn);
        const float inter = fcs[tid] + mst, mi = fmaxf(fcs[tid] + v, inter); mis[tid] = mi;
        ((float*)(sm + SM_MSI))[um * 64 + tid] = expf(inter - mi); ((float*)(sm + SM_MEN))[um * 64 + tid] = expf(-mi); wks[tid] = expf(flc - fcs[tid] + ics[tid] - mn); }
    __syncthreads();
    if (wid < 4) {
        f32x4 acc[4];
#pragma unroll
        for (int n = 0; n < 4; ++n) acc[n] = (f32x4){0.f, 0.f, 0.f, 0.f};
#pragma unroll
        for (int ks = 0; ks < 4; ++ks) { const bf16x8 af = frag(Qs, 16 * wid, 136, 32 * ks, lane);
#pragma unroll
            for (int n = 0; n < 4; ++n) acc[n] = MMA16(frag(Ks, 16 * n, 136, 32 * ks, lane), af, acc[n]); }
        bf16* WT = (bf16*)(ws + WS_MWT) + (size_t)um * 4096; float rsum = 0.f;
        const int i = 16 * wid + c15; const float fi = fcs[i] - mis[i];
#pragma unroll
        for (int n = 0; n < 4; ++n) { const int j0 = 16 * n + 4 * g4; const f32x4 fj = *(const LAS f32x4*)(fcs + j0), ij = *(const LAS f32x4*)(ics + j0); f32x4 o;
#pragma unroll
            for (int rg = 0; rg < 4; ++rg) { const int j = j0 + rg; o[rg] = (j <= i) ? __expf(fi - fj[rg] + ij[rg]) * acc[n][rg] : 0.f; rsum += o[rg]; }
            *(u32x2*)(WT + i * 64 + j0) = (u32x2){pk2(o[0], o[1]), pk2(o[2], o[3])}; }
        rsum += __shfl_xor(rsum, 16); rsum += __shfl_xor(rsum, 32);
        if (g4 == 0) ((float*)(sm + SM_MWS))[um * 64 + i] = rsum;
    } else {
        const int t2 = tid - 256, l2 = t2 >> 2, part = t2 & 3; const float wk = wks[l2];
#pragma unroll 8
        for (int i = 0; i < 32; ++i) { const int d = part * 32 + i; KWTs[tsw(d, l2, 5)] = f2bf(wk * bf2f(Ks[l2 * 136 + d])); }
    }
    __syncthreads();
    {
        bf16* BM = (bf16*)(ws + WS_MBM) + (size_t)um * 32768;
        bf16x8 kf[2];
#pragma unroll
        for (int ks = 0; ks < 2; ++ks) kf[ks] = fragsw(KWTs, wid, ks, lane, 5);
#pragma unroll
        for (int n = 0; n < 16; ++n) { f32x4 b1 = (f32x4){0.f, 0.f, 0.f, 0.f};
#pragma unroll
            for (int ks = 0; ks < 2; ++ks) b1 = MMA16(kf[ks], fragsw(VTs, n, ks, lane, 5), b1);
            *(u32x2*)(BM + (((n * 8 + wid) * 64) + lane) * 4) = (u32x2){pk2(b1[0], b1[1]), pk2(b1[2], b1[3])}; }
        if (tid < 128) { float s = 0.f;
#pragma unroll
            for (int c8 = 0; c8 < 8; ++c8) { const u32x4 kv = *(const LAS u32x4*)(KWTs + tid * 72 + c8 * 8); s += (bflo(kv.x) + bfhi(kv.x)) + (bflo(kv.y) + bfhi(kv.y)) + (bflo(kv.z) + bfhi(kv.z)) + (bflo(kv.w) + bfhi(kv.w)); }
            ((float*)(sm + SM_MKS))[um * 128 + tid] = s; }
        bf16* VT = (bf16*)(ws + WS_MVT) + (size_t)um * 16384;
        for (int p = tid; p < 2048; p += 512) { const int row = p >> 3, seg = p & 7; *(u32x4*)(VT + row * 64 + seg * 8) = *(const LAS u32x4*)(VTs + row * 72 + ((seg ^ (row >> 5)) & 7) * 8); }
    }
    __syncthreads();
}

__device__ __forceinline__ void gdn_scan_item(const Args& a, int item, LAS unsigned char* lds, int tid, int wid, int lane) {
    asm volatile("" : "+v"(tid), "+v"(lane));
    unsigned char* ws = a.ws; unsigned char* sm = ws + WS_SMALL;
    LAS bf16* STs = (LAS bf16*)lds;
    LAS float* gls = (LAS float*)(lds + 8704);
    const int bh = item >> 3, n = item & 7, g4 = lane >> 4, c15 = lane & 15;
    const int ug0 = bh * 64;
    const size_t toff = (size_t)ug0 * 16384 + (size_t)(((((n >> 1) * 8 + wid) * 2 + (n & 1)) * 64) + lane) * 4;
    const bf16* APl = (const bf16*)(ws + WS_GAP) + (size_t)ug0 * 16384 + wid * 2048 + lane * 8;
    const bf16* BBl = (const bf16*)(ws + WS_GBB) + toff; bf16* SSl = (bf16*)(ws + WS_GSS) + toff;
    f32x4 S = (f32x4){0.f, 0.f, 0.f, 0.f};
    for (int i = tid; i < 16 * 136; i += 512) STs[i] = 0;
    if (tid < 64) gls[tid] = ((const float*)(sm + SM_GLAST))[ug0 + tid];
    u32x4 ap[8][4]; u32x2 bb[8];
#define GS_FILL(st, c) do { const bf16* _pa = APl + (size_t)(c) * 16384; const bf16* _pb = BBl + (size_t)(c) * 16384; \
        asm volatile("global_load_dwordx4 %0, %5, off\n\tglobal_load_dwordx4 %1, %5, off offset:1024\n\tglobal_load_dwordx4 %2, %5, off offset:2048\n\tglobal_load_dwordx4 %3, %5, off offset:3072\n\t" \
                     "global_load_dwordx2 %4, %6, off" \
                     : "=&v"(ap[st][0]), "=&v"(ap[st][1]), "=&v"(ap[st][2]), "=&v"(ap[st][3]), "=&v"(bb[st]) : "v"(_pa), "v"(_pb) : "memory"); } while (0)
#pragma unroll
    for (int st = 0; st < 8; ++st) GS_FILL(st, st);
    int cur = 0;
    __syncthreads();
    for (int c0 = 0; c0 < 64; c0 += 8) {
#pragma unroll
        for (int st = 0; st < 8; ++st) { const int c = c0 + st;
            asm volatile("s_waitcnt vmcnt(30)" : "+v"(ap[st][0]), "+v"(ap[st][1]), "+v"(ap[st][2]), "+v"(ap[st][3]), "+v"(bb[st]) :: "memory");
            const LAS bf16* STc = STs + cur * (16 * 136); LAS bf16* STn = STs + (cur ^ 1) * (16 * 136);
            const float gl = gls[c];
            *(u32x2*)(SSl + (size_t)c * 16384) = (u32x2){pk2(S[0], S[1]), pk2(S[2], S[3])};
            f32x4 acc; acc[0] = gl * S[0] + bflo(bb[st].x); acc[1] = gl * S[1] + bfhi(bb[st].x); acc[2] = gl * S[2] + bflo(bb[st].y); acc[3] = gl * S[3] + bfhi(bb[st].y);
#pragma unroll
            for (int ks = 0; ks < 4; ++ks) acc = MMA16(__builtin_bit_cast(bf16x8, ap[st][ks]), frag(STc, 0, 136, 32 * ks, lane), acc);
            S = acc; *(LAS u32x2*)(STn + c15 * 136 + 16 * wid + 4 * g4) = (u32x2){pk2(acc[0], acc[1]), pk2(acc[2], acc[3])};
            { const int cn = c + 8 < 64 ? c + 8 : 63; GS_FILL(st, cn); }
            __syncthreads();
            cur ^= 1;
        }
    }
    asm volatile("s_waitcnt vmcnt(0)" ::: "memory");
#undef GS_FILL
}
__device__ __forceinline__ void ml_scan_item(const Args& a, int item, int tid) {
    unsigned char* ws = a.ws; unsigned char* sm = ws + WS_SMALL;
    const int bh = item >> 4, part = item & 15, um0 = bh * 64; const size_t el = (size_t)part * 2048 + (size_t)tid * 4;
    const bf16* BM = (const bf16*)(ws + WS_MBM) + (size_t)um0 * 32768 + el; bf16* CS = (bf16*)(ws + WS_MCS) + (size_t)um0 * 32768 + el;
    const float* DEC = (const float*)(sm + SM_MDEC) + um0; const float* KS = (const float*)(sm + SM_MKS) + um0 * 128; float* NS = (float*)(sm + SM_MNS) + um0 * 128;
    float C[4] = {0.f, 0.f, 0.f, 0.f}; float n = 0.f; const bool don = (part == 0 && tid < 128);
    for (int c0 = 0; c0 < 64; c0 += 16) {
        u32x2 bv[16]; float dc[16], kv[16];
#pragma unroll
        for (int j = 0; j < 16; ++j) { bv[j] = *(const u32x2*)(BM + (size_t)(c0 + j) * 32768); dc[j] = DEC[c0 + j]; kv[j] = don ? KS[(c0 + j) * 128 + tid] : 0.f; }
#pragma unroll
        for (int j = 0; j < 16; ++j) {
            *(u32x2*)(CS + (size_t)(c0 + j) * 32768) = (u32x2){pk2(C[0], C[1]), pk2(C[2], C[3])};
            if (don) { NS[(c0 + j) * 128 + tid] = n; n = dc[j] * n + kv[j]; }
            C[0] = dc[j] * C[0] + bflo(bv[j].x); C[1] = dc[j] * C[1] + bfhi(bv[j].x); C[2] = dc[j] * C[2] + bflo(bv[j].y); C[3] = dc[j] * C[3] + bfhi(bv[j].y); }
    }
}

struct GdnOutPre { u32x4 s4[4], w2[2], q2[2], a1, z0, z1; u32x2 u4[4]; };
#define GDN_OUT_LOAD_T(ugx, P, TID) do { const bf16* _S = (const bf16*)(a.ws + WS_GSS) + (size_t)(ugx) * 16384; const bf16* _W = (const bf16*)(a.ws + WS_GW) + (size_t)(ugx) * 8192; const bf16* _Q = (const bf16*)(a.ws + WS_GQD) + (size_t)(ugx) * 8192; \
        const bf16* _A = (const bf16*)(a.ws + WS_GAT) + (size_t)(ugx) * 4096; const bf16* _U = (const bf16*)(a.ws + WS_GU) + (size_t)(ugx) * 8192; \
        _Pragma("unroll") for (int _i = 0; _i < 4; ++_i) (P).s4[_i] = NTL4(_S + ((TID) + 512 * _i) * 8); \
        _Pragma("unroll") for (int _i = 0; _i < 2; ++_i) { const int _p = (TID) + 512 * _i; (P).w2[_i] = NTL4(_W + _p * 8); (P).q2[_i] = NTL4(_Q + (_p >> 4) * 128 + (_p & 15) * 8); } \
        (P).a1 = NTL4(_A + ((TID) >> 3) * 64 + ((TID) & 7) * 8); \
        _Pragma("unroll") for (int _lt = 0; _lt < 4; ++_lt) (P).u4[_lt] = NTL2(_U + (((((TID) >> 6) * 4 + _lt) * 64) + ((TID) & 63)) * 4); \
        { const int _b = (ugx) >> 9, _h = ((ugx) >> 6) & 7, _c = (ugx) & 63; const bf16* _zr = (const bf16*)(a.ws + WS_Z) + (size_t)(_b * SEQL + _c * 64 + ((TID) >> 3)) * NZ + ZG + _h * 128 + ((TID) & 7) * 16; \
          (P).z0 = *(const u32x4*)_zr; (P).z1 = NTL4(_zr + 8); } } while (0)
#define GDN_OUT_LOAD(ugx, P) GDN_OUT_LOAD_T(ugx, P, tid)
__device__ __forceinline__ void gdn_out_unit(const Args& a, int ug, int ug_next, const bool pf, GdnOutPre& pre, LAS unsigned char* lds, int tid, int wid, int lane) {
    asm volatile("" : "+v"(tid), "+v"(lane));
    unsigned char* ws = a.ws;
    LAS bf16* Ss = (LAS bf16*)lds; LAS bf16* Ws = (LAS bf16*)(lds + 34816); LAS bf16* QDs = (LAS bf16*)(lds + 52224); LAS bf16* ATs = (LAS bf16*)(lds + 69632); LAS bf16* VNt = (LAS bf16*)(lds + 78848);
    LAS float* Os = (LAS float*)lds;
    const int b = ug >> 9, h = (ug >> 6) & 7, c = ug & 63, t0 = b * SEQL + c * 64, g4 = lane >> 4, c15 = lane & 15;
    u32x2 u4r[4]; u32x4 z0, z1;
    {
#pragma unroll
        for (int i = 0; i < 4; ++i) { const int p = tid + 512 * i;
#pragma unroll
            for (int hq = 0; hq < 2; ++hq) { const int q = 2 * p + hq, lr = q & 63, et = (q >> 6) & 1, w = (q >> 7) & 7, es = q >> 10;
                *(LAS u32x2*)(Ss + (es * 32 + 16 * et + (lr & 15)) * 136 + 16 * w + 4 * (lr >> 4)) = hq ? (u32x2){pre.s4[i].z, pre.s4[i].w} : (u32x2){pre.s4[i].x, pre.s4[i].y}; } }
#pragma unroll
        for (int i = 0; i < 2; ++i) { const int p = tid + 512 * i; *(LAS u32x4*)(QDs + (p >> 4) * 136 + (p & 15) * 8) = pre.q2[i];
#pragma unroll
            for (int hq = 0; hq < 2; ++hq) { const int q = 2 * p + hq, lr = q & 63, it = (q >> 6) & 3, en = q >> 8;
                *(LAS u32x2*)(Ws + (16 * it + (lr & 15)) * 136 + 16 * en + 4 * (lr >> 4)) = hq ? (u32x2){pre.w2[i].z, pre.w2[i].w} : (u32x2){pre.w2[i].x, pre.w2[i].y}; } }
        *(LAS u32x4*)(ATs + (tid >> 3) * 72 + (tid & 7) * 8) = pre.a1;
#pragma unroll
        for (int lt = 0; lt < 4; ++lt) u4r[lt] = pre.u4[lt];
        z0 = pre.z0; z1 = pre.z1;
        if (pf) GDN_OUT_LOAD(ug_next, pre);
    }
    __syncthreads();
    f32x4 O[4];
    {
        bf16x8 sf[4];
#pragma unroll
        for (int ks = 0; ks < 4; ++ks) sf[ks] = frag(Ss, 16 * wid, 136, 32 * ks, lane);
#pragma unroll
        for (int lt = 0; lt < 4; ++lt) { f32x4 P = (f32x4){0.f, 0.f, 0.f, 0.f}; const u32x2 u4 = u4r[lt];
#pragma unroll
            for (int ks = 0; ks < 4; ++ks) P = MMA16(sf[ks], frag(Ws, 16 * lt, 136, 32 * ks, lane), P);
            const float v0 = bflo(u4.x) - P[0], v1 = bfhi(u4.x) - P[1], v2 = bflo(u4.y) - P[2], v3 = bfhi(u4.y) - P[3];
            LAS bf16* vp = VNt + (16 * wid + 4 * g4) * 72 + 16 * lt + c15; vp[0] = f2bf(v0); vp[72] = f2bf(v1); vp[144] = f2bf(v2); vp[216] = f2bf(v3); }
        LDS_WAIT();
#pragma unroll
        for (int lt = 0; lt < 4; ++lt) { f32x4 o = (f32x4){0.f, 0.f, 0.f, 0.f};
#pragma unroll
            for (int ks = 0; ks < 4; ++ks) o = MMA16(frag(QDs, 16 * lt, 136, 32 * ks, lane), sf[ks], o);
#pragma unroll
            for (int ks = 0; ks < 2; ++ks) o = MMA16(frag(ATs, 16 * lt, 72, 32 * ks, lane), frag(VNt, 16 * wid, 72, 32 * ks, lane), o);
            O[lt] = o; }
    }
    __syncthreads();
#pragma unroll
    for (int lt = 0; lt < 4; ++lt)
#pragma unroll
        for (int rg = 0; rg < 4; ++rg) Os[(16 * lt + 4 * g4 + rg) * 132 + 16 * wid + c15] = O[lt][rg];
    __syncthreads();
    {
        const int l = tid >> 3, cg = tid & 7; const LAS f32x4* op = (const LAS f32x4*)(Os + l * 132 + cg * 16);
        const f32x4 o0 = op[0], o1 = op[1], o2 = op[2], o3 = op[3];
        float ss = ((o0[0] * o0[0] + o0[1] * o0[1]) + (o0[2] * o0[2] + o0[3] * o0[3])) + ((o1[0] * o1[0] + o1[1] * o1[1]) + (o1[2] * o1[2] + o1[3] * o1[3]))
                 + ((o2[0] * o2[0] + o2[1] * o2[1]) + (o2[2] * o2[2] + o2[3] * o2[3])) + ((o3[0] * o3[0] + o3[1] * o3[1]) + (o3[2] * o3[2] + o3[3] * o3[3]));
#pragma unroll
        for (int o = 1; o < 8; o <<= 1) ss += __shfl_xor(ss, o);
        const float r = rsqrtf(ss * (1.f / 128.f) + EPS);
        const LAS float* gn = (const LAS float*)(lds + GN_LDS) + cg * 16; const f32x4 g0 = *(const LAS f32x4*)gn, g1 = *(const LAS f32x4*)(gn + 4), g2 = *(const LAS f32x4*)(gn + 8), g3 = *(const LAS f32x4*)(gn + 12);
#define GY(ov, gv, zw, k) pk2(ov[2 * (k)] * r * gv[2 * (k)] * (bflo(zw) * sigm(bflo(zw))), ov[2 * (k) + 1] * r * gv[2 * (k) + 1] * (bfhi(zw) * sigm(bfhi(zw))))
        bf16* yp = (bf16*)(ws + WS_Y) + (size_t)(t0 + l) * DM + h * 128 + cg * 16;
        *(u32x4*)yp = (u32x4){GY(o0, g0, z0.x, 0), GY(o0, g0, z0.y, 1), GY(o1, g1, z0.z, 0), GY(o1, g1, z0.w, 1)};
        *(u32x4*)(yp + 8) = (u32x4){GY(o2, g2, z1.x, 0), GY(o2, g2, z1.y, 1), GY(o3, g3, z1.z, 0), GY(o3, g3, z1.w, 1)};
#undef GY
    }
    __syncthreads();
}
struct MlOutPre { u32x4 c4[8], q2[2], v4[4], w1; float nsv, siv, mwv, mev; };
#define ML_OUT_LOAD_T(umx, P, TID) do { const int _b = (umx) >> 8, _h = ((umx) >> 6) & 3, _c = (umx) & 63, _t0 = _b * SEQL + _c * 64; \
        const bf16* _C = (const bf16*)(a.ws + WS_MCS) + (size_t)(umx) * 32768; const bf16* _Z = (const bf16*)(a.ws + WS_Z); const bf16* _WT = (const bf16*)(a.ws + WS_MWT) + (size_t)(umx) * 4096; const bf16* _VT = (const bf16*)(a.ws + WS_MVT) + (size_t)(umx) * 16384; \
        _Pragma("unroll") for (int _i = 0; _i < 8; ++_i) { const int _p = (TID) + 512 * _i; (P).c4[_i] = NTL4(_C + _p * 8); } \
        _Pragma("unroll") for (int _i = 0; _i < 2; ++_i) { const int _p = (TID) + 512 * _i; (P).q2[_i] = NTL4(_Z + (size_t)(_t0 + (_p >> 4)) * NZ + ZMQ + _h * 128 + (_p & 15) * 8); } \
        _Pragma("unroll") for (int _i = 0; _i < 4; ++_i) { const int _p = (TID) + 512 * _i; (P).v4[_i] = NTL4(_VT + (_p >> 3) * 64 + (_p & 7) * 8); } \
        (P).w1 = NTL4(_WT + ((TID) >> 3) * 64 + ((TID) & 7) * 8); \
        (P).nsv = ((const float*)(a.ws + WS_SMALL + SM_MNS))[(umx) * 128 + ((TID) & 127)]; (P).siv = ((const float*)(a.ws + WS_SMALL + SM_MSI))[(umx) * 64 + ((TID) & 63)]; \
        (P).mwv = ((const float*)(a.ws + WS_SMALL + SM_MWS))[(umx) * 64 + ((TID) >> 3)]; (P).mev = ((const float*)(a.ws + WS_SMALL + SM_MEN))[(umx) * 64 + ((TID) >> 3)]; } while (0)
#define ML_OUT_LOAD(umx, P) ML_OUT_LOAD_T(umx, P, tid)
__device__ __forceinline__ void ml_out_unit(const Args& a, int um, int um_next, MlOutPre& pre, LAS unsigned char* lds, int tid, int wid, int lane) {
    asm volatile("" : "+v"(tid), "+v"(lane));
    unsigned char* ws = a.ws; unsigned char* sm = ws + WS_SMALL;
    LAS bf16* Cs = (LAS bf16*)lds; LAS bf16* Qs = (LAS bf16*)(lds + 69632); LAS bf16* WTs = (LAS bf16*)(lds + 87040); LAS bf16* VTs = (LAS bf16*)(lds + 96256);
    LAS float* ns = (LAS float*)(lds + 133120); LAS float* sis = ns + 128; LAS float* dns = ns + 192;
    LAS float* Hs = (LAS float*)lds;
    const int b = um >> 8, h = (um >> 6) & 3, c = um & 63, t0 = b * SEQL + c * 64, g4 = lane >> 4, c15 = lane & 15;
    float mwv, mev;
    u32x4 zo[4];
    { const bf16* zr0 = (const bf16*)(ws + WS_Z) + (size_t)(t0 + (tid >> 3)) * NZ + ZMO + h * 256 + (tid & 7) * 32;
#pragma unroll
      for (int i = 0; i < 4; ++i) zo[i] = *(const u32x4*)(zr0 + 8 * i); }
    {
#pragma unroll
        for (int i = 0; i < 8; ++i) { const int p = tid + 512 * i;
#pragma unroll
            for (int hq = 0; hq < 2; ++hq) { const int q = 2 * p + hq, lr = q & 63, w = (q >> 6) & 7, n = q >> 9;
                *(LAS u32x2*)(Cs + (16 * n + (lr & 15)) * 136 + 16 * w + 4 * (lr >> 4)) = hq ? (u32x2){pre.c4[i].z, pre.c4[i].w} : (u32x2){pre.c4[i].x, pre.c4[i].y}; } }
#pragma unroll
        for (int i = 0; i < 2; ++i) { const int p = tid + 512 * i; *(LAS u32x4*)(Qs + (p >> 4) * 136 + (p & 15) * 8) = pre.q2[i]; }
#pragma unroll
        for (int i = 0; i < 4; ++i) { const int p = tid + 512 * i; *(LAS u32x4*)(VTs + (p >> 3) * 72 + (p & 7) * 8) = pre.v4[i]; }
        *(LAS u32x4*)(WTs + (tid >> 3) * 72 + (tid & 7) * 8) = pre.w1;
        if (tid < 128) ns[tid] = pre.nsv;
        if (tid < 64) sis[tid] = pre.siv;
        mwv = pre.mwv; mev = pre.mev;
        { const int un = um_next >= 0 ? um_next : 0, tq = um_next >= 0 ? tid : 0; ML_OUT_LOAD_T(un, pre, tq); }
    }
    __syncthreads();
    {
        const int l = tid >> 3, part = tid & 7; float s = 0.f;
#pragma unroll
        for (int hq = 0; hq < 2; ++hq) { const u32x4 qv = *(const LAS u32x4*)(Qs + l * 136 + part * 16 + 8 * hq); const f32x4 n0 = *(const LAS f32x4*)(ns + part * 16 + 8 * hq), n1 = *(const LAS f32x4*)(ns + part * 16 + 8 * hq + 4);
            s += (bflo(qv.x) * n0[0] + bfhi(qv.x) * n0[1]) + (bflo(qv.y) * n0[2] + bfhi(qv.y) * n0[3]) + (bflo(qv.z) * n1[0] + bfhi(qv.z) * n1[1]) + (bflo(qv.w) * n1[2] + bfhi(qv.w) * n1[3]); }
#pragma unroll
        for (int o = 1; o < 8; o <<= 1) s += __shfl_xor(s, o);
        if (part == 0) dns[l] = 1.f / fmaxf(fabsf(sis[l] * s + mwv), mev);
    }
    f32x4 N[2][4];
#pragma unroll
    for (int e2 = 0; e2 < 2; ++e2) { const int et = 2 * wid + e2; bf16x8 cf[4];
#pragma unroll
        for (int ks = 0; ks < 4; ++ks) cf[ks] = frag(Cs, 16 * et, 136, 32 * ks, lane);
#pragma unroll
        for (int lt = 0; lt < 4; ++lt) { f32x4 n4 = (f32x4){0.f, 0.f, 0.f, 0.f};
#pragma unroll
            for (int ks = 0; ks < 4; ++ks) n4 = MMA16(frag(Qs, 16 * lt, 136, 32 * ks, lane), cf[ks], n4);
#pragma unroll
            for (int rg = 0; rg < 4; ++rg) n4[rg] *= sis[16 * lt + 4 * g4 + rg];
#pragma unroll
            for (int ks = 0; ks < 2; ++ks) n4 = MMA16(frag(WTs, 16 * lt, 72, 32 * ks, lane), frag(VTs, 16 * et, 72, 32 * ks, lane), n4);
            N[e2][lt] = n4; } }
    __syncthreads();
#pragma unroll
    for (int e2 = 0; e2 < 2; ++e2)
#pragma unroll
        for (int lt = 0; lt < 4; ++lt)
#pragma unroll
            for (int rg = 0; rg < 4; ++rg) { const int l = 16 * lt + 4 * g4 + rg; Hs[l * 260 + 16 * (2 * wid + e2) + c15] = N[e2][lt][rg] * dns[l]; }
    __syncthreads();
    {
        const int l = tid >> 3, cg = tid & 7; const LAS f32x4* hp = (const LAS f32x4*)(Hs + l * 260 + cg * 32);
        f32x4 hv[8]; float ss = 0.f;
#pragma unroll
        for (int i = 0; i < 8; ++i) { hv[i] = hp[i]; ss += (hv[i][0] * hv[i][0] + hv[i][1] * hv[i][1]) + (hv[i][2] * hv[i][2] + hv[i][3] * hv[i][3]); }
#pragma unroll
        for (int o = 1; o < 8; o <<= 1) ss += __shfl_xor(ss, o);
        const float r = rsqrtf(ss * (1.f / 256.f) + EPS);
        const LAS float* mn = (const LAS float*)(lds + GN_LDS + 512) + h * 256 + cg * 32;
        bf16* yp = (bf16*)(ws + WS_Y) + (size_t)(t0 + l) * DM + 1024 + h * 256 + cg * 32;
#pragma unroll
        for (int i = 0; i < 4; ++i) { const u32x4 zw = zo[i]; const f32x4 m0 = *(const LAS f32x4*)(mn + 8 * i), m1 = *(const LAS f32x4*)(mn + 8 * i + 4); const f32x4 h0 = hv[2 * i], h1 = hv[2 * i + 1];
            u32x4 y; y.x = pk2(h0[0] * r * m0[0] * sigm(bflo(zw.x)), h0[1] * r * m0[1] * sigm(bfhi(zw.x))); y.y = pk2(h0[2] * r * m0[2] * sigm(bflo(zw.y)), h0[3] * r * m0[3] * sigm(bfhi(zw.y)));
            y.z = pk2(h1[0] * r * m1[0] * sigm(bflo(zw.z)), h1[1] * r * m1[1] * sigm(bfhi(zw.z))); y.w = pk2(h1[2] * r * m1[2] * sigm(bflo(zw.w)), h1[3] * r * m1[3] * sigm(bfhi(zw.w)));
            *(u32x4*)(yp + 8 * i) = y; }
    }
    __syncthreads();
}

__device__ __forceinline__ void router_unit(const Args& a, int u, LAS unsigned char* lds, int tid, int wid, int lane) {
    asm volatile("" : "+v"(tid), "+v"(lane));
    unsigned char* ws = a.ws; unsigned char* sm = ws + WS_SMALL;
    const bf16* H1 = (const bf16*)(ws + WS_H1);
    LAS float* red = (LAS float*)lds; LAS float* Ls = (LAS float*)(lds + 67584); LAS int* sel = (LAS int*)(lds + 67584 + 8448); LAS int* rks = sel + 256; LAS float* rsl = (LAS float*)(rks + 256);
    const int t0 = u * 64, g4 = lane >> 4, c15 = lane & 15;
    if (tid < 64) { const float* SSQ = (const float*)(sm + SM_SSQ1) + (size_t)(t0 + tid) * 32; float s = 0.f;
#pragma unroll
        for (int q = 0; q < 8; ++q) { const f32x4 v = *(const f32x4*)(SSQ + 4 * q); s += (v[0] + v[1]) + (v[2] + v[3]); }
        const float r = rsqrtf(s * (1.f / DM) + EPS); rsl[tid] = r; ((float*)(sm + SM_RS2))[t0 + tid] = r; }
    __syncthreads();
    float rr[4];
#pragma unroll
    for (int rt = 0; rt < 4; ++rt) rr[rt] = rsl[16 * rt + c15];
    unsigned char* qb = ws + WS_H1B + (size_t)(t0 + c15) * DM;
    skinny_mfma<true>(H1 + (size_t)t0 * DM, (const bf16*)(ws + WS_WSK) + 64 * DM, (const bf16*)(ws + WS_WSK) + 96 * DM, red, Ls, tid, wid, lane,
        [&](int rt, int k, const f32x4& v0, const f32x4& v1) { const float r = rr[rt];
            *(u32x2*)(qb + (size_t)(16 * rt) * DM + k) = (u32x2){pk4_fp8(v0[0] * r, v0[1] * r, v0[2] * r, v0[3] * r), pk4_fp8(v1[0] * r, v1[1] * r, v1[2] * r, v1[3] * r)}; });
    if (tid < 64) { const int l = tid, t = t0 + l; float tv[4]; int ti[4]; const float r = rsl[l]; const float* b_r = argin(a, 14);
        float lg[32];
#pragma unroll
        for (int c4 = 0; c4 < 8; ++c4) { const f32x4 bq = *(const f32x4*)(b_r + 4 * c4);
#pragma unroll
            for (int e = 0; e < 4; ++e) lg[4 * c4 + e] = Ls[l * 33 + 4 * c4 + e] * r + bq[e]; }
        unsigned taken = 0u;
#pragma unroll
        for (int k = 0; k < 4; ++k) { float best = -INFINITY; int bi = 0;
#pragma unroll
            for (int c = 0; c < 32; ++c) { const bool ok = !((taken >> c) & 1u) && lg[c] > best; best = ok ? lg[c] : best; bi = ok ? c : bi; }
            tv[k] = best; ti[k] = bi; taken |= 1u << bi; }
        const float e1 = expf(tv[1] - tv[0]), e2 = expf(tv[2] - tv[0]), e3 = expf(tv[3] - tv[0]); const float inv = 1.f / (1.f + e1 + e2 + e3);
        int* TOPI = (int*)(sm + SM_TOPI); float* TOPG = (float*)(sm + SM_TOPG);
        *(i32x4*)(TOPI + t * 4) = (i32x4){ti[0], ti[1], ti[2], ti[3]};
        *(f32x4*)(TOPG + t * 4) = (f32x4){inv, e1 * inv, e2 * inv, e3 * inv};
        sel[l * 4 + 0] = ti[0]; sel[l * 4 + 1] = ti[1]; sel[l * 4 + 2] = ti[2]; sel[l * 4 + 3] = ti[3]; }
    __syncthreads();
    int my_e = 0, my_lr = 0;
    if (tid < 256) {
        my_e = sel[tid];
#pragma unroll 4
        for (int e = 0; e < 32; ++e) { const unsigned long long m = __ballot(my_e == e); if (my_e == e) my_lr = __popcll(m & ((1ull << lane) - 1ull)); if (lane == 0) rks[wid * 32 + e] = __popcll(m); }
    }
    __syncthreads();
    if (tid < 256) { int rk = my_lr; for (int w = 0; w < wid; ++w) rk += rks[w * 32 + my_e]; ((int*)(sm + SM_LRANK))[t0 * 4 + tid] = rk; }
    if (tid < 32) { const int cnt = (rks[tid] + rks[32 + tid]) + (rks[64 + tid] + rks[96 + tid]);
        ((int*)(sm + SM_UCNT))[u * 32 + tid] = cnt; atomicAdd((int*)(ws + WS_CTL) + CW_CNTE + tid, cnt); }
    __syncthreads();
}

constexpr int NPHASE = 13;
__global__ void __launch_bounds__(NWAVES * 64, 2) mk_fwd(Args args) {
    extern __shared__ __attribute__((aligned(16))) unsigned char lds_raw[];
    LAS unsigned char* lds = (LAS unsigned char*)lds_raw;
    volatile LAS unsigned* MISC = (volatile LAS unsigned*)(lds + MISC_OFF);
    const int wave = __builtin_amdgcn_readfirstlane((int)threadIdx.x >> 6);
#define PHASE_IDS int lane_; asm volatile("v_mbcnt_lo_u32_b32 %0, -1, 0\n\tv_mbcnt_hi_u32_b32 %0, -1, %0" : "=v"(lane_)); const int tid = wave * 64 + lane_; const int lane = lane_; (void)lane;
    const int G = gridDim.x, bx = blockIdx.x;
    unsigned char* ws = args.ws; unsigned char* sm = ws + WS_SMALL;
    const int gw = bx * NWAVES + wave, NGW = G * NWAVES;
    { PHASE_IDS for (int u = tid; u < 64; u += NWAVES * 64) MISC[u] = 0u; }
    __syncthreads();
#if MK_SPLIT
#define GRID_BAR() do { } while (0)
#else
    XcdBarrier bar; { PHASE_IDS bar = xcd_barrier_post((unsigned*)(ws + WS_CTL) + CW_BAR, MISC + 8, tid == 0); }
#define GRID_BAR() xcd_barrier(bar, tid == 0)
#endif
#if MK_SPLIT
    const int lo = args.ph_lo, hi = args.ph_hi;
#else
    constexpr int lo = 0, hi = NPHASE;
#endif
#ifndef PH_MASK
#define PH_MASK 0xffffffffu
#endif
#define IN(k) ((((PH_MASK) >> (k)) & 1u) && lo <= (k) && (k) < hi)
#define BOTH(k) (IN(k) && IN((k) + 1))

    if (IN(0)) {
        PHASE_IDS
        {
            const float* x = argin(args, 0); bf16* xb = (bf16*)(ws + WS_XB);
            for (int t = gw; t < NTOK; t += NGW) { float ss = 0.f; f32x4 v[8];
#pragma unroll
                for (int j = 0; j < 8; ++j) { const int col = 4 * lane + 256 * j; v[j] = *(const f32x4*)(x + (size_t)t * DM + col); ss += (v[j][0] * v[j][0] + v[j][1] * v[j][1]) + (v[j][2] * v[j][2] + v[j][3] * v[j][3]); }
                ss = wave_sum(ss); const float r = rsqrtf(ss * (1.f / DM) + EPS); if (lane == 0) ((float*)(sm + SM_RS1))[t] = r;
#pragma unroll
                for (int j = 0; j < 8; ++j) { const int col = 4 * lane + 256 * j; *(u32x2*)(xb + (size_t)t * DM + col) = (u32x2){pk2(v[j][0] * r, v[j][1] * r), pk2(v[j][2] * r, v[j][3] * r)}; } } }
        {
            const float* w_in = argin(args, 3); const float* g_mix = argin(args, 2); const float* w_r = argin(args, 13); const float* g_ffn = argin(args, 12); bf16* wsk = (bf16*)(ws + WS_WSK);
            for (int i = bx * 512 + tid; i < 2 * 32 * DM; i += G * 512) { const int which = i >> 16, n = (i >> 11) & 31, k = i & 2047; float v;
                if (which == 0) { const int col = n < 16 ? 3072 + n : 6160 + (n - 16); v = n < 24 ? w_in[(size_t)k * DIN + col] * g_mix[k] : 0.f; } else v = w_r[(size_t)k * 32 + n] * g_ffn[k];
                const bf16 hi = f2bf(v); wsk[(size_t)(which * 64 + n) * DM + k] = hi; wsk[(size_t)(which * 64 + 32 + n) * DM + k] = f2bf(v - bf2f(hi)); } }
        p0_weights(args, gw, NGW, lane);
        { const float* p = argin(args, 1); bf16* pb = (bf16*)(ws + WS_PB);
          for (size_t i = (size_t)bx * 512 + tid; i < (size_t)NTOK * PLE / 4; i += (size_t)G * 512) { const f32x4 v = *(const f32x4*)(p + 4 * i); u32x2 w; w.x = pk2(v[0], v[1]); w.y = pk2(v[2], v[3]); *(u32x2*)(pb + 4 * i) = w; } }
        if (BOTH(0)) GRID_BAR();
    }
    if (IN(1)) {
        PHASE_IDS
        const int GA = (G == 256) ? 144 : G;
        if (args.aux == 6) { if (bx >= GA) { PHASE_IDS __syncthreads(); convert_pool(args, lds, tid, wave, lane); } }
        else {
        if (GA == G || bx >= GA) { const int u0 = (GA == G) ? bx : bx - GA, us = (GA == G) ? G : G - GA; for (int u = u0; u < NCHT; u += us) xgate_unit(args, u, lds, tid, wave, lane); }
        if (bx < GA) {
            { pg8::Gemm g{ws + WS_XB, ws + WS_WIN, DM * 2, 0, nullptr, 0, 0}; pg8::Order S; S.init(NTOK / 256, NZ / 256, GA, bx, nullptr, (G == 256) ? 6 : pg8::WGM);
              pg8::EpiZ E{(bf16*)(ws + WS_Z), NZ, (const float*)(sm + SM_RS1)};
              pg8::gemm_phase<pg8::EpiZ, false, true>(lds, g, S, E, tid); }
            { pg8::Gemm g{ws + WS_PB, ws + WS_WPP, PLE * 2, 0, nullptr, 0, 0}; pg8::Order S; S.init(NTOK / 256, DM / 256, GA, (bx + GA - ((NTOK / 256) * (NZ / 256)) % GA) % GA, nullptr);
              pg8::EpiPe E{(bf16*)(ws + WS_PE), (float*)(sm + SM_PESSQ)};
              pg8::gemm_phase<pg8::EpiPe, false, true>(lds, g, S, E, tid); }
        }
        { PHASE_IDS __syncthreads(); convert_pool(args, lds, tid, wave, lane); }
        }
        if (BOTH(1)) GRID_BAR();
    }
    if (IN(2)) {
        PHASE_IDS
        { GdnPre pre; pre.z[0] = pre.z[1] = pre.z[2] = (u32x4){0u, 0u, 0u, 0u}; pre.cw = (f32x4){0.f, 0.f, 0.f, 0.f};
          { const Args& a = args; if (bx < 2048) { GDN_ZLOAD(bx, 0, pre.z); GDN_CWLOAD(bx, pre.cw); } }
          for (int u = bx; u < 2048; u += G) gdn_prep_unit(args, u, (u + G < 2048) ? u + G : -1, pre, lds, tid, wave, lane); }
        { const Args& a = args; MlPre mp; const int u0 = bx + ((2048 - bx + G - 1) / G) * G;
          if (u0 < 3072) ML_PREP_LOAD(u0 - 2048, mp);
          for (int u = u0; u < 3072; u += G) ml_prep_unit(args, u - 2048, (u + G < 3072) ? u + G - 2048 : -1, mp, lds, tid, wave, lane); }
        if (BOTH(2)) GRID_BAR();
    }
    if (IN(3)) {
        PHASE_IDS
        for (int it = bx; it < 256; it += G) { const int itx = (G == 256) ? ((((it & 7) * 4 + (it >> 6)) << 3) | ((it >> 3) & 7)) : it;
            gdn_scan_item(args, itx, lds, tid, wave, lane); ml_scan_item(args, it, tid); __syncthreads(); }
        if (BOTH(3)) GRID_BAR();
    }
    if (IN(4)) {
        PHASE_IDS
        { const Args& a = args;
          { LAS float* gns = (LAS float*)(lds + GN_LDS); const float* gsrc = argin(args, 7); const float* msrc = argin(args, 10); if (tid < 128) gns[tid] = gsrc[tid]; gns[128 + tid] = msrc[tid]; gns[640 + tid] = msrc[512 + tid]; __syncthreads(); }
          if (G == 256) {
            GdnOutPre preA, preB; GDN_OUT_LOAD(bx, preA); GDN_OUT_LOAD(bx + 256, preB);
            if (args.aux != 2) {
#pragma unroll
              for (int k = 0; k < 4; ++k) {
                gdn_out_unit(args, bx + 512 * k, bx + 512 * (k + 1), k < 3, preA, lds, tid, wave, lane);
                gdn_out_unit(args, bx + 512 * k + 256, bx + 512 * (k + 1) + 256, k < 3, preB, lds, tid, wave, lane); } }
          } else { GdnOutPre pre; if (bx < 2048) GDN_OUT_LOAD(bx, pre);
            if (args.aux != 2) for (int u = bx; u < 2048; u += G) gdn_out_unit(args, u, u + G, u + G < 2048, pre, lds, tid, wave, lane); }
          { MlOutPre pre; const int u0 = bx + ((2048 - bx + G - 1) / G) * G;
            if (u0 < 3072) ML_OUT_LOAD(u0 - 2048, pre);
            if (args.aux != 1) for (int u = u0; u < 3072; u += G) ml_out_unit(args, u - 2048, (u + G < 3072) ? u + G - 2048 : -1, pre, lds, tid, wave, lane); } }
        if (BOTH(4)) GRID_BAR();
    }
    if (IN(5)) {
        PHASE_IDS
        pg8::Gemm g{ws + WS_Y, ws + WS_WOUT, DM * 2, 0, nullptr, 0, 0}; pg8::Order S; S.init(NTOK / 256, DM / 256, G, bx, nullptr);
        pg8::EpiOut E{(const bf16*)(ws + WS_XB), (bf16*)(ws + WS_H1), (float*)(sm + SM_SSQ1), (const float*)(sm + SM_RS1)};
        pg8::gemm_phase<pg8::EpiOut, false, true>(lds, g, S, E, tid);
        if (BOTH(5)) GRID_BAR();
    }
    if (IN(6)) {
        PHASE_IDS
        for (int u = bx; u < NCHT; u += G) router_unit(args, u, lds, tid, wave, lane);
        if (BOTH(6)) GRID_BAR();
    }
    if (IN(7)) {
        PHASE_IDS
        LAS int* ps = (LAS int*)lds; LAS int* up = ps + 32; LAS int* cn = ps + 64;
        const int* CNTE = (const int*)(ws + WS_CTL) + CW_CNTE; const int* UCNT = (const int*)(sm + SM_UCNT);
        int* ROWTOK = (int*)(sm + SM_ROWTOK); float* ROWGATE = (float*)(sm + SM_ROWGATE); float* ROWRS = (float*)(sm + SM_ROWRS);
        if (tid < 64) {
            const int cnt = tid < 32 ? CNTE[tid] : 0, pad = ((cnt + 255) >> 8) << 8; int inc = pad;
#pragma unroll
            for (int off = 1; off < 32; off <<= 1) { const int p = __shfl_up(inc, off); if (tid >= off) inc += p; }
            if (tid < 32) { ps[tid] = inc - pad; cn[tid] = cnt; } }
        __syncthreads();
        for (int u = bx; u < NCHT; u += G) {
            { LAS int* pp = ps + 128; int s0 = 0, s1 = 0, s2 = 0, s3 = 0; const int e = tid & 31, part = tid >> 5;
              for (int v = part; v < u; v += 64) { s0 += UCNT[v * 32 + e]; if (v + 16 < u) s1 += UCNT[(v + 16) * 32 + e]; if (v + 32 < u) s2 += UCNT[(v + 32) * 32 + e]; if (v + 48 < u) s3 += UCNT[(v + 48) * 32 + e]; }
              pp[part * 32 + e] = (s0 + s1) + (s2 + s3); }
            __syncthreads();
            if (tid < 32) { int s = 0; for (int q = 0; q < 16; ++q) s += ps[128 + q * 32 + tid]; up[tid] = s; }
            __syncthreads();
            if (tid < 256) { const int ai = u * 256 + tid, t = ai >> 2; const int e = ((const int*)(sm + SM_TOPI))[ai]; const int dest = ps[e] + up[e] + ((const int*)(sm + SM_LRANK))[ai];
                ROWTOK[dest] = t; ROWGATE[dest] = ((const float*)(sm + SM_TOPG))[ai]; ROWRS[dest] = ((const float*)(sm + SM_RS2))[t]; ((int*)(sm + SM_DEST))[ai] = dest; }
            __syncthreads();
        }
        for (int e = bx; e < 32; e += G) { const int c0 = cn[e], c1 = ((c0 + 255) >> 8) << 8; for (int p = c0 + tid; p < c1; p += 512) { ROWTOK[ps[e] + p] = 0; ROWGATE[ps[e] + p] = 0.f; ROWRS[ps[e] + p] = 0.f; } }
        if (BOTH(7)) GRID_BAR();
    }
    if (IN(8) || IN(9)) {
        PHASE_IDS
        LAS int* tile_e = (LAS int*)(lds + MISC_OFF + 1024); LAS int* meta = (LAS int*)(lds + MISC_OFF + 512); LAS int* toffs = (LAS int*)(lds + MISC_OFF + 2304); LAS int* poffs = (LAS int*)(lds + MISC_OFF + 3584); LAS int* ptile = (LAS int*)(lds + 132096);
        if (tid < 64) {
            const int* CNTE = (const int*)(ws + WS_CTL) + CW_CNTE; const int nt = tid < 32 ? (CNTE[tid] + 255) >> 8 : 0; int inc = nt;
#pragma unroll
            for (int off = 1; off < 32; off <<= 1) { const int p = __shfl_up(inc, off); if (tid >= off) inc += p; }
            for (int i = 0; i < nt; ++i) tile_e[inc - nt + i] = tid;
            if (tid < 32) { toffs[tid] = inc - nt; toffs[32 + tid] = nt; }
            { const int ne = (nt & 1) ? 0 : nt, no = (nt & 1) ? nt : 0; int ie = ne, io = no;
#pragma unroll
              for (int off = 1; off < 32; off <<= 1) { const int pe = __shfl_up(ie, off), po = __shfl_up(io, off); if (tid >= off) { ie += pe; io += po; } }
              const int tot_e = __shfl(ie, 31); const int poff = (nt & 1) ? tot_e + io - no : ie - ne;
              if (tid < 32) poffs[tid] = poff;
              for (int i = 0; i < nt; ++i) ptile[poff + i] = tid; }
            if (tid == 31) meta[0] = inc; }
        __syncthreads();
        const int n_mt = meta[0];
#define MOE_ULIST(nN_) do { LAS int* ulist = tile_e + 384; if (tid < 64) { const int nwg_ = n_mt * (nN_); const long L_ = (long)tid * G + bx; int pm_ = -1, pn_ = 0, e_ = 0; \
            if (L_ < nwg_) { int w_ = (int)L_; { const int q_ = nwg_ / 8, r_ = nwg_ % 8, x_ = w_ % 8, o_ = w_ / 8; w_ = (x_ < r_ ? x_ * (q_ + 1) : r_ * (q_ + 1) + (x_ - r_) * q_) + o_; } \
                e_ = ptile[w_ / (nN_)]; const int to_ = toffs[e_], nt_ = toffs[32 + e_], idx_ = w_ - (nN_) * poffs[e_]; pm_ = to_ + idx_ % nt_; pn_ = idx_ / nt_; } \
            ulist[4 * tid] = pm_; ulist[4 * tid + 1] = pn_; ulist[4 * tid + 2] = e_; } __syncthreads(); } while (0)
        if (IN(8)) {
            pg8::Gemm g{ws + WS_H1B, ws + WS_WGU, DM, (size_t)4096 * DM, (const int*)(sm + SM_ROWTOK), ONE_E8M0, W8_E8M0}; pg8::Order S;
            pg8::EpiMoe1 E{ws + WS_ACT, argin(args, 16)};
            if (G >= 80) { MOE_ULIST(16); pg8::ListOrder LS{tile_e + 384}; pg8::gemm_phase<pg8::EpiMoe1, true, true, true, pg8::ListOrder>(lds, g, LS, E, tid); }
            else { S.init(n_mt, 16, G, bx, tile_e); pg8::gemm_phase<pg8::EpiMoe1, true, true, true>(lds, g, S, E, tid); }
            if (BOTH(8)) GRID_BAR();
        }
        if (IN(9)) {
            pg8::Gemm g{ws + WS_ACT, ws + WS_WDN, DM, (size_t)DM * DM, nullptr, ACT8_E8M0, W8_E8M0}; pg8::Order S;
            pg8::EpiMoe2 E{ws + WS_YB, argin(args, 18), (const float*)(sm + SM_ROWGATE)};
            if (G >= 80) { MOE_ULIST(8); pg8::ListOrder LS{tile_e + 384}; pg8::gemm_phase<pg8::EpiMoe2, false, true, true, pg8::ListOrder>(lds, g, LS, E, tid); }
            else { S.init(n_mt, 8, G, bx, tile_e); pg8::gemm_phase<pg8::EpiMoe2, false, true, true>(lds, g, S, E, tid); }
            if (BOTH(9)) GRID_BAR();
        }
    }
    if (IN(10)) {
        PHASE_IDS
        const bf16* H1 = (const bf16*)(ws + WS_H1); const unsigned char* YB = ws + WS_YB; bf16* H2 = (bf16*)(ws + WS_H2); unsigned char* H2Q = ws + WS_H2B;
        const int* DEST = (const int*)(sm + SM_DEST); const float* PESSQ = (const float*)(sm + SM_PESSQ);
        for (int t = gw; t < NTOK; t += NGW) { const i32x4 dd = *(const i32x4*)(DEST + t * 4); float ss = 0.f;
            u32x2 hvv[8]; unsigned yv[8][4];
#pragma unroll
            for (int j = 0; j < 8; ++j) { const int col = 4 * lane + 256 * j; hvv[j] = NTL2(H1 + (size_t)t * DM + col);
                yv[j][0] = NTL1(YB + (size_t)dd[0] * DM + col); yv[j][1] = NTL1(YB + (size_t)dd[1] * DM + col); yv[j][2] = NTL1(YB + (size_t)dd[2] * DM + col); yv[j][3] = NTL1(YB + (size_t)dd[3] * DM + col); }
            asm volatile("" ::: "memory");
#pragma unroll
            for (int j = 0; j < 8; ++j) { const int col = 4 * lane + 256 * j; f32x4 hv = (f32x4){bflo(hvv[j].x), bfhi(hvv[j].x), bflo(hvv[j].y), bfhi(hvv[j].y)}; const unsigned y0 = yv[j][0], y1 = yv[j][1], y2 = yv[j][2], y3 = yv[j][3];
                const f32x2 a0 = __builtin_amdgcn_cvt_pk_f32_fp8(y0, false) + __builtin_amdgcn_cvt_pk_f32_fp8(y1, false) + (__builtin_amdgcn_cvt_pk_f32_fp8(y2, false) + __builtin_amdgcn_cvt_pk_f32_fp8(y3, false));
                const f32x2 a1 = __builtin_amdgcn_cvt_pk_f32_fp8(y0, true) + __builtin_amdgcn_cvt_pk_f32_fp8(y1, true) + (__builtin_amdgcn_cvt_pk_f32_fp8(y2, true) + __builtin_amdgcn_cvt_pk_f32_fp8(y3, true));
                hv[0] += a0[0] * (1.f / YB8_SCALE); hv[1] += a0[1] * (1.f / YB8_SCALE); hv[2] += a1[0] * (1.f / YB8_SCALE); hv[3] += a1[1] * (1.f / YB8_SCALE);
                *(u32x2*)(H2 + (size_t)t * DM + col) = (u32x2){pk2(hv[0], hv[1]), pk2(hv[2], hv[3])}; *(unsigned*)(H2Q + (size_t)t * DM + col) = pk4_fp8(hv[0] * ACT8_SCALE, hv[1] * ACT8_SCALE, hv[2] * ACT8_SCALE, hv[3] * ACT8_SCALE);
                ss += (hv[0] * hv[0] + hv[1] * hv[1]) + (hv[2] * hv[2] + hv[3] * hv[3]); }
            ss = wave_sum(ss); const float ps = wave_sum(lane < 32 ? PESSQ[(size_t)t * 32 + lane] : 0.f);
            if (lane == 0) { ((float*)(sm + SM_RS3))[t] = rsqrtf(ss * (1.f / DM) + EPS); ((float*)(sm + SM_RSPE))[t] = rsqrtf(ps * (1.f / DM) + EPS); } }
        if (BOTH(10)) GRID_BAR();
    }
    if (IN(11)) {
        PHASE_IDS
        pg8::Gemm g{ws + WS_H2B, ws + WS_WPG, DM, 0, nullptr, ACT8_E8M0, W8_E8M0}; pg8::Order S; S.init(NTOK / 256, DM / 256, G, bx, nullptr);
        pg8::EpiPg E{(const bf16*)(ws + WS_H2), (const bf16*)(ws + WS_PE), (const float*)(sm + SM_RS3), (const float*)(sm + SM_RSPE), argin(args, 22), (bf16*)(ws + WS_H3), (float*)(sm + SM_SSQ3)};
        pg8::gemm_phase<pg8::EpiPg, false, true, true>(lds, g, S, E, tid);
        if (BOTH(11)) GRID_BAR();
    }
#ifdef DBG_OUT
    if (IN(12)) {
        PHASE_IDS
        for (int t = gw; t < NTOK; t += NGW) {
#pragma unroll
            for (int j = 0; j < 8; ++j) { const int col = 4 * lane + 256 * j; f32x4 v;
#if DBG_OUT == 1
                { const u32x2 w = *(const u32x2*)((const bf16*)(ws + WS_Z) + (size_t)t * NZ + col); v = (f32x4){bflo(w.x), bfhi(w.x), bflo(w.y), bfhi(w.y)}; }
#elif DBG_OUT == 3
                v = *(const f32x4*)((const float*)(ws + WS_OSC) + (size_t)t * DM + col);
#elif DBG_OUT == 2
                { const size_t idx = (size_t)t * 1024 + (col & 1023);
                  if (col < 1024) v = *(const f32x4*)((const float*)(ws + WS_GU) + idx);
                  else { for (int q = 0; q < 4; ++q) { const size_t ix = idx + q; float a = bf2f(((const bf16*)(ws + WS_MVT))[ix]) + bf2f(((const bf16*)(ws + WS_MKWT))[ix & 8388607]) + bf2f(((const bf16*)(ws + WS_MWT))[ix & 4194303])
                      + bf2f(((const bf16*)(ws + WS_GW))[ix]) + bf2f(((const bf16*)(ws + WS_GKDT))[ix]) + bf2f(((const bf16*)(ws + WS_GQD))[ix]) + bf2f(((const bf16*)(ws + WS_GAT))[ix & 8388607])
                      + ((const float*)(sm + SM_MSI))[ix & 65535] + ((const float*)(sm + SM_MEN))[ix & 65535] + ((const float*)(sm + SM_MWS))[ix & 65535] + ((const float*)(sm + SM_GLAST))[ix & 2047] + ((const float*)(sm + SM_MDEC))[ix & 1023];
                      v[q] = a; } } }
#elif DBG_OUT == 31
                v = col < 1024 ? *(const f32x4*)((const float*)(ws + WS_OSC) + (size_t)t * DM + col) : (f32x4){0.f, 0.f, 0.f, 0.f};
#elif DBG_OUT == 32
                v = col >= 1024 ? *(const f32x4*)((const float*)(ws + WS_OSC) + (size_t)t * DM + col) : (f32x4){0.f, 0.f, 0.f, 0.f};
#elif DBG_OUT == 5
                v = *(const f32x4*)((const float*)(ws + WS_H1) + (size_t)t * DM + col);
#elif DBG_OUT == 10
                v = *(const f32x4*)((const float*)(ws + WS_H2) + (size_t)t * DM + col);
#endif
                *(f32x4*)(args.out + (size_t)t * DM + col) = v; } }
    }
#else
    if (IN(12)) {
        PHASE_IDS
        const bf16* H3 = (const bf16*)(ws + WS_H3); const float* SSQ3 = (const float*)(sm + SM_SSQ3); const float* gf = argin(args, 23);
        for (int t = gw; t < NTOK; t += NGW) { u32x2 hw[8]; f32x4 gv[8];
#pragma unroll
            for (int j = 0; j < 8; ++j) { const int col = 4 * lane + 256 * j; hw[j] = *(const u32x2*)(H3 + (size_t)t * DM + col); gv[j] = *(const f32x4*)(gf + col); }
            const float r = rsqrtf(wave_sum(lane < 32 ? SSQ3[(size_t)t * 32 + lane] : 0.f) * (1.f / DM) + EPS);
#pragma unroll
            for (int j = 0; j < 8; ++j) { const int col = 4 * lane + 256 * j; const f32x4 hv = (f32x4){bflo(hw[j].x), bfhi(hw[j].x), bflo(hw[j].y), bfhi(hw[j].y)};
                *(f32x4*)(args.out + (size_t)t * DM + col) = hv * gv[j] * r; } }
    }
#endif
#ifdef DBG_DET
    if (lo == 13) { PHASE_IDS
        unsigned long long s1 = 0ull, s2 = 0ull;
        auto acc_region = [&](const unsigned* p, size_t nwords) { for (size_t i = (size_t)bx * 512 + tid; i < nwords; i += (size_t)G * 512) { const unsigned w = p[i]; s1 += w; s2 += (unsigned long long)w * ((unsigned)i | 1u); } };
#if DBG_DET == 0
        acc_region((const unsigned*)(ws + WS_WIN), (size_t)(WS_Z - WS_WIN) / 4);
        acc_region((const unsigned*)(sm + SM_RS1), (size_t)(SM_GLAST - SM_RS1) / 4);
#elif DBG_DET == 1
        acc_region((const unsigned*)(ws + WS_Z), (size_t)(WS_GW - WS_Z) / 4);
        acc_region((const unsigned*)(sm + SM_PESSQ), (size_t)(2 << 20) / 4);
#elif DBG_DET == 2
        acc_region((const unsigned*)(ws + WS_GW), (size_t)(WS_OSC - WS_GW) / 4);
        acc_region((const unsigned*)(sm + SM_GLAST), (size_t)(SM_DEN - SM_GLAST) / 4);
#elif DBG_DET == 3
        acc_region((const unsigned*)(ws + WS_OSC), (size_t)(WS_Y - WS_OSC) / 4);
        acc_region((const unsigned*)(sm + SM_DEN), (size_t)(256 << 10) / 4);
#endif
        for (int o = 1; o < 64; o <<= 1) { s1 += __shfl_xor(s1, o); s2 += __shfl_xor(s2, o); }
        if (lane == 0) { unsigned long long* slot = (unsigned long long*)(ws + WS_CTL) + 8192 + 2 * args.aux; atomicAdd(slot, s1); atomicAdd(slot + 1, s2); }
    }
    if (lo == 14) { PHASE_IDS
        const unsigned long long* slot = (const unsigned long long*)(ws + WS_CTL) + 8192;
        const float v = (slot[0] == slot[2] && slot[1] == slot[3]) ? 0.f : 3.f;
        for (size_t i = (size_t)bx * 512 + tid; i < (size_t)NTOK * DM; i += (size_t)G * 512) args.out[i] = v;
    }
#endif
#undef IN
#undef BOTH
}

extern "C" void kernel_launch(void* const* d_in, const int* in_sizes, int n_in, void* d_out, int out_size, void* d_ws, size_t ws_size, hipStream_t stream) {
    static int grid = 0;
    if (grid == 0) {
        if (n_in != 24 || out_size != NTOK * DM || ws_size < WS_END) { fprintf(stderr, "kernel_launch: unexpected problem (n_in %d, out %d, ws %zu)\n", n_in, out_size, ws_size); grid = -1; return; }
        int dev = 0, cus = 0, per_cu = 0;
        if (hipGetDevice(&dev) != hipSuccess || hipDeviceGetAttribute(&cus, hipDeviceAttributeMultiprocessorCount, dev) != hipSuccess) { grid = -1; return; }
        if (hipFuncSetAttribute((const void*)mk_fwd, hipFuncAttributeMaxDynamicSharedMemorySize, LDS_BYTES) != hipSuccess) { fprintf(stderr, "kernel_launch: hipFuncSetAttribute failed\n"); grid = -1; return; }
        if (hipOccupancyMaxActiveBlocksPerMultiprocessor(&per_cu, (const void*)mk_fwd, NWAVES * 64, LDS_BYTES) != hipSuccess || per_cu < 1) fprintf(stderr, "kernel_launch: occupancy query reports %d\n", per_cu);
        (void)hipGetLastError();
        grid = cus;
    }
    if (grid < 0) return;
    (void)hipMemsetAsync((char*)d_ws + WS_CTL, 0, CTL_ZERO_BYTES, stream);
    Args a{};
    for (int i = 0; i < 24; ++i) a.in[i] = (const float*)d_in[i];
    a.out = (float*)d_out; a.ws = (unsigned char*)d_ws;
#ifdef DBG_DET
    for (int rep = 0; rep < 2; ++rep) {
        for (int ph = 0; ph <= DBG_DET; ++ph) { a.ph_lo = ph; a.ph_hi = ph + 1; hipLaunchKernelGGL(mk_fwd, dim3(grid), dim3(NWAVES * 64), LDS_BYTES, stream, a); }
        a.ph_lo = 13; a.ph_hi = 13; a.aux = rep; hipLaunchKernelGGL(mk_fwd, dim3(grid), dim3(NWAVES * 64), LDS_BYTES, stream, a); a.aux = 0;
    }
    a.ph_lo = 14; a.ph_hi = 14; hipLaunchKernelGGL(mk_fwd, dim3(grid), dim3(NWAVES * 64), LDS_BYTES, stream, a);
    return;
#endif
#if MK_SPLIT
#ifndef DUP_MASK
#define DUP_MASK 0u
#endif
    for (int ph = 0; ph < NPHASE; ++ph) { a.ph_lo = ph; a.ph_hi = ph + 1; const int reps = ((DUP_MASK >> ph) & 1u) ? 2 : 1;
        for (int r = 0; r < reps; ++r) { a.aux = (r == 1) ? DUP_AUX : 0; hipLaunchKernelGGL(mk_fwd, dim3(grid), dim3(NWAVES * 64), LDS_BYTES, stream, a); a.aux = 0; } }
#else
    a.ph_lo = 0; a.ph_hi = NPHASE; hipLaunchKernelGGL(mk_fwd, dim3(grid), dim3(NWAVES * 64), LDS_BYTES, stream, a);
#endif
}
```
